# Optimizing an MI355X kernel written in HIP

```python
import jax, jax.numpy as jnp
from jax import lax
import numpy as np

D_MODEL = 4096
BATCH = 1
SEQ = 16384
DEPTH = 2

N_A_LAYERS = DEPTH // 2
N_B_LAYERS = DEPTH - N_A_LAYERS

D_FF = 11008
RMS_EPS = 1e-6
ROPE_THETA = 10000.0
NEG = -1e30

A_HEADS = 32
A_KV_HEADS = 8
A_HEAD_DIM = D_MODEL // A_HEADS
A_Q_WIDTH = A_HEADS * A_HEAD_DIM
A_KV_WIDTH = A_KV_HEADS * A_HEAD_DIM
MOBA_BLOCK = 256
MOBA_TOPK = 3
MOBA_QCHUNK = 32

B_HEADS = 64
B_KV_HEADS = 8
B_HEAD_DIM = D_MODEL // B_HEADS
B_Q_WIDTH = B_HEADS * B_HEAD_DIM
B_KV_WIDTH = B_KV_HEADS * B_HEAD_DIM
SWA_WINDOW = 128
SWA_BLOCK = 128

kernel_name = "yoco_moba_swa_sink_macaron"


def rms_norm(x, g):
    x32 = x.astype(jnp.float32)
    y = x32 * lax.rsqrt(jnp.mean(x32 * x32, axis=-1, keepdims=True) + RMS_EPS)
    return (y * g.astype(jnp.float32)).astype(x.dtype)


def rope_tables(seq, dim):
    inv = 1.0 / (ROPE_THETA ** (jnp.arange(0, dim, 2, dtype=jnp.float32) / dim))
    ang = jnp.arange(seq, dtype=jnp.float32)[:, None] * inv[None, :]
    return jnp.cos(ang), jnp.sin(ang)


def apply_rope(x, cos, sin):
    x32 = x.astype(jnp.float32)
    x1, x2 = jnp.split(x32, 2, axis=-1)
    c = cos[None, :, None, :]
    s = sin[None, :, None, :]
    return jnp.concatenate([x1 * c - x2 * s, x2 * c + x1 * s], axis=-1).astype(x.dtype)


def swiglu(h, w_in, w_out):
    g, u = jnp.split(h @ w_in, 2, axis=-1)
    return (jax.nn.silu(g) * u) @ w_out


def moba_attention(q, k, v):
    b, s, h, dh = q.shape
    hkv = k.shape[2]
    g = h // hkv
    L = MOBA_BLOCK
    nb = -(-s // L)
    pad = nb * L - s
    topk = min(MOBA_TOPK, nb)
    scale = dh ** -0.5
    padw = ((0, 0), (0, pad), (0, 0), (0, 0))
    kb = jnp.pad(k, padw).reshape(b, nb, L, hkv, dh).transpose(0, 3, 1, 2, 4)
    vb = jnp.pad(v, padw).reshape(b, nb, L, hkv, dh).transpose(0, 3, 1, 2, 4)
    kmean = jnp.mean(kb.astype(jnp.float32), axis=3)

    nq = s // MOBA_QCHUNK
    qc = q.reshape(b, nq, MOBA_QCHUNK, hkv, g, dh).transpose(1, 0, 2, 3, 4, 5)
    chunk_ids = jnp.arange(nq, dtype=jnp.int32)
    bi = jnp.arange(b)[:, None, None, None, None]
    hi = jnp.arange(hkv)[None, None, :, None, None]
    blk = jnp.arange(nb)

    def body(args):
        qch, ci = args
        t0 = ci * MOBA_QCHUNK
        cur = t0 // L
        qpos = t0 + jnp.arange(MOBA_QCHUNK)
        q32 = qch.astype(jnp.float32)
        gate = jnp.einsum('bqhgd,bhnd->bqhgn', q32, kmean)
        gate = jnp.where(blk < cur, gate, NEG)
        _, sel = lax.top_k(gate, topk)
        valid = sel < cur
        kg = kb[bi, hi, sel].astype(jnp.float32)
        vg = vb[bi, hi, sel].astype(jnp.float32)
        s_past = jnp.einsum('bqhgd,bqhgkld->bqhgkl', q32, kg) * scale
        s_past = jnp.where(valid[..., None], s_past, NEG).reshape(b, MOBA_QCHUNK, hkv, g, topk * L)
        k_own = lax.dynamic_slice_in_dim(kb, cur, 1, axis=2)[:, :, 0].astype(jnp.float32)
        v_own = lax.dynamic_slice_in_dim(vb, cur, 1, axis=2)[:, :, 0].astype(jnp.float32)
        s_own = jnp.einsum('bqhgd,bhld->bqhgl', q32, k_own) * scale
        kpos = cur * L + jnp.arange(L)
        causal = kpos[None, :] <= qpos[:, None]
        s_own = jnp.where(causal[None, :, None, None, :], s_own, NEG)
        p = jax.nn.softmax(jnp.concatenate([s_own, s_past], axis=-1), axis=-1)
        p_own = p[..., :L]
        p_past = p[..., L:].reshape(b, MOBA_QCHUNK, hkv, g, topk, L)
        o = (jnp.einsum('bqhgl,bhld->bqhgd', p_own, v_own)
             + jnp.einsum('bqhgkl,bqhgkld->bqhgd', p_past, vg))
        return o.astype(q.dtype)

    out = lax.map(body, (qc, chunk_ids))
    return out.transpose(1, 0, 2, 3, 4, 5).reshape(b, s, h * dh)


def swa_sink_attention(q, k, v, sinks):
    b, s, h, dh = q.shape
    hkv = k.shape[2]
    g = h // hkv
    L = SWA_BLOCK
    nblk = s // L
    scale = dh ** -0.5
    qb = q.reshape(b, nblk, L, hkv, g, dh).astype(jnp.float32)
    kb = k.reshape(b, nblk, L, hkv, dh)
    vb = v.reshape(b, nblk, L, hkv, dh)
    padw = ((0, 0), (1, 0), (0, 0), (0, 0), (0, 0))
    kband = jnp.concatenate([jnp.pad(kb, padw)[:, :-1], kb], axis=2).astype(jnp.float32)
    vband = jnp.concatenate([jnp.pad(vb, padw)[:, :-1], vb], axis=2).astype(jnp.float32)
    scores = jnp.einsum('bnqhgd,bnkhd->bnhgqk', qb, kband) * scale
    n = jnp.arange(nblk)[:, None, None]
    qpos = n * L + jnp.arange(L)[None, :, None]
    kpos = n * L - L + jnp.arange(2 * L)[None, None, :]
    allowed = (kpos <= qpos) & (qpos - kpos < SWA_WINDOW) & (kpos >= 0)
    scores = jnp.where(allowed[None, :, None, None], scores, NEG)
    sink = sinks.astype(jnp.float32).reshape(hkv, g)[None, None, :, :, None, None]
    m = jnp.maximum(jnp.max(scores, axis=-1, keepdims=True), sink)
    p = jnp.exp(scores - m)
    p = p / (jnp.sum(p, axis=-1, keepdims=True) + jnp.exp(sink - m))
    o = jnp.einsum('bnhgqk,bnkhd->bnqhgd', p, vband)
    return o.reshape(b, s, h * dh).astype(q.dtype)


def setup_inputs(seed: int = 0) -> dict:
    key = jax.random.key(seed)
    ks = jax.random.split(key, 14)
    f32 = jnp.float32
    nrm = lambda k, shape, fan_in: jax.random.normal(k, shape, f32) * (fan_in ** -0.5)
    gain = lambda k, shape: 1.0 + 0.01 * jax.random.normal(k, shape, f32)
    return {
        "x": jax.random.normal(ks[0], (BATCH, SEQ, D_MODEL), f32),
        "ffn_norm": gain(ks[1], (DEPTH, 2, D_MODEL)),
        "ffn_w_in": nrm(ks[2], (DEPTH, 2, D_MODEL, 2 * D_FF), D_MODEL),
        "ffn_w_out": nrm(ks[3], (DEPTH, 2, D_FF, D_MODEL), D_FF),
        "attn_norm": gain(ks[4], (DEPTH, D_MODEL)),
        "a_w_qkv": nrm(ks[5], (N_A_LAYERS, D_MODEL, A_Q_WIDTH + 2 * A_KV_WIDTH), D_MODEL),
        "a_w_o": nrm(ks[6], (N_A_LAYERS, A_Q_WIDTH, D_MODEL), A_Q_WIDTH),
        "kv_norm": gain(ks[7], (D_MODEL,)),
        "w_kv_shared": nrm(ks[8], (D_MODEL, 2 * B_KV_WIDTH), D_MODEL),
        "b_w_q": nrm(ks[9], (N_B_LAYERS, D_MODEL, B_Q_WIDTH), D_MODEL),
        "b_sinks": 0.5 * jax.random.normal(ks[10], (N_B_LAYERS, B_HEADS), f32),
        "b_w_o": nrm(ks[11], (N_B_LAYERS, B_Q_WIDTH, D_MODEL), B_Q_WIDTH),
        "final_norm": gain(ks[12], (D_MODEL,)),
    }


def reference(x, ffn_norm, ffn_w_in, ffn_w_out, attn_norm, a_w_qkv, a_w_o, kv_norm,
              w_kv_shared, b_w_q, b_sinks, b_w_o, final_norm):
    b, s, _ = x.shape
    cos_a, sin_a = rope_tables(s, A_HEAD_DIM)
    cos_b, sin_b = rope_tables(s, B_HEAD_DIM)
    k_sh = None
    v_sh = None
    for layer in range(DEPTH):
        if layer == N_A_LAYERS:
            kv = rms_norm(x, kv_norm) @ w_kv_shared
            k_sh, v_sh = jnp.split(kv, 2, axis=-1)
            k_sh = apply_rope(k_sh.reshape(b, s, B_KV_HEADS, B_HEAD_DIM), cos_b, sin_b)
            v_sh = v_sh.reshape(b, s, B_KV_HEADS, B_HEAD_DIM)
        x = x + 0.5 * swiglu(rms_norm(x, ffn_norm[layer, 0]), ffn_w_in[layer, 0], ffn_w_out[layer, 0])
        h = rms_norm(x, attn_norm[layer])
        if layer < N_A_LAYERS:
            q, k, v = jnp.split(h @ a_w_qkv[layer], [A_Q_WIDTH, A_Q_WIDTH + A_KV_WIDTH], axis=-1)
            q = apply_rope(q.reshape(b, s, A_HEADS, A_HEAD_DIM), cos_a, sin_a)
            k = apply_rope(k.reshape(b, s, A_KV_HEADS, A_HEAD_DIM), cos_a, sin_a)
            v = v.reshape(b, s, A_KV_HEADS, A_HEAD_DIM)
            x = x + moba_attention(q, k, v) @ a_w_o[layer]
        else:
            i = layer - N_A_LAYERS
            q = apply_rope((h @ b_w_q[i]).reshape(b, s, B_HEADS, B_HEAD_DIM), cos_b, sin_b)
            x = x + swa_sink_attention(q, k_sh, v_sh, b_sinks[i]) @ b_w_o[i]
        x = x + 0.5 * swiglu(rms_norm(x, ffn_norm[layer, 1]), ffn_w_in[layer, 1], ffn_w_out[layer, 1])
    return rms_norm(x, final_norm)
```

```cpp
#include <hip/hip_runtime.h>
#include <cstdio>
#include <cstdint>
#include <cmath>
namespace pg8 {
#define PG8_LAS __attribute__((address_space(3)))
typedef unsigned short bf16_t;
typedef short bf16x8 __attribute__((ext_vector_type(8)));
typedef float f32x4 __attribute__((ext_vector_type(4)));
typedef unsigned u32x4 __attribute__((ext_vector_type(4)));
constexpr int BM = 256, BK = 64, HALF = 128, HTB = HALF * BK * 2  , STAGE_BYTES = 8 * HTB, NXCD = 8, WGM = 8;

__host__ __device__ __forceinline__ int lds_byte(int r, int c) { const int st = (r >> 4) * 2 + (c >> 5), rr = r & 15, cc = c & 31, ob = rr * 64 + cc * 2; return st * 1024 + (ob ^ (((ob >> 9) & 1) << 5)); }
__host__ __device__ __forceinline__ void stage_rc(int b, int& R, int& C) { const int st = b / 1024, sb = b % 1024, swz = sb ^ (((sb >> 9) & 1) << 5); R = (st >> 1) * 16 + swz / 64; C = (st & 1) * 32 + (swz % 64) / 2; }
__host__ __device__ __forceinline__ int perm32(int rho) { const int n = rho >> 4, i = rho & 15; return 8 * (i >> 2) + 4 * n + (i & 3); }

__host__ __device__ __forceinline__ size_t tiled_off(int r, int k, int K) { return (size_t)(r >> 8) * ((size_t)BM * K) + (size_t)(k >> 6) * (BM * BK) + (size_t)(r & 255) * BK + (k & 63); }
typedef int i32x4 __attribute__((ext_vector_type(4)));
template <bool I8> struct AccType { typedef f32x4 type; };
template <> struct AccType<true> { typedef i32x4 type; };
__device__ __forceinline__ f32x4 mma16(bf16x8 a, bf16x8 b, f32x4 c) { return __builtin_amdgcn_mfma_f32_16x16x32_bf16(a, b, c, 0, 0, 0); }
__device__ __forceinline__ i32x4 mma16(bf16x8 a, bf16x8 b, i32x4 c) { return __builtin_amdgcn_mfma_i32_16x16x64_i8(__builtin_bit_cast(i32x4, a), __builtin_bit_cast(i32x4, b), c, 0, 0, 0); }
struct Unit { int pm, pn; };
struct Gemm { const bf16_t* A; const bf16_t* Bt; int M, N, K; };

struct StaticOrder {
    int nM, nN, nwg, G, c, wgm, i0, i1;
    __host__ __device__ void init(int M, int N, int G_, int c_, int wgm_ = WGM, int i0_ = 0, int i1_ = 1 << 20) { nM = M / BM; nN = N / BM; nwg = nM * nN; G = G_; c = c_; wgm = wgm_; i0 = i0_; i1 = i1_; }
    __host__ __device__ void decode(long L, Unit& u) const {
        int wgid = (int)L; { const int q = nwg / NXCD, r = nwg % NXCD, xcd = wgid % NXCD, off = wgid / NXCD; wgid = (xcd < r ? xcd * (q + 1) : r * (q + 1) + (xcd - r) * q) + off; }
        const int nig = wgm * nN, gid = wgid / nig, fm = gid * wgm, gsz = (nM - fm) < wgm ? (nM - fm) : wgm;
        u.pm = fm + ((wgid % nig) % gsz); u.pn = (wgid % nig) / gsz;
    }
    __host__ __device__ bool next(int i, Unit& u) const {
        if (i + i0 >= i1) return false;
        const long L = (long)(i + i0) * G + c; if (L >= nwg) return false;
        decode(L, u); return true;
    }
    __device__ __forceinline__ void a_ready(const Unit&) const {}
    __device__ __forceinline__ void done(const Unit&) const {}
};
struct ClaimOrder : StaticOrder {
    int nfull, nleft; unsigned* ctr; volatile PG8_LAS unsigned* slot;
    __device__ void setup(unsigned* ctr_, volatile PG8_LAS unsigned* slot_) { nfull = nwg / G; nleft = nwg - nfull * G; ctr = ctr_; slot = slot_; }
    __device__ __forceinline__ bool next(int i, Unit& u) const {
        if (i < nfull) { decode((long)i * G + c, u); return true; }
        if (i > nfull || nleft == 0) return false;
        if (threadIdx.x == 0) { const unsigned id = __hip_atomic_fetch_add(ctr, 1u, __ATOMIC_RELAXED, __HIP_MEMORY_SCOPE_AGENT); *slot = id; }
        asm volatile("s_waitcnt lgkmcnt(0)" ::: "memory"); __builtin_amdgcn_s_barrier(); asm volatile("" ::: "memory");
        const unsigned id = *slot;
        if (id >= (unsigned)nleft) return false;
        decode((long)nfull * G + id, u); return true;
    }
};
__device__ __forceinline__ unsigned cvt_pk_bf16(float lo, float hi) { unsigned r; asm volatile("v_cvt_pk_bf16_f32 %0, %1, %2" : "=v"(r) : "v"(lo), "v"(hi)); return r; }
__device__ __forceinline__ float silu_mul(float g, float u) { return g * u * __builtin_amdgcn_rcpf(1.0f + __builtin_amdgcn_exp2f(g * -1.4426950408889634f)); }
#ifndef ACT_DROP
#define ACT_DROP 0
#endif
struct EpiSwiGLU {
    static constexpr bool PERM = true, AFTER_DRAIN = false;
    bf16_t* O; int ldc;
    __device__ __forceinline__ void operator()(const f32x4 (&acc)[2][2][4][2], const Unit& u, int wr, int wc, int fr, int fq) const {
        const int row0 = u.pm * BM + wr * 64 + fr, col0 = u.pn * HALF + wc * 32 + 8 * fq;
#pragma unroll
        for (int ai = 0; ai < 2; ++ai)
#pragma unroll
            for (int m = 0; m < 4; ++m) { bf16_t* p = O + tiled_off(row0 + ai * HALF + m * 16, col0, ldc);
                const f32x4 g0 = acc[ai][0][m][0], g1 = acc[ai][0][m][1], u0 = acc[ai][1][m][0], u1 = acc[ai][1][m][1];
                u32x4 w; w.x = cvt_pk_bf16(silu_mul(g0[0], u0[0]), silu_mul(g0[1], u0[1])); w.y = cvt_pk_bf16(silu_mul(g0[2], u0[2]), silu_mul(g0[3], u0[3]));
                w.z = cvt_pk_bf16(silu_mul(g1[0], u1[0]), silu_mul(g1[1], u1[1])); w.w = cvt_pk_bf16(silu_mul(g1[2], u1[2]), silu_mul(g1[3], u1[3]));
                if (ACT_DROP > 0) { constexpr unsigned add_ = ((1u << ACT_DROP) >> 1) * 0x00010001u, msk_ = ~(((1u << ACT_DROP) - 1u) * 0x00010001u);
                    w.x = (w.x + add_) & msk_; w.y = (w.y + add_) & msk_; w.z = (w.z + add_) & msk_; w.w = (w.w + add_) & msk_; }
                *(u32x4*)p = w; }
    }
};
struct EpiSwiGLU8 {
    static constexpr bool PERM = true, AFTER_DRAIN = false;
    bf16_t* O; int ldc; const float* sA; const float* colmax;
    __device__ __forceinline__ void operator()(const i32x4 (&acc)[2][2][4][2], const Unit& u, int wr, int wc, int fr, int fq) const {
        const int row0 = u.pm * BM + wr * 64 + fr, col0 = u.pn * HALF + wc * 32 + 8 * fq;
        const f32x4 sg0 = *(const f32x4*)(colmax + col0) * (1.0f / 127.0f), sg1 = *(const f32x4*)(colmax + col0 + 4) * (1.0f / 127.0f);
        const f32x4 su0 = *(const f32x4*)(colmax + ldc + col0) * (1.0f / 127.0f), su1 = *(const f32x4*)(colmax + ldc + col0 + 4) * (1.0f / 127.0f);
        float rs[2][4];
#pragma unroll
        for (int ai = 0; ai < 2; ++ai)
#pragma unroll
            for (int m = 0; m < 4; ++m) rs[ai][m] = sA[row0 + ai * HALF + m * 16];
#pragma unroll
        for (int ai = 0; ai < 2; ++ai)
#pragma unroll
            for (int m = 0; m < 4; ++m) { bf16_t* p = O + (size_t)(row0 + ai * HALF + m * 16) * ldc + col0; const float r = rs[ai][m];
                const f32x4 g0 = __builtin_convertvector(acc[ai][0][m][0], f32x4) * sg0 * r, g1 = __builtin_convertvector(acc[ai][0][m][1], f32x4) * sg1 * r;
                const f32x4 u0 = __builtin_convertvector(acc[ai][1][m][0], f32x4) * su0 * r, u1 = __builtin_convertvector(acc[ai][1][m][1], f32x4) * su1 * r;
                u32x4 w; w.x = cvt_pk_bf16(silu_mul(g0[0], u0[0]), silu_mul(g0[1], u0[1])); w.y = cvt_pk_bf16(silu_mul(g0[2], u0[2]), silu_mul(g0[3], u0[3]));
                w.z = cvt_pk_bf16(silu_mul(g1[0], u1[0]), silu_mul(g1[1], u1[1])); w.w = cvt_pk_bf16(silu_mul(g1[2], u1[2]), silu_mul(g1[3], u1[3]));
                *(u32x4*)p = w; }
    }
};
struct EpiResid {
    static constexpr bool PERM = false, AFTER_DRAIN = false;
    const float* base; float* out; int ldc; float alpha;
    __device__ __forceinline__ void operator()(const f32x4 (&acc)[2][2][4][2], const Unit& u, int wr, int wc, int fr, int fq) const {
        const int row0 = u.pm * BM + wr * 64 + fr, col0 = u.pn * BM + wc * 32 + 4 * fq;
#pragma unroll
        for (int ai = 0; ai < 2; ++ai)
#pragma unroll
            for (int m = 0; m < 4; ++m) { const size_t off = (size_t)(row0 + ai * HALF + m * 16) * ldc + col0;
#pragma unroll
                for (int bj = 0; bj < 2; ++bj)
#pragma unroll
                    for (int n = 0; n < 2; ++n) { const f32x4 b = *(const f32x4*)(base + off + bj * HALF + n * 16); *(f32x4*)(out + off + bj * HALF + n * 16) = b + acc[ai][bj][m][n] * alpha; }
                asm volatile("" ::: "memory"); }
    }
};
template <int DH> struct EpiRope {
    static constexpr bool PERM = true, AFTER_DRAIN = false;
    bf16_t *dq, *dk, *dv; int ldq, ldk, ldv, nq, nk; float qscale; const float *cosT, *sinT;
    __device__ __forceinline__ void operator()(const f32x4 (&acc)[2][2][4][2], const Unit& u, int wr, int wc, int fr, int fq) const {
        const int row0 = u.pm * BM + wr * 64 + fr;
        if (u.pn >= nq + nk) {
            const int col0 = (u.pn - nq - nk) * BM + wc * 32 + 8 * fq;
#pragma unroll
            for (int ai = 0; ai < 2; ++ai)
#pragma unroll
                for (int m = 0; m < 4; ++m) { bf16_t* p = dv + (size_t)(row0 + ai * HALF + m * 16) * ldv + col0;
#pragma unroll
                    for (int bj = 0; bj < 2; ++bj) { const f32x4 v0 = acc[ai][bj][m][0], v1 = acc[ai][bj][m][1];
                        u32x4 w; w.x = cvt_pk_bf16(v0[0], v0[1]); w.y = cvt_pk_bf16(v0[2], v0[3]); w.z = cvt_pk_bf16(v1[0], v1[1]); w.w = cvt_pk_bf16(v1[2], v1[3]);
                        *(u32x4*)(p + bj * HALF) = w; } }
            return;
        }
        const bool isq = u.pn < nq; bf16_t* dst = isq ? dq : dk; const int ld = isq ? ldq : ldk, pt = isq ? u.pn : u.pn - nq; const float sc = isq ? qscale : 1.0f;
        constexpr int HD2 = DH / 2, HPT = BM / DH;
        const int t = wc * 32 + 8 * fq, hl = t / HD2, i0 = t % HD2, col1 = (HPT * pt + hl) * DH + i0;
#pragma unroll
        for (int ai = 0; ai < 2; ++ai)
#pragma unroll
            for (int m = 0; m < 4; ++m) { const int row = row0 + ai * HALF + m * 16;
                const f32x4 c0 = *(const f32x4*)(cosT + (size_t)row * HD2 + i0), c1 = *(const f32x4*)(cosT + (size_t)row * HD2 + i0 + 4);
                const f32x4 s0 = *(const f32x4*)(sinT + (size_t)row * HD2 + i0), s1 = *(const f32x4*)(sinT + (size_t)row * HD2 + i0 + 4);
                const f32x4 xa0 = acc[ai][0][m][0], xa1 = acc[ai][0][m][1], xb0 = acc[ai][1][m][0], xb1 = acc[ai][1][m][1];
                const f32x4 o10 = (xa0 * c0 - xb0 * s0) * sc, o11 = (xa1 * c1 - xb1 * s1) * sc, o20 = (xb0 * c0 + xa0 * s0) * sc, o21 = (xb1 * c1 + xa1 * s1) * sc;
                bf16_t* p = dst + (size_t)row * ld + col1;
                u32x4 w; w.x = cvt_pk_bf16(o10[0], o10[1]); w.y = cvt_pk_bf16(o10[2], o10[3]); w.z = cvt_pk_bf16(o11[0], o11[1]); w.w = cvt_pk_bf16(o11[2], o11[3]);
                *(u32x4*)p = w;
                w.x = cvt_pk_bf16(o20[0], o20[1]); w.y = cvt_pk_bf16(o20[2], o20[3]); w.z = cvt_pk_bf16(o21[0], o21[1]); w.w = cvt_pk_bf16(o21[2], o21[3]);
                *(u32x4*)(p + HD2) = w;
                asm volatile("" ::: "memory"); }
    }
};
template <int DH> struct EpiRope8 {
    static constexpr bool PERM = true, AFTER_DRAIN = false;
    bf16_t *dq, *dk, *dv; int ldq, ldk, ldv, nq, nk; float qscale; const float *cosT, *sinT; const float* sA; const float* colmax;
    __device__ __forceinline__ void operator()(const i32x4 (&acc)[2][2][4][2], const Unit& u, int wr, int wc, int fr, int fq) const {
        const int row0 = u.pm * BM + wr * 64 + fr;
        float rs[2][4];
#pragma unroll
        for (int ai = 0; ai < 2; ++ai)
#pragma unroll
            for (int m = 0; m < 4; ++m) rs[ai][m] = sA[row0 + ai * HALF + m * 16];
        if (u.pn >= nq + nk) {
            const int col0 = (u.pn - nq - nk) * BM + wc * 32 + 8 * fq, src0 = u.pn * BM + wc * 32 + 8 * fq;
            f32x4 sc[2][2];
#pragma unroll
            for (int bj = 0; bj < 2; ++bj) { sc[bj][0] = *(const f32x4*)(colmax + src0 + bj * HALF) * (1.0f / 127.0f); sc[bj][1] = *(const f32x4*)(colmax + src0 + bj * HALF + 4) * (1.0f / 127.0f); }
#pragma unroll
            for (int ai = 0; ai < 2; ++ai)
#pragma unroll
                for (int m = 0; m < 4; ++m) { bf16_t* p = dv + (size_t)(row0 + ai * HALF + m * 16) * ldv + col0; const float r = rs[ai][m];
#pragma unroll
                    for (int bj = 0; bj < 2; ++bj) { const f32x4 v0 = __builtin_convertvector(acc[ai][bj][m][0], f32x4) * sc[bj][0] * r, v1 = __builtin_convertvector(acc[ai][bj][m][1], f32x4) * sc[bj][1] * r;
                        u32x4 w; w.x = cvt_pk_bf16(v0[0], v0[1]); w.y = cvt_pk_bf16(v0[2], v0[3]); w.z = cvt_pk_bf16(v1[0], v1[1]); w.w = cvt_pk_bf16(v1[2], v1[3]);
                        *(u32x4*)(p + bj * HALF) = w; } }
            return;
        }
        const bool isq = u.pn < nq; bf16_t* dst = isq ? dq : dk; const int ld = isq ? ldq : ldk, pt = isq ? u.pn : u.pn - nq; const float scq = isq ? qscale : 1.0f;
        constexpr int HD2 = DH / 2, HPT = BM / DH;
        const int t = wc * 32 + 8 * fq, hl = t / HD2, i0 = t % HD2, col1 = (HPT * pt + hl) * DH + i0, src1 = (HPT * u.pn + hl) * DH + i0;
        const f32x4 sa0 = *(const f32x4*)(colmax + src1) * (1.0f / 127.0f), sa1 = *(const f32x4*)(colmax + src1 + 4) * (1.0f / 127.0f);
        const f32x4 sb0 = *(const f32x4*)(colmax + src1 + HD2) * (1.0f / 127.0f), sb1 = *(const f32x4*)(colmax + src1 + HD2 + 4) * (1.0f / 127.0f);
#pragma unroll
        for (int ai = 0; ai < 2; ++ai)
#pragma unroll
            for (int m = 0; m < 4; ++m) { const int row = row0 + ai * HALF + m * 16; const float r = rs[ai][m];
                const f32x4 c0 = *(const f32x4*)(cosT + (size_t)row * HD2 + i0), c1 = *(const f32x4*)(cosT + (size_t)row * HD2 + i0 + 4);
                const f32x4 s0 = *(const f32x4*)(sinT + (size_t)row * HD2 + i0), s1 = *(const f32x4*)(sinT + (size_t)row * HD2 + i0 + 4);
                const f32x4 xa0 = __builtin_convertvector(acc[ai][0][m][0], f32x4) * sa0 * r, xa1 = __builtin_convertvector(acc[ai][0][m][1], f32x4) * sa1 * r;
                const f32x4 xb0 = __builtin_convertvector(acc[ai][1][m][0], f32x4) * sb0 * r, xb1 = __builtin_convertvector(acc[ai][1][m][1], f32x4) * sb1 * r;
                const f32x4 o10 = (xa0 * c0 - xb0 * s0) * scq, o11 = (xa1 * c1 - xb1 * s1) * scq, o20 = (xb0 * c0 + xa0 * s0) * scq, o21 = (xb1 * c1 + xa1 * s1) * scq;
                bf16_t* p = dst + (size_t)row * ld + col1;
                u32x4 w; w.x = cvt_pk_bf16(o10[0], o10[1]); w.y = cvt_pk_bf16(o10[2], o10[3]); w.z = cvt_pk_bf16(o11[0], o11[1]); w.w = cvt_pk_bf16(o11[2], o11[3]);
                *(u32x4*)p = w;
                w.x = cvt_pk_bf16(o20[0], o20[1]); w.y = cvt_pk_bf16(o20[2], o20[3]); w.z = cvt_pk_bf16(o21[0], o21[1]); w.w = cvt_pk_bf16(o21[2], o21[3]);
                *(u32x4*)(p + HD2) = w;
                asm volatile("" ::: "memory"); }
    }
};
struct EpiResid8 {
    static constexpr bool PERM = false, AFTER_DRAIN = false;
    const float* base; float* out; int ldc; float alpha; const float* sA; const float* colmax;
    __device__ __forceinline__ void operator()(const i32x4 (&acc)[2][2][4][2], const Unit& u, int wr, int wc, int fr, int fq) const {
        const int row0 = u.pm * BM + wr * 64 + fr, col0 = u.pn * BM + wc * 32 + 4 * fq;
        f32x4 sc[2][2];
#pragma unroll
        for (int bj = 0; bj < 2; ++bj)
#pragma unroll
            for (int n = 0; n < 2; ++n) sc[bj][n] = *(const f32x4*)(colmax + col0 + bj * HALF + n * 16) * (alpha * (1.0f / 127.0f));
        float rs[2][4];
#pragma unroll
        for (int ai = 0; ai < 2; ++ai)
#pragma unroll
            for (int m = 0; m < 4; ++m) rs[ai][m] = sA[row0 + ai * HALF + m * 16];
#pragma unroll
        for (int ai = 0; ai < 2; ++ai)
#pragma unroll
            for (int m = 0; m < 4; ++m) { const size_t off = (size_t)(row0 + ai * HALF + m * 16) * ldc + col0; const float r = rs[ai][m];
#pragma unroll
                for (int bj = 0; bj < 2; ++bj)
#pragma unroll
                    for (int n = 0; n < 2; ++n) { const f32x4 b = *(const f32x4*)(base + off + bj * HALF + n * 16); *(f32x4*)(out + off + bj * HALF + n * 16) = b + __builtin_convertvector(acc[ai][bj][m][n], f32x4) * sc[bj][n] * r; }
                asm volatile("" ::: "memory"); }
    }
};
template <class Epi, class Sched, bool ALIGN_EPI = false, bool SP2 = false, bool TA = false, bool TB = false, bool I8 = false>
__device__ __forceinline__ void gemm_phase(PG8_LAS unsigned char* lds, const Gemm g, const Sched& S, const Epi& E) {
    const int tid = threadIdx.x, wid = __builtin_amdgcn_readfirstlane(tid >> 6), lane = tid & 63, wr = wid >> 2, wc = wid & 3, fr = lane & 15, fq = lane >> 4;
    const int KB = I8 ? g.K : 2 * g.K, nt = KB / (BK * 2);
    unsigned voffA[2], voffB[2];
#pragma unroll
    for (int i = 0; i < 2; ++i) { int R, C; stage_rc(tid * 16 + i * 8192, R, C); const int Rb = Epi::PERM ? ((R & ~31) + perm32(R & 31)) : R;
        voffA[i] = (unsigned)(R * (TA ? BK * 2 : KB) + C * 2); voffB[i] = (unsigned)(Rb * (TB ? BK * 2 : KB) + C * 2); }
    const size_t kstepA = TA ? (size_t)(BM * BK * 2) : (size_t)(BK * 2), kstepB = TB ? (size_t)(BM * BK * 2) : (size_t)(BK * 2);
    const size_t hstepA = TA ? (size_t)(HALF * BK * 2) : (size_t)HALF * KB, hstepB = TB ? (size_t)(HALF * BK * 2) : (size_t)HALF * KB;
    const size_t tstep = (size_t)BM * KB;
    const unsigned ldsw = (unsigned)wid * 1024u;
    const int aoff = lds_byte(wr * 64 + fr, fq * 8), boff = lds_byte(wc * 32 + fr, fq * 8);
#define PG8_SA(b, h) (((b) * 2 + (h)) * HTB)
#define PG8_SB(b, h) ((4 + (b) * 2 + (h)) * HTB)
#define PG8_STAGE(bufoff, gbase, voff) do { _Pragma("unroll") for (int _i = 0; _i < 2; ++_i) \
        __builtin_amdgcn_global_load_lds((const unsigned*)((const char*)(gbase) + (voff)[_i]), (PG8_LAS unsigned*)(lds + (bufoff) + ldsw + _i * 8192), 16, 0, 0); } while (0)
#define PG8_LDA(dst, b, h) do { _Pragma("unroll") for (int m = 0; m < 4; ++m) _Pragma("unroll") for (int k = 0; k < 2; ++k) dst[m][k] = *(const PG8_LAS bf16x8*)(lds + PG8_SA(b, h) + aoff + m * 2048 + k * 1024); } while (0)
#define PG8_LDB(dst, b, h) do { _Pragma("unroll") for (int n = 0; n < 2; ++n) _Pragma("unroll") for (int k = 0; k < 2; ++k) dst[n][k] = *(const PG8_LAS bf16x8*)(lds + PG8_SB(b, h) + boff + n * 2048 + k * 1024); } while (0)
#define PG8_MMA(ai, bj, At, Bt) do { __builtin_amdgcn_s_setprio(1); _Pragma("unroll") for (int m = 0; m < 4; ++m) _Pragma("unroll") for (int n = 0; n < 2; ++n) _Pragma("unroll") for (int k = 0; k < 2; ++k) \
        acc[ai][bj][m][n] = mma16(Bt[n][k], At[m][k], acc[ai][bj][m][n]); __builtin_amdgcn_s_setprio(0); } while (0)
#define PG8_WAIT_V(n) asm volatile("s_waitcnt vmcnt(" #n ")" ::: "memory")
#define PG8_WAIT_L(n) asm volatile("s_waitcnt lgkmcnt(" #n ")" ::: "memory")
#define PG8_BAR __builtin_amdgcn_s_barrier()
#define PG8_SCHED __builtin_amdgcn_sched_barrier(0)
    Unit cur, nxt; int ui = 0;
    if (!S.next(0, cur)) return;
    typedef typename AccType<I8>::type accv;
    accv acc[2][2][4][2];
#pragma unroll
    for (int a = 0; a < 2; ++a)
#pragma unroll
        for (int b = 0; b < 2; ++b)
#pragma unroll
            for (int m = 0; m < 4; ++m)
#pragma unroll
                for (int n = 0; n < 2; ++n) acc[a][b][m][n] = (accv){0, 0, 0, 0};
    bf16x8 At[4][2], B0[2][2], B1[2][2];
    const char* cA = (const char*)g.A + (size_t)cur.pm * tstep; const char* cB = (const char*)g.Bt + (size_t)cur.pn * tstep;
    S.a_ready(cur);
    if constexpr (SP2) {
        PG8_STAGE(PG8_SB(0, 0), cB, voffB); PG8_STAGE(PG8_SB(0, 1), cB + hstepB, voffB); PG8_STAGE(PG8_SA(0, 0), cA, voffA); PG8_STAGE(PG8_SA(0, 1), cA + hstepA, voffA);
        if (wr == 1) PG8_BAR;
        PG8_WAIT_V(2); PG8_BAR;
        PG8_STAGE(PG8_SB(1, 0), cB + kstepB, voffB); PG8_STAGE(PG8_SA(1, 0), cA + kstepA, voffA); PG8_STAGE(PG8_SB(1, 1), cB + hstepB + kstepB, voffB);
        PG8_WAIT_V(6); PG8_BAR;
    } else {
        PG8_STAGE(PG8_SB(0, 0), cB, voffB); PG8_STAGE(PG8_SA(0, 0), cA, voffA); PG8_STAGE(PG8_SB(0, 1), cB + hstepB, voffB); PG8_STAGE(PG8_SA(0, 1), cA + hstepA, voffA);
        if (wr == 1) PG8_BAR;
        PG8_WAIT_V(4); PG8_BAR;
        PG8_STAGE(PG8_SB(1, 0), cB + kstepB, voffB); PG8_STAGE(PG8_SA(1, 0), cA + kstepA, voffA); PG8_STAGE(PG8_SB(1, 1), cB + hstepB + kstepB, voffB);
        PG8_WAIT_V(6); PG8_BAR;
    }
    for (;;) {
        const bool has_next = S.next(ui + 1, nxt);
        const char* nA = has_next ? (const char*)g.A + (size_t)nxt.pm * tstep : cA; const char* nB = has_next ? (const char*)g.Bt + (size_t)nxt.pn * tstep : cB;
        for (int t = 0; t < nt; t += 2) {
            const bool last = (t == nt - 2);
            const char* a1 = cA + (size_t)(t + 1) * kstepA;
            const char* a2 = last ? nA : cA + (size_t)(t + 2) * kstepA; const char* b2 = last ? nB : cB + (size_t)(t + 2) * kstepB;
            const char* a3 = a2 + kstepA; const char* b3 = b2 + kstepB;
            if (last && has_next) S.a_ready(nxt);
            if constexpr (SP2) {
            PG8_LDB(B0, 0, 0); PG8_LDB(B1, 0, 1); PG8_SCHED; PG8_LDA(At, 0, 0); PG8_STAGE(PG8_SA(1, 1), a1 + hstepA, voffA);
            PG8_WAIT_V(8); PG8_WAIT_L(0); PG8_BAR; PG8_MMA(0, 0, At, B0); PG8_MMA(0, 1, At, B1); PG8_BAR; PG8_SCHED;
            PG8_LDA(At, 0, 1); PG8_STAGE(PG8_SB(0, 0), b2, voffB); PG8_STAGE(PG8_SB(0, 1), b2 + hstepB, voffB); PG8_STAGE(PG8_SA(0, 0), a2, voffA);
            PG8_WAIT_V(8); PG8_WAIT_L(0); PG8_BAR; PG8_MMA(1, 0, At, B0); PG8_MMA(1, 1, At, B1); PG8_BAR; PG8_SCHED;
            PG8_LDB(B0, 1, 0); PG8_LDB(B1, 1, 1); PG8_SCHED; PG8_LDA(At, 1, 0); PG8_STAGE(PG8_SA(0, 1), a2 + hstepA, voffA);
            PG8_WAIT_V(8); PG8_WAIT_L(0); PG8_BAR; PG8_MMA(0, 0, At, B0); PG8_MMA(0, 1, At, B1); PG8_BAR; PG8_SCHED;
            PG8_LDA(At, 1, 1); PG8_STAGE(PG8_SB(1, 0), b3, voffB); PG8_STAGE(PG8_SB(1, 1), b3 + hstepB, voffB); PG8_STAGE(PG8_SA(1, 0), a3, voffA);
            PG8_WAIT_V(8); PG8_WAIT_L(0); PG8_BAR; PG8_MMA(1, 0, At, B0); PG8_MMA(1, 1, At, B1); PG8_BAR; PG8_SCHED;
            } else {
            PG8_LDB(B0, 0, 0); PG8_SCHED; PG8_LDA(At, 0, 0); PG8_STAGE(PG8_SA(1, 1), a1 + hstepA, voffA);
            PG8_WAIT_L(8); PG8_BAR; PG8_WAIT_L(0); PG8_MMA(0, 0, At, B0); PG8_BAR; PG8_SCHED;
            PG8_LDB(B1, 0, 1); PG8_STAGE(PG8_SB(0, 0), b2, voffB);
            PG8_BAR; PG8_WAIT_L(0); PG8_MMA(0, 1, At, B1); PG8_BAR;
            PG8_LDA(At, 0, 1); PG8_STAGE(PG8_SA(0, 0), a2, voffA);
            PG8_BAR; PG8_WAIT_L(0); PG8_MMA(1, 0, At, B0); PG8_BAR; PG8_SCHED;
            PG8_STAGE(PG8_SB(0, 1), b2 + hstepB, voffB);
            PG8_WAIT_V(6); PG8_BAR; PG8_MMA(1, 1, At, B1); PG8_BAR;
            PG8_LDB(B0, 1, 0); PG8_SCHED; PG8_LDA(At, 1, 0); PG8_STAGE(PG8_SA(0, 1), a2 + hstepA, voffA);
            PG8_WAIT_L(8); PG8_BAR; PG8_WAIT_L(0); PG8_MMA(0, 0, At, B0); PG8_BAR; PG8_SCHED;
            PG8_LDB(B1, 1, 1); PG8_STAGE(PG8_SB(1, 0), b3, voffB);
            PG8_BAR; PG8_WAIT_L(0); PG8_MMA(0, 1, At, B1); PG8_BAR;
            PG8_LDA(At, 1, 1); PG8_STAGE(PG8_SA(1, 0), a3, voffA);
            PG8_BAR; PG8_WAIT_L(0); PG8_MMA(1, 0, At, B0); PG8_BAR; PG8_SCHED;
            PG8_STAGE(PG8_SB(1, 1), b3 + hstepB, voffB);
            PG8_WAIT_V(6); PG8_BAR; PG8_MMA(1, 1, At, B1); PG8_BAR;
            }
        }
        if constexpr (ALIGN_EPI) { if (wr == 0) PG8_BAR; }
        if constexpr (!Epi::AFTER_DRAIN) { E(acc, cur, wr, wc, fr, fq); S.done(cur); }
        if (!has_next) break;
#pragma unroll
        for (int a = 0; a < 2; ++a)
#pragma unroll
            for (int b = 0; b < 2; ++b)
#pragma unroll
                for (int m = 0; m < 4; ++m)
#pragma unroll
                    for (int n = 0; n < 2; ++n) acc[a][b][m][n] = (accv){0, 0, 0, 0};
        cur = nxt; cA = nA; cB = nB; ++ui;
        if constexpr (ALIGN_EPI) { if (wr == 1) PG8_BAR; }
    }
    PG8_WAIT_V(0);
    if constexpr (!ALIGN_EPI) { if (wr == 0) PG8_BAR; }
    PG8_BAR;
    if constexpr (Epi::AFTER_DRAIN) { E.fused(acc, cur, wr, wc, fr, fq, lds, wid, lane); S.done(cur); }
#undef PG8_SA
#undef PG8_SB
#undef PG8_STAGE
#undef PG8_LDA
#undef PG8_LDB
#undef PG8_MMA
#undef PG8_WAIT_V
#undef PG8_WAIT_L
#undef PG8_BAR
#undef PG8_SCHED
}
}
constexpr int NWAVES = 8;
#ifndef MK_SPLIT
#define MK_SPLIT 0
#endif
#ifndef PG8_SP2
#define PG8_SP2 true
#endif
#ifndef PG8_ALIGN
#define PG8_ALIGN true
#endif
#ifndef XN_TILED
#define XN_TILED false
#endif
constexpr int N_PHASES = 31;

constexpr int SEQ = 16384, DM = 4096, DFF = 11008, M = SEQ;
constexpr int A_H = 32, A_D = 128, A_KVW = 1024, NQKV = 6144;
constexpr int B_H = 64, B_D = 64, B_KVW = 512;
constexpr int NBLK = 64;
constexpr float RMS_EPS = 1e-6f;
constexpr float LOG2E = 1.4426950408889634f;

constexpr size_t MiB = 1u << 20;
constexpr size_t WS_CTL = 0, CTL_ZERO_BYTES = 1 * MiB;
constexpr size_t SZ_WIN = 172 * MiB, SZ_WOUT = 86 * MiB;
constexpr size_t WS_WIN = 1 * MiB;
constexpr size_t WS_WOUT = WS_WIN + 4 * SZ_WIN;
constexpr size_t WS_WQKV = WS_WOUT + 4 * SZ_WOUT;
constexpr size_t WS_WAO = WS_WQKV + 48 * MiB;
constexpr size_t WS_WKV = WS_WAO + 32 * MiB;
constexpr size_t WS_WBQ = WS_WKV + 8 * MiB;
constexpr size_t WS_WBO = WS_WBQ + 32 * MiB;
constexpr size_t WS_XN = WS_WBO + 32 * MiB;
constexpr size_t WS_ACT = WS_XN + 128 * MiB;
constexpr size_t WS_Q = WS_ACT + 344 * MiB;
constexpr size_t WS_K = WS_Q + 128 * MiB;
constexpr size_t WS_V = WS_K + 32 * MiB;
constexpr size_t WS_O = WS_V + 32 * MiB;
constexpr size_t WS_KSH = WS_O + 128 * MiB;
constexpr size_t WS_VSH = WS_KSH + 16 * MiB;
constexpr size_t WS_ROPEA = WS_VSH + 16 * MiB;
constexpr size_t WS_ROPEB = WS_ROPEA + 8 * MiB;
constexpr size_t WS_KMEAN = WS_ROPEB + 4 * MiB;
constexpr size_t WS_LIST = WS_KMEAN + 1 * MiB;
constexpr size_t WS_PARTO = WS_LIST + 63 * MiB;
constexpr size_t WS_PARTML = WS_PARTO + 512 * MiB;
constexpr size_t WS_XN8 = WS_PARTML + 16 * MiB;
constexpr size_t WS_SA = WS_XN8 + 64 * MiB;
constexpr size_t WS_ACT8 = WS_SA + 1 * MiB;
constexpr size_t WS_SACT = WS_ACT8 + 172 * MiB;
constexpr size_t WS_END = WS_SACT + 1 * MiB;
static_assert(SZ_WIN == (size_t)22016 * 4096 * 2 && SZ_WOUT == (size_t)4096 * 11008 * 2, "weight sizes");
constexpr int CW_TMO = 0, CW_CODE = 1;
constexpr int CW_BAR = 4096;
constexpr int CW_CLAIM = 12288;
constexpr int CW_COLMAX = 32768;
constexpr int CW_CNT = 8192;

constexpr int RING_OFF = 0, RING_BYTES = 131072;
constexpr int LDSCTL_OFF = 146944, MISC_OFF = LDSCTL_OFF + 256;
constexpr int LDS_BYTES = 147456;
static_assert(MISC_OFF + 128 <= 147456 && RING_BYTES <= LDSCTL_OFF, "LDS map");

#define GAS __attribute__((address_space(1)))
#define LAS __attribute__((address_space(3)))
#define DI __device__ __forceinline__
typedef unsigned short bf16;
typedef unsigned v4u __attribute__((ext_vector_type(4)));
typedef unsigned v2u __attribute__((ext_vector_type(2)));
typedef float f32x4 __attribute__((ext_vector_type(4)));
typedef float f32x16 __attribute__((ext_vector_type(16)));
typedef short bf16x8 __attribute__((ext_vector_type(8)));
typedef short s16x4 __attribute__((ext_vector_type(4)));
typedef GAS unsigned gu32;
#define RLX_AGENT __ATOMIC_RELAXED, __HIP_MEMORY_SCOPE_AGENT
#define LDS_WAIT() asm volatile("s_waitcnt lgkmcnt(0)" ::: "memory")
#define VM_WAIT() asm volatile("s_waitcnt vmcnt(0)" ::: "memory")
DI unsigned f2bf(float f) { unsigned u = __builtin_bit_cast(unsigned, f); return (u + 0x7fffu + ((u >> 16) & 1u)) >> 16; }
DI unsigned pk2(float lo, float hi) { return f2bf(lo) | (f2bf(hi) << 16); }
DI float bf2f(unsigned b) { return __builtin_bit_cast(float, b << 16); }
#define XB_TMO      128
#define XB_XCNT(j)  (256  + 64 * (j))
#define XB_XSUB(j)  (1280 + 64 * (j))
#define XB_XGEN(j)  (2304 + 64 * (j))
#define XB_TOP      3328
#define XB_TOPGEN   3392
#define XCD_BAR_WORDS 3456
#define XB_SPIN_CAP (1u << 18)

__device__ __forceinline__ unsigned xb_ld(unsigned* p)              { return __hip_atomic_load(p, __ATOMIC_RELAXED, __HIP_MEMORY_SCOPE_AGENT); }
__device__ __forceinline__ unsigned xb_add(unsigned* p, unsigned v) { return __hip_atomic_fetch_add(p, v, __ATOMIC_RELAXED, __HIP_MEMORY_SCOPE_AGENT); }
__device__ __forceinline__ unsigned xb_xcc_id() { return (unsigned)__builtin_amdgcn_s_getreg((3 << 11) | 20) & 0xFu; }
#define XB_SPIN(cond, bar) do { unsigned _sp = 0; while (cond) { __builtin_amdgcn_s_sleep(1); \
    if ((++_sp & 255u) == 0u) { if (xb_ld(&(bar)[XB_TMO])) break; if (_sp > XB_SPIN_CAP) { atomicAdd(&(bar)[XB_TMO], 1u); break; } } } } while (0)

struct XcdBarrier {
    unsigned* bar; unsigned x;
    volatile LAS unsigned* st;
};

__device__ __forceinline__ XcdBarrier xcd_barrier_post(unsigned* bar, volatile LAS unsigned* st) {
    XcdBarrier b; b.bar = bar; b.x = xb_xcc_id(); b.st = st;
    if (threadIdx.x == 0) (void)xb_add(&bar[XB_XCNT(b.x)], 1u);
    return b;
}
__device__ __forceinline__ void xcd_barrier_complete(unsigned* bar, unsigned x, unsigned& nloc, unsigned& nx) {
    const unsigned G = gridDim.x * gridDim.y * gridDim.z;
    unsigned sum, cnt, mine, sp = 0u;
    for (;;) {
        sum = 0u; cnt = 0u; mine = 0u;
#pragma unroll
        for (unsigned j = 0; j < 16; ++j) { const unsigned c = xb_ld(&bar[XB_XCNT(j)]); sum += c; cnt += (c > 0u) ? 1u : 0u; mine = (j == x) ? c : mine; }
        if (sum == G) break;
        __builtin_amdgcn_s_sleep(1);
        if ((++sp & 255u) == 0u) { if (xb_ld(&bar[XB_TMO])) break; if (sp > XB_SPIN_CAP) { atomicAdd(&bar[XB_TMO], 1u); break; } }
    }
    nloc = mine > 0u ? mine : 1u; nx = cnt > 0u ? cnt : 1u;
}

__device__ __forceinline__ void xcd_barrier(const XcdBarrier& b) {
    asm volatile("s_waitcnt vmcnt(0)" ::: "memory");
    __syncthreads();
    if (threadIdx.x == 0) {
        unsigned* bar = b.bar;
        __builtin_amdgcn_s_waitcnt(0);
        unsigned nloc = b.st[0], nx = b.st[1];
        if (nloc == 0u) { xcd_barrier_complete(bar, b.x, nloc, nx); b.st[0] = nloc; b.st[1] = nx; }
        const unsigned old = xb_add(&bar[XB_XSUB(b.x)], 1u);
        const unsigned gen = old / nloc;
        if (old + 1u == (gen + 1u) * nloc) {
            __builtin_amdgcn_fence(__ATOMIC_RELEASE, "agent");
            asm volatile("s_waitcnt vmcnt(0)" ::: "memory");
            const unsigned og = xb_add(&bar[XB_TOP], 1u);
            const unsigned tg = og / nx;
            if (og + 1u == (tg + 1u) * nx) xb_add(&bar[XB_TOPGEN], 1u);
            else XB_SPIN(xb_ld(&bar[XB_TOPGEN]) == tg, bar);
            __builtin_amdgcn_fence(__ATOMIC_ACQUIRE, "agent");
            xb_add(&bar[XB_XGEN(b.x)], 1u);
            asm volatile("s_waitcnt vmcnt(0)" ::: "memory");
        } else {
            XB_SPIN(xb_ld(&bar[XB_XGEN(b.x)]) == gen, bar);
            __builtin_amdgcn_fence(__ATOMIC_ACQUIRE, "agent");
            asm volatile("s_waitcnt vmcnt(0)" ::: "memory");
        }
    }
    __syncthreads();
}
struct Frame {
    LAS unsigned char* lds;
    volatile LAS unsigned* MISC;
    gu32* ctl;
    int tid, lane, wave;
    int vcu, G;
    unsigned char* ws;
    const float* x; const float* ffn_norm; const float* ffn_w_in; const float* ffn_w_out; const float* attn_norm; const float* a_w_qkv; const float* a_w_o;
    const float* kv_norm; const float* w_kv; const float* b_w_q; const float* b_sinks; const float* b_w_o; const float* final_norm;
    float* out;
};
DI float wave_sum(float v) {
#pragma unroll
    for (int o = 1; o < 64; o <<= 1) v += __shfl_xor(v, o);
    return v;
}
__device__ const float ROPE_INV[64] = {
1.000000000e+00f, 8.659643531e-01f, 7.498942018e-01f, 6.493816376e-01f, 5.623413324e-01f, 4.869675338e-01f, 4.216965139e-01f, 3.651741147e-01f, 3.162277639e-01f, 2.738419771e-01f, 2.371373922e-01f, 2.053525001e-01f, 1.778279394e-01f, 1.539926529e-01f, 1.333521456e-01f, 1.154782027e-01f,
1.000000015e-01f, 8.659642935e-02f, 7.498941571e-02f, 6.493816525e-02f, 5.623412877e-02f, 4.869675264e-02f, 4.216964915e-02f, 3.651741147e-02f, 3.162277862e-02f, 2.738419734e-02f, 2.371373586e-02f, 2.053524926e-02f, 1.778279431e-02f, 1.539926510e-02f, 1.333521493e-02f, 1.154781971e-02f,
9.999999776e-03f, 8.659643121e-03f, 7.498942316e-03f, 6.493816618e-03f, 5.623413250e-03f, 4.869675264e-03f, 4.216964822e-03f, 3.651741426e-03f, 3.162277862e-03f, 2.738419687e-03f, 2.371373819e-03f, 2.053525066e-03f, 1.778279431e-03f, 1.539926627e-03f, 1.333521446e-03f, 1.154781901e-03f,
1.000000047e-03f, 8.659643354e-04f, 7.498941850e-04f, 6.493816618e-04f, 5.623413017e-04f, 4.869675031e-04f, 4.216965463e-04f, 3.651741135e-04f, 3.162277862e-04f, 2.738419571e-04f, 2.371373848e-04f, 2.053525241e-04f, 1.778279402e-04f, 1.539926452e-04f, 1.333521504e-04f, 1.154782076e-04f };

template <int DROP> DI unsigned f2bf_drop(float f) { unsigned u = __builtin_bit_cast(unsigned, f); constexpr int sh = 16 + DROP; u += ((1u << (sh - 1)) - 1u) + ((u >> sh) & 1u); return ((u >> sh) << DROP) & 0xffffu; }

DI int map_col(int mode, int lim, int c) {
    const int pn = c >> 8, bj = (c >> 7) & 1, t = c & 127;
    if (mode == 1) return bj * DFF + 128 * pn + t;
    if (mode == 2 && c < lim) return (2 * pn + (t >> 6)) * 128 + 64 * bj + (t & 63);
    if (mode == 3 && c < lim) return (4 * pn + (t >> 5)) * 64 + 32 * bj + (t & 31);
    return c;
}
template <bool TILED, int DROP = 0> DI void tr_item(const float* __restrict__ src, const float* __restrict__ gain, bf16* __restrict__ dst, int K, int N, int ld, int mode, int lim, LAS float* scr, int item, int lane) {
    const int nblk = N >> 5, kb = item / nblk, nb = item - kb * nblk, k0 = kb << 6, n0 = nb << 5, s0 = map_col(mode, lim, n0);
    const int kr = lane >> 3, c4 = lane & 7;
    f32x4 v[8]; float g[8];
#pragma unroll
    for (int it = 0; it < 8; ++it) { v[it] = *(const GAS f32x4*)(src + (size_t)(k0 + 8 * it + kr) * ld + s0 + 4 * c4); g[it] = gain ? gain[k0 + 8 * it + kr] : 1.0f; }
#pragma unroll
    for (int it = 0; it < 8; ++it) { LAS float* p = scr + (8 * it + kr) * 33 + 4 * c4; p[0] = v[it].x * g[it]; p[1] = v[it].y * g[it]; p[2] = v[it].z * g[it]; p[3] = v[it].w * g[it]; }
    LDS_WAIT(); asm volatile("" ::: "memory");
#pragma unroll
    for (int j = 0; j < 4; ++j) { const int n = kr + 8 * j; const LAS float* s = scr + (8 * c4) * 33 + n;
#define PKW(a_, b_) (DROP > 0 ? (f2bf_drop<DROP>(a_) | (f2bf_drop<DROP>(b_) << 16)) : pk2(a_, b_))
        v4u o; o.x = PKW(s[0 * 33], s[1 * 33]); o.y = PKW(s[2 * 33], s[3 * 33]); o.z = PKW(s[4 * 33], s[5 * 33]); o.w = PKW(s[6 * 33], s[7 * 33]);
#undef PKW
        *(GAS v4u*)(dst + (TILED ? pg8::tiled_off(n0 + n, k0 + 8 * c4, K) : (size_t)(n0 + n) * K + k0 + 8 * c4)) = o; }
    LDS_WAIT(); asm volatile("" ::: "memory");
}
DI void sincos_acc(float angf, float& s, float& c) {
    const double x = (double)angf, q = __builtin_rint(x * 0.63661977236758134308);
    double r = __builtin_fma(-q, 1.57079632679489655800e+00, x); r = __builtin_fma(-q, 6.12323399573676603587e-17, r);
    const int qi = (int)q & 3; const double r2 = r * r;
    const double sp = r + r * r2 * (-1.0 / 6 + r2 * (1.0 / 120 + r2 * (-1.0 / 5040 + r2 * (1.0 / 362880 + r2 * (-1.0 / 39916800 + r2 * (1.0 / 6227020800.0))))));
    const double cp = 1.0 + r2 * (-0.5 + r2 * (1.0 / 24 + r2 * (-1.0 / 720 + r2 * (1.0 / 40320 + r2 * (-1.0 / 3628800 + r2 * (1.0 / 479001600 + r2 * (-1.0 / 87178291200.0)))))));
    const double ss = (qi & 1) ? cp : sp, cc = (qi & 1) ? sp : cp;
    s = (float)((qi & 2) ? -ss : ss); c = (float)(((qi + 1) & 2) ? -cc : cc);
}
DI void rope_tables(Frame& F) {
    const int gt = (F.vcu * NWAVES + F.wave) * 64 + F.lane, NT = F.G * NWAVES * 64;
    float* ca = (float*)(F.ws + WS_ROPEA); float* sa = ca + (size_t)M * 64; float* cb = (float*)(F.ws + WS_ROPEB); float* sb = cb + (size_t)M * 32;
    for (int e = gt; e < M * 64; e += NT) { const int pos = e >> 6, i = e & 63; float s, c; sincos_acc((float)pos * ROPE_INV[i], s, c); ca[e] = c; sa[e] = s; }
    for (int e = gt; e < M * 32; e += NT) { const int pos = e >> 5, i = e & 31; float s, c; sincos_acc((float)pos * ROPE_INV[2 * i], s, c); cb[e] = c; sb[e] = s; }
}
template <int DROP = 0> DI void norm_rows(Frame& F, const float* x, bf16* xn) {
    const int gw = F.vcu * NWAVES + F.wave, NGW = F.G * NWAVES;
    for (int m = gw; m < M; m += NGW) {
        const GAS f32x4* xr = (const GAS f32x4*)(x + (size_t)m * DM) + F.lane;
        f32x4 v[16]; float s = 0.f;
#pragma unroll
        for (int j = 0; j < 16; ++j) { v[j] = xr[64 * j]; s += (v[j].x * v[j].x + v[j].y * v[j].y) + (v[j].z * v[j].z + v[j].w * v[j].w); }
        const float r = 1.0f / sqrtf(wave_sum(s) * (1.0f / DM) + RMS_EPS);
#pragma unroll
        for (int j = 0; j < 16; ++j) { v2u w; if (DROP > 0) { w.x = f2bf_drop<DROP>(v[j].x * r) | (f2bf_drop<DROP>(v[j].y * r) << 16); w.y = f2bf_drop<DROP>(v[j].z * r) | (f2bf_drop<DROP>(v[j].w * r) << 16); }
            else { w.x = pk2(v[j].x * r, v[j].y * r); w.y = pk2(v[j].z * r, v[j].w * r); } const int col = 256 * j + 4 * F.lane;
            *(GAS v2u*)(xn + (XN_TILED ? pg8::tiled_off(m, col, DM) : (size_t)m * DM + col)) = w; }
    }
}
DI void colmax_item(const float* __restrict__ src, const float* __restrict__ gain, unsigned* cm, int N, int item, int lane) {
    const int ncg = N >> 8, rb = item / ncg, cg = item - rb * ncg; const int c0 = cg * 256 + 4 * lane;
    f32x4 mx = {0.f, 0.f, 0.f, 0.f};
#pragma unroll 8
    for (int r = 0; r < 256; ++r) { const int k = rb * 256 + r; const f32x4 v = *(const GAS f32x4*)(src + (size_t)k * N + c0) * (gain ? gain[k] : 1.0f);
        mx.x = __builtin_fmaxf(mx.x, __builtin_fabsf(v.x)); mx.y = __builtin_fmaxf(mx.y, __builtin_fabsf(v.y)); mx.z = __builtin_fmaxf(mx.z, __builtin_fabsf(v.z)); mx.w = __builtin_fmaxf(mx.w, __builtin_fabsf(v.w)); }
    __hip_atomic_fetch_max(cm + c0 + 0, __builtin_bit_cast(unsigned, mx.x), RLX_AGENT); __hip_atomic_fetch_max(cm + c0 + 1, __builtin_bit_cast(unsigned, mx.y), RLX_AGENT);
    __hip_atomic_fetch_max(cm + c0 + 2, __builtin_bit_cast(unsigned, mx.z), RLX_AGENT); __hip_atomic_fetch_max(cm + c0 + 3, __builtin_bit_cast(unsigned, mx.w), RLX_AGENT);
}
DI unsigned q8x4(float a, float b, float c, float d, float inv) { unsigned w = 0u;
    w = __builtin_amdgcn_cvt_pk_u8_f32(__builtin_rintf(__builtin_fmaf(a, inv, 128.f)), 0, w); w = __builtin_amdgcn_cvt_pk_u8_f32(__builtin_rintf(__builtin_fmaf(b, inv, 128.f)), 1, w);
    w = __builtin_amdgcn_cvt_pk_u8_f32(__builtin_rintf(__builtin_fmaf(c, inv, 128.f)), 2, w); w = __builtin_amdgcn_cvt_pk_u8_f32(__builtin_rintf(__builtin_fmaf(d, inv, 128.f)), 3, w); return w ^ 0x80808080u; }
DI unsigned q8(float v) { const float r = __builtin_rintf(v); const int i = (int)__builtin_fminf(__builtin_fmaxf(r, -127.f), 127.f); return (unsigned)i & 0xffu; }
DI void tr_item8(const float* __restrict__ src, const float* __restrict__ gain, const float* __restrict__ cm, unsigned char* __restrict__ dst, int K, int N, int mode, int lim, int item, LAS float* scr, int lane) {
    const int nblk = N >> 5, kb = item / nblk, nb = item - kb * nblk, k0 = kb << 6, n0 = nb << 5, s0 = map_col(mode, lim, n0);
    const int kr = lane >> 3, c4 = lane & 7;
    f32x4 v[8]; float g[8];
#pragma unroll
    for (int it = 0; it < 8; ++it) { v[it] = *(const GAS f32x4*)(src + (size_t)(k0 + 8 * it + kr) * N + s0 + 4 * c4); g[it] = gain ? gain[k0 + 8 * it + kr] : 1.0f; }
#pragma unroll
    for (int it = 0; it < 8; ++it) { LAS float* p = scr + (8 * it + kr) * 33 + 4 * c4; p[0] = v[it].x * g[it]; p[1] = v[it].y * g[it]; p[2] = v[it].z * g[it]; p[3] = v[it].w * g[it]; }
    LDS_WAIT(); asm volatile("" ::: "memory");
#pragma unroll
    for (int j = 0; j < 4; ++j) { const int n = kr + 8 * j; const LAS float* s = scr + (8 * c4) * 33 + n;
        const float cmx = cm[s0 + n], inv = cmx > 0.f ? 127.0f / cmx : 0.f;
        v2u o; o.x = q8x4(s[0 * 33], s[1 * 33], s[2 * 33], s[3 * 33], inv);
        o.y = q8x4(s[4 * 33], s[5 * 33], s[6 * 33], s[7 * 33], inv);
        const int nn = n0 + n, kk = k0 + 8 * c4;
        *(GAS v2u*)(dst + (size_t)(nn >> 8) * ((size_t)256 * K) + (size_t)(kk >> 7) * (256 * 128) + (size_t)(nn & 255) * 128 + (kk & 127)) = o; }
    LDS_WAIT(); asm volatile("" ::: "memory");
}
DI void strip_quant8(Frame& F, const float* __restrict__ src, const float* __restrict__ gain, float* __restrict__ cm, unsigned char* __restrict__ dst, int K, int N, int mode, int lim, int strip, LAS float* scr, LAS unsigned* cml) {
    const int n0 = strip << 5, s0 = map_col(mode, lim, n0), lane = F.lane, kr = lane >> 3, c4 = lane & 7, nkb = K >> 6;
    if (F.tid < 32) cml[F.tid] = 0u;
    __syncthreads();
    f32x4 mx = {0.f, 0.f, 0.f, 0.f};
#pragma unroll 1
    for (int kb = F.wave; kb < nkb; kb += NWAVES) {
#pragma unroll
        for (int it = 0; it < 8; ++it) { const int k = (kb << 6) + 8 * it + kr; const f32x4 v = *(const GAS f32x4*)(src + (size_t)k * N + s0 + 4 * c4) * (gain ? gain[k] : 1.0f);
            mx.x = __builtin_fmaxf(mx.x, __builtin_fabsf(v.x)); mx.y = __builtin_fmaxf(mx.y, __builtin_fabsf(v.y)); mx.z = __builtin_fmaxf(mx.z, __builtin_fabsf(v.z)); mx.w = __builtin_fmaxf(mx.w, __builtin_fabsf(v.w)); } }
#pragma unroll
    for (int o = 8; o < 64; o <<= 1) { mx.x = __builtin_fmaxf(mx.x, __shfl_xor(mx.x, o)); mx.y = __builtin_fmaxf(mx.y, __shfl_xor(mx.y, o)); mx.z = __builtin_fmaxf(mx.z, __shfl_xor(mx.z, o)); mx.w = __builtin_fmaxf(mx.w, __shfl_xor(mx.w, o)); }
    if (lane < 8) { __hip_atomic_fetch_max(cml + 4 * lane + 0, __builtin_bit_cast(unsigned, mx.x), __ATOMIC_RELAXED, __HIP_MEMORY_SCOPE_WORKGROUP); __hip_atomic_fetch_max(cml + 4 * lane + 1, __builtin_bit_cast(unsigned, mx.y), __ATOMIC_RELAXED, __HIP_MEMORY_SCOPE_WORKGROUP);
                    __hip_atomic_fetch_max(cml + 4 * lane + 2, __builtin_bit_cast(unsigned, mx.z), __ATOMIC_RELAXED, __HIP_MEMORY_SCOPE_WORKGROUP); __hip_atomic_fetch_max(cml + 4 * lane + 3, __builtin_bit_cast(unsigned, mx.w), __ATOMIC_RELAXED, __HIP_MEMORY_SCOPE_WORKGROUP); }
    __syncthreads();
#pragma unroll 1
    for (int kb = F.wave; kb < nkb; kb += NWAVES) { const int k0 = kb << 6;
        f32x4 v[8]; float g[8];
#pragma unroll
        for (int it = 0; it < 8; ++it) { v[it] = *(const GAS f32x4*)(src + (size_t)(k0 + 8 * it + kr) * N + s0 + 4 * c4); g[it] = gain ? gain[k0 + 8 * it + kr] : 1.0f; }
#pragma unroll
        for (int it = 0; it < 8; ++it) { LAS float* p = scr + (8 * it + kr) * 33 + 4 * c4; p[0] = v[it].x * g[it]; p[1] = v[it].y * g[it]; p[2] = v[it].z * g[it]; p[3] = v[it].w * g[it]; }
        LDS_WAIT(); asm volatile("" ::: "memory");
#pragma unroll
        for (int j = 0; j < 4; ++j) { const int n = kr + 8 * j; const LAS float* s = scr + (8 * c4) * 33 + n;
            const float cmx = __builtin_bit_cast(float, cml[n]), inv = cmx > 0.f ? 127.0f / cmx : 0.f;
            v2u o; o.x = q8x4(s[0 * 33], s[1 * 33], s[2 * 33], s[3 * 33], inv);
            o.y = q8x4(s[4 * 33], s[5 * 33], s[6 * 33], s[7 * 33], inv);
            const int nn = n0 + n, kk = k0 + 8 * c4;
            *(GAS v2u*)(dst + (size_t)(nn >> 8) * ((size_t)256 * K) + (size_t)(kk >> 7) * (256 * 128) + (size_t)(nn & 255) * 128 + (kk & 127)) = o; }
        LDS_WAIT(); asm volatile("" ::: "memory"); }
    if (F.tid < 32) cm[s0 + F.tid] = __builtin_bit_cast(float, cml[F.tid]);
    __syncthreads();
}
#ifndef HAD_ON
#define HAD_ON 1
#endif
#ifndef ACT8_TILED
#define ACT8_TILED 0
#endif
DI void fwht_inlane8(float (&v)[8]) {
#pragma unroll
    for (int b = 1; b < 8; b <<= 1)
#pragma unroll
        for (int i = 0; i < 8; ++i) if (!(i & b)) { const float lo = v[i], hi = v[i | b]; v[i] = lo + hi; v[i | b] = lo - hi; }
}
template <int CTRL> DI float dpp_f(float v) { return __builtin_bit_cast(float, __builtin_amdgcn_update_dpp(0, __builtin_bit_cast(int, v), CTRL, 0xf, 0xf, false)); }
DI float swz_xor4(float v) { return __builtin_bit_cast(float, __builtin_amdgcn_ds_swizzle(__builtin_bit_cast(int, v), 0x101f)); }
constexpr int AQ_NIT = 11;
DI void aq_load(const bf16* act, int m, int sub, int lane, v4u (&t)[AQ_NIT]) {
    const bf16* row = act + (size_t)m * DFF + sub * (AQ_NIT * 512) + lane * 8;
#pragma unroll
    for (int it = 0; it < AQ_NIT; ++it) { t[it] = v4u{0u, 0u, 0u, 0u}; if (sub * (AQ_NIT * 512) + it * 512 + lane * 8 < DFF) t[it] = *(const GAS v4u*)(row + it * 512); }
}
DI void act_quant_phase(Frame& F, const bf16* act, unsigned char* aq, float* sact) {
    const int lane = F.lane, pair = F.wave >> 1, sub = F.wave & 1, step = F.G * (NWAVES / 2);
    LAS float* const smx = (LAS float*)(F.lds + RING_BYTES);
    const float s1 = (lane & 1) ? -1.f : 1.f, s2 = (lane & 2) ? -1.f : 1.f, s4 = (lane & 4) ? -1.f : 1.f;
    int par = 0;
    v4u t[AQ_NIT];
    { const int m = F.vcu * (NWAVES / 2) + pair; aq_load(act, m < M ? m : 0, sub, lane, t); }
#pragma unroll 1
    for (int m0 = F.vcu * (NWAVES / 2); m0 < M; m0 += step, par ^= 8) {
        const int m = m0 + pair; const bool rowok = m < M;
        float r[AQ_NIT][8]; float mx = 0.f;
#pragma unroll
        for (int it = 0; it < AQ_NIT; ++it) {
            float v[8] = {bf2f(t[it].x & 0xffffu), __builtin_bit_cast(float, t[it].x & 0xffff0000u), bf2f(t[it].y & 0xffffu), __builtin_bit_cast(float, t[it].y & 0xffff0000u),
                          bf2f(t[it].z & 0xffffu), __builtin_bit_cast(float, t[it].z & 0xffff0000u), bf2f(t[it].w & 0xffffu), __builtin_bit_cast(float, t[it].w & 0xffff0000u)};
            if (HAD_ON) { fwht_inlane8(v);
#pragma unroll
                for (int i = 0; i < 8; ++i) v[i] = __builtin_fmaf(v[i], s1, dpp_f<0xB1>(v[i]));
#pragma unroll
                for (int i = 0; i < 8; ++i) v[i] = __builtin_fmaf(v[i], s2, dpp_f<0x4E>(v[i]));
#pragma unroll
                for (int i = 0; i < 8; ++i) v[i] = __builtin_fmaf(v[i], s4, swz_xor4(v[i])); }
#pragma unroll
            for (int i = 0; i < 8; ++i) { mx = __builtin_fmaxf(mx, __builtin_fabsf(v[i])); r[it][i] = v[i]; } }
        { const int mn = m + step; aq_load(act, mn < M ? mn : 0, sub, lane, t); }
#pragma unroll
        for (int s = 1; s < 64; s <<= 1) mx = __builtin_fmaxf(mx, __shfl_xor(mx, s));
        if (lane == 0) smx[par + F.wave] = mx;
        __syncthreads();
        mx = __builtin_fmaxf(smx[par + 2 * pair], smx[par + 2 * pair + 1]);
        const float inv = mx > 0.f ? 127.0f / mx : 0.f;
#pragma unroll
        for (int it = 0; it < AQ_NIT; ++it) { const int e0 = sub * (AQ_NIT * 512) + it * 512 + lane * 8;
            v2u w = {0u, 0u};
#pragma unroll
            for (int i = 0; i < 4; ++i) { w.x = __builtin_amdgcn_cvt_pk_u8_f32(__builtin_rintf(__builtin_fmaf(r[it][i], inv, 128.f)), i, w.x);
                                          w.y = __builtin_amdgcn_cvt_pk_u8_f32(__builtin_rintf(__builtin_fmaf(r[it][4 + i], inv, 128.f)), i, w.y); }
            w.x ^= 0x80808080u; w.y ^= 0x80808080u;
            if (rowok && e0 < DFF) *(GAS v2u*)(aq + (ACT8_TILED ? (size_t)(m >> 8) * ((size_t)256 * DFF) + (size_t)(e0 >> 7) * (256 * 128) + (size_t)(m & 255) * 128 + (e0 & 127) : (size_t)m * DFF + e0)) = w; }
        if (rowok && sub == 0 && lane == 0) sact[m] = mx * (HAD_ON ? 0.125f / 127.0f : 1.0f / 127.0f);
    }
    __syncthreads();
}
DI void rot_tile_col(const LAS float* scr, int lane, float (&v)[32]) {
    const int n = lane & 31, half = lane >> 5;
#pragma unroll
    for (int i = 0; i < 32; ++i) v[i] = scr[(32 * half + i) * 33 + n];
    if (HAD_ON) {
#pragma unroll
        for (int b = 1; b < 32; b <<= 1)
#pragma unroll
            for (int i = 0; i < 32; ++i) if (!(i & b)) { const float lo = v[i], hi = v[i | b]; v[i] = lo + hi; v[i | b] = lo - hi; }
#pragma unroll
        for (int i = 0; i < 32; ++i) { const float p = __shfl_xor(v[i], 32); v[i] = (half ? p - v[i] : v[i] + p) * 0.125f; } }
}
DI void strip_quant8_rot(Frame& F, const float* __restrict__ src, float* __restrict__ cm, unsigned char* __restrict__ dst, int K, int N, int strip, LAS float* scr, LAS unsigned* cml) {
    const int n0 = strip << 5, lane = F.lane, kr = lane >> 3, c4 = lane & 7, nkb = K >> 6, n = lane & 31, half = lane >> 5;
    if (F.tid < 32) cml[F.tid] = 0u;
    __syncthreads();
    float mxc = 0.f;
#pragma unroll 1
    for (int pass = 0; pass < 2; ++pass) {
        float inv = 0.f; if (pass) { const float cmx = __builtin_bit_cast(float, cml[n]); inv = cmx > 0.f ? 127.0f / cmx : 0.f; }
#pragma unroll 1
        for (int kb = F.wave; kb < nkb; kb += NWAVES) { const int k0 = kb << 6;
            f32x4 t[8];
#pragma unroll
            for (int it = 0; it < 8; ++it) t[it] = *(const GAS f32x4*)(src + (size_t)(k0 + 8 * it + kr) * N + n0 + 4 * c4);
#pragma unroll
            for (int it = 0; it < 8; ++it) { LAS float* p = scr + (8 * it + kr) * 33 + 4 * c4; p[0] = t[it].x; p[1] = t[it].y; p[2] = t[it].z; p[3] = t[it].w; }
            LDS_WAIT(); asm volatile("" ::: "memory");
            float v[32]; rot_tile_col(scr, lane, v);
            if (!pass) {
#pragma unroll
                for (int i = 0; i < 32; ++i) mxc = __builtin_fmaxf(mxc, __builtin_fabsf(v[i])); }
            else { v4u o[2];
#pragma unroll
                for (int h = 0; h < 2; ++h)
#pragma unroll
                    for (int c = 0; c < 4; ++c) { const int i = 16 * h + 4 * c; o[h][c] = q8x4(v[i], v[i + 1], v[i + 2], v[i + 3], inv); }
                const int nn = n0 + n, kk = k0 + 32 * half;
                unsigned char* p = dst + (size_t)(nn >> 8) * ((size_t)256 * K) + (size_t)(kk >> 7) * (256 * 128) + (size_t)(nn & 255) * 128 + (kk & 127);
                *(GAS v4u*)p = o[0]; *(GAS v4u*)(p + 16) = o[1]; }
            LDS_WAIT(); asm volatile("" ::: "memory"); }
        if (!pass) { mxc = __builtin_fmaxf(mxc, __shfl_xor(mxc, 32)); if (half == 0) __hip_atomic_fetch_max(cml + n, __builtin_bit_cast(unsigned, mxc), __ATOMIC_RELAXED, __HIP_MEMORY_SCOPE_WORKGROUP); __syncthreads(); }
    }
    if (F.tid < 32) cm[n0 + F.tid] = __builtin_bit_cast(float, cml[F.tid]);
    __syncthreads();
}
template <int DROP> DI void norm_rows8(Frame& F, const float* x, unsigned char* xq, float* sA, bf16* xb) {
    const int gw = F.vcu * NWAVES + F.wave, NGW = F.G * NWAVES;
    for (int m = gw; m < M; m += NGW) {
        const GAS f32x4* xr = (const GAS f32x4*)(x + (size_t)m * DM) + 4 * F.lane;
        f32x4 v[16]; float s = 0.f, mx = 0.f;
#pragma unroll
        for (int j = 0; j < 4; ++j)
#pragma unroll
            for (int i = 0; i < 4; ++i) { const f32x4 t = xr[256 * j + i]; v[4 * j + i] = t; s += (t.x * t.x + t.y * t.y) + (t.z * t.z + t.w * t.w);
                mx = __builtin_fmaxf(mx, __builtin_fmaxf(__builtin_fmaxf(__builtin_fabsf(t.x), __builtin_fabsf(t.y)), __builtin_fmaxf(__builtin_fabsf(t.z), __builtin_fabsf(t.w)))); }
        const float r = 1.0f / sqrtf(wave_sum(s) * (1.0f / DM) + RMS_EPS);
#pragma unroll
        for (int o = 1; o < 64; o <<= 1) mx = __builtin_fmaxf(mx, __shfl_xor(mx, o));
        const float inv = mx > 0.f ? 127.0f / mx : 0.f;
#pragma unroll
        for (int j = 0; j < 4; ++j) { v4u w;
#pragma unroll
            for (int i = 0; i < 4; ++i) { const f32x4 t = v[4 * j + i]; w[i] = q8x4(t.x, t.y, t.z, t.w, inv); }
            *(GAS v4u*)(xq + (size_t)m * DM + 1024 * j + 16 * F.lane) = w;
            if (xb) {
#pragma unroll
                for (int h = 0; h < 2; ++h) { const f32x4 a = v[4 * j + 2 * h] * r, b = v[4 * j + 2 * h + 1] * r; v4u y;
                    if (DROP > 0) { y.x = f2bf_drop<DROP>(a.x) | (f2bf_drop<DROP>(a.y) << 16); y.y = f2bf_drop<DROP>(a.z) | (f2bf_drop<DROP>(a.w) << 16); y.z = f2bf_drop<DROP>(b.x) | (f2bf_drop<DROP>(b.y) << 16); y.w = f2bf_drop<DROP>(b.z) | (f2bf_drop<DROP>(b.w) << 16); }
                    else { y.x = pk2(a.x, a.y); y.y = pk2(a.z, a.w); y.z = pk2(b.x, b.y); y.w = pk2(b.z, b.w); }
                    *(GAS v4u*)(xb + (size_t)m * DM + 1024 * j + 16 * F.lane + 8 * h) = y; } } }
        if (F.lane == 0) sA[m] = mx * r * (1.0f / 127.0f);
    }
}
DI void quant_rows_bf16(Frame& F, const bf16* o, unsigned char* oq, float* sO) {
    const int gw = F.vcu * NWAVES + F.wave, NGW = F.G * NWAVES;
    for (int m = gw; m < M; m += NGW) {
        const GAS v4u* orow = (const GAS v4u*)(o + (size_t)m * DM) + 2 * F.lane;
        v4u v[8]; float mx = 0.f;
#pragma unroll
        for (int j = 0; j < 4; ++j)
#pragma unroll
            for (int h = 0; h < 2; ++h) { const v4u t = orow[128 * j + h]; v[2 * j + h] = t;
#pragma unroll
                for (int c = 0; c < 4; ++c) mx = __builtin_fmaxf(mx, __builtin_fmaxf(__builtin_fabsf(bf2f(t[c] & 0xffffu)), __builtin_fabsf(bf2f(t[c] >> 16)))); }
#pragma unroll
        for (int s = 1; s < 64; s <<= 1) mx = __builtin_fmaxf(mx, __shfl_xor(mx, s));
        const float inv = mx > 0.f ? 127.0f / mx : 0.f;
#pragma unroll
        for (int j = 0; j < 4; ++j) { v4u w;
#pragma unroll
            for (int h = 0; h < 2; ++h) { const v4u t = v[2 * j + h];
                w[2 * h] = q8x4(bf2f(t[0] & 0xffffu), bf2f(t[0] >> 16), bf2f(t[1] & 0xffffu), bf2f(t[1] >> 16), inv);
                w[2 * h + 1] = q8x4(bf2f(t[2] & 0xffffu), bf2f(t[2] >> 16), bf2f(t[3] & 0xffffu), bf2f(t[3] >> 16), inv); }
            *(GAS v4u*)(oq + (size_t)m * DM + 1024 * j + 16 * F.lane) = w; }
        if (F.lane == 0) sO[m] = mx * (1.0f / 127.0f);
    }
}
DI void final_norm_rows(Frame& F, float* x, const float* gain, bool poison) {
    const int gw = F.vcu * NWAVES + F.wave, NGW = F.G * NWAVES;
    for (int m = gw; m < M; m += NGW) {
        GAS f32x4* xr = (GAS f32x4*)(x + (size_t)m * DM) + F.lane; const GAS f32x4* gr = (const GAS f32x4*)gain + F.lane;
        f32x4 v[16]; float s = 0.f;
#pragma unroll
        for (int j = 0; j < 16; ++j) { v[j] = xr[64 * j]; s += (v[j].x * v[j].x + v[j].y * v[j].y) + (v[j].z * v[j].z + v[j].w * v[j].w); }
        float r = 1.0f / sqrtf(wave_sum(s) * (1.0f / DM) + RMS_EPS); if (poison) r = __builtin_nanf("");
#pragma unroll
        for (int j = 0; j < 16; ++j) xr[64 * j] = v[j] * r * gr[64 * j];
    }
}
DI void kmean_phase(Frame& F) {
    const bf16* Kb = (const bf16*)(F.ws + WS_K); bf16* kh = (bf16*)(F.ws + WS_KMEAN); bf16* kl = kh + 8 * 64 * 128;
    LAS float* red = (LAS float*)(F.lds + RING_OFF);
    const int c = F.tid & 15, rg = F.tid >> 4;
    for (int it = F.vcu; it < 8 * NBLK; it += F.G) {
        const int kvh = it >> 6, n = it & 63; float a[8];
#pragma unroll
        for (int e = 0; e < 8; ++e) a[e] = 0.f;
#pragma unroll
        for (int r = 0; r < 8; ++r) { const v4u w = *(const GAS v4u*)(Kb + (size_t)(n * 256 + rg + 32 * r) * A_KVW + kvh * 128 + c * 8);
            a[0] += bf2f(w.x & 0xffffu); a[1] += bf2f(w.x >> 16); a[2] += bf2f(w.y & 0xffffu); a[3] += bf2f(w.y >> 16); a[4] += bf2f(w.z & 0xffffu); a[5] += bf2f(w.z >> 16); a[6] += bf2f(w.w & 0xffffu); a[7] += bf2f(w.w >> 16); }
#pragma unroll
        for (int e = 0; e < 8; ++e) red[rg * 128 + c * 8 + e] = a[e];
        __syncthreads();
        if (F.tid < 128) { float s = 0.f;
#pragma unroll 8
            for (int g = 0; g < 32; ++g) s += red[g * 128 + F.tid];
            s *= (1.0f / 256.0f); const unsigned h = f2bf(s); const float l = s - bf2f(h);
            kh[(size_t)it * 128 + F.tid] = (bf16)h; kl[(size_t)it * 128 + F.tid] = (bf16)f2bf(l); }
        __syncthreads();
    }
}
namespace att {
template <int D> struct TL { static constexpr int PITCH = D * 2 + 16, BYTES = 64 * PITCH, NCH = D / 8, NLD = (64 * NCH) / 512; };
DI int crow(int reg, int h) { return (reg & 3) + 8 * (reg >> 2) + 4 * h; }
typedef float f32x2_t __attribute__((ext_vector_type(2))); typedef __bf16 bf16x2_t __attribute__((ext_vector_type(2)));
DI unsigned cvtpk(float lo, float hi) { f32x2_t v = {lo, hi}; bf16x2_t b = __builtin_convertvector(v, bf16x2_t); return __builtin_bit_cast(unsigned, b); }
typedef short v4i16_t __attribute__((ext_vector_type(4)));
DI s16x4 vtr(const LAS unsigned char* p) { return __builtin_bit_cast(s16x4, __builtin_amdgcn_ds_read_tr16_b64_v4i16((LAS v4i16_t*)p)); }
#define MFMA32(a, b, c) __builtin_amdgcn_mfma_f32_32x32x16_bf16((a), (b), (c), 0, 0, 0)

template <int D, int NL = TL<D>::NLD> DI void tile_load(v4u (&r)[NL], const bf16* g, int pitch, int tid) {
#pragma unroll
    for (int i = 0; i < NL; ++i) { const int c = tid + 512 * i, row = c / TL<D>::NCH, ch = c % TL<D>::NCH; r[i] = *(const GAS v4u*)(g + (size_t)row * pitch + ch * 8); }
}
template <int D, int NL = TL<D>::NLD> DI void tile_store(LAS unsigned char* t, const v4u (&r)[NL], int tid) {
#pragma unroll
    for (int i = 0; i < NL; ++i) { const int c = tid + 512 * i, row = c / TL<D>::NCH, ch = c % TL<D>::NCH; *(LAS v4u*)(t + row * TL<D>::PITCH + ch * 16) = r[i]; }
}
template <int D, bool INIT = true> DI void qk(f32x16& p0, f32x16& p1, const LAS unsigned char* kt, const bf16x8 (&qf)[D / 16], int r32, int hi) {
    const LAS unsigned char* a = kt + r32 * TL<D>::PITCH + hi * 16;
    if (INIT) {
#pragma unroll
        for (int i = 0; i < 16; ++i) { p0[i] = 0.f; p1[i] = 0.f; } }
#pragma unroll
    for (int s = 0; s < D / 16; ++s) { const bf16x8 a0 = *(const LAS bf16x8*)(a + s * 32), a1 = *(const LAS bf16x8*)(a + 32 * TL<D>::PITCH + s * 32);
        p0 = MFMA32(a0, qf[s], p0); p1 = MFMA32(a1, qf[s], p1); if ((s & 3) == 3) __builtin_amdgcn_sched_barrier(0); }
}
DI bf16x8 pack8(const f32x16& x, int s) {
    v4u p; p.x = cvtpk(x[8 * s], x[8 * s + 1]); p.y = cvtpk(x[8 * s + 2], x[8 * s + 3]); p.z = cvtpk(x[8 * s + 4], x[8 * s + 5]); p.w = cvtpk(x[8 * s + 6], x[8 * s + 7]);
    return __builtin_bit_cast(bf16x8, p);
}
template <int D> DI void pv(f32x16 (&o)[D / 32], const LAS unsigned char* vt, const f32x16& p0, const f32x16& p1, int lane, int hi) {
    bf16x8 pf[4]; pf[0] = pack8(p0, 0); pf[1] = pack8(p0, 1); pf[2] = pack8(p1, 0); pf[3] = pack8(p1, 1);
    const LAS unsigned char* vb = vt + (4 * hi + ((lane & 15) >> 2)) * TL<D>::PITCH + ((lane >> 4) & 1) * 32 + (lane & 3) * 8;
#pragma unroll
    for (int db = 0; db < D / 32; ++db)
#pragma unroll
        for (int ks = 0; ks < 4; ++ks) { const s16x4 lo = vtr(vb + (16 * ks) * TL<D>::PITCH + db * 64), hh = vtr(vb + (16 * ks + 8) * TL<D>::PITCH + db * 64);
            const bf16x8 va = (bf16x8){lo[0], lo[1], lo[2], lo[3], hh[0], hh[1], hh[2], hh[3]};
            o[db] = MFMA32(va, pf[ks], o[db]); if (ks == 3) __builtin_amdgcn_sched_barrier(0); }
}
template <int D> DI void softmax_update(f32x16& p0, f32x16& p1, float& m, float& l, f32x16 (&o)[D / 32]) {
    float mx = __builtin_fmaxf(p0[0], p1[0]);
#pragma unroll
    for (int i = 1; i < 16; ++i) mx = __builtin_fmaxf(mx, __builtin_fmaxf(p0[i], p1[i]));
    mx = __builtin_fmaxf(mx, __shfl_xor(mx, 32));
    const float mn = __builtin_fmaxf(m, mx), al = __builtin_amdgcn_exp2f(m - mn);
    float s = 0.f;
#pragma unroll
    for (int i = 0; i < 16; ++i) { p0[i] = __builtin_amdgcn_exp2f(p0[i] - mn); p1[i] = __builtin_amdgcn_exp2f(p1[i] - mn); s += p0[i] + p1[i]; }
    l = l * al + s; m = mn;
#pragma unroll
    for (int db = 0; db < D / 32; ++db)
#pragma unroll
        for (int i = 0; i < 16; ++i) o[db][i] *= al;
}
template <int D> DI void store_rows16(bf16* orow, const f32x16 (&o)[D / 32], float inv, int hi, bool valid) {
#pragma unroll
    for (int db = 0; db < D / 32; ++db)
#pragma unroll
        for (int gp = 0; gp < 2; ++gp) { const int ge = 8 * gp, go = 8 * gp + 4;
            const unsigned ex = cvtpk(o[db][ge] * inv, o[db][ge + 1] * inv), ey = cvtpk(o[db][ge + 2] * inv, o[db][ge + 3] * inv);
            const unsigned ox = cvtpk(o[db][go] * inv, o[db][go + 1] * inv), oy = cvtpk(o[db][go + 2] * inv, o[db][go + 3] * inv);
            const auto sx = __builtin_amdgcn_permlane32_swap(ex, ox, false, false), sy = __builtin_amdgcn_permlane32_swap(ey, oy, false, false);
            v4u w; w.x = sx[0]; w.y = sy[0]; w.z = sx[1]; w.w = sy[1];
            if (valid) *(GAS v4u*)(orow + db * 32 + 16 * gp + 8 * hi) = w; }
}
template <int D> DI void store_o(bf16* orow  , const f32x16 (&o)[D / 32], float l, int hi) {
    const float L = l + __shfl_xor(l, 32), inv = 1.0f / L;
    store_rows16<D>(orow, o, inv, hi, true);
}

constexpr int MOBA_HIST_OFF = 36864, MOBA_SCAN_OFF = 40960;
DI size_t moba_list_off(int kvh, int n) { return (size_t)kvh * 2064384 + (size_t)1024 * (63 * n - (n * (n - 1)) / 2); }
template <int D> DI void store_part(bf16* po  , float* pml, const f32x16 (&o)[D / 32], float m, float l, int hi, bool valid) {
    const float L = l + __shfl_xor(l, 32), inv = 1.0f / L;
    store_rows16<D>(po, o, inv, hi, valid);
    if (valid && hi == 0) { pml[0] = m; pml[1] = L; }
}
DI void moba_own_item(Frame& F, int b, int h) {
    constexpr int D = 128; typedef TL<D> T;
    LAS unsigned char* kt = F.lds + RING_OFF; LAS unsigned char* vt = kt + T::BYTES;
    LAS unsigned* hist = (LAS unsigned*)(F.lds + RING_OFF + MOBA_HIST_OFF); LAS unsigned* bases = hist + 64;
    const int lane = F.lane, r32 = lane & 31, hi = lane >> 5, w = F.wave, kvh = h >> 2, tid = F.tid;
    const bf16* Kb = (const bf16*)(F.ws + WS_K) + kvh * 128; const bf16* Vb = (const bf16*)(F.ws + WS_V) + kvh * 128;
    const bf16* kmh = (const bf16*)(F.ws + WS_KMEAN) + (size_t)kvh * 64 * 128; const bf16* kml = kmh + 8 * 64 * 128;
    const int tok = b * 256 + w * 32 + r32, pair = tok * 32 + h;
    const bf16* qrow = (const bf16*)(F.ws + WS_Q) + (size_t)tok * DM + h * 128;
    bf16x8 qf[8];
#pragma unroll
    for (int s = 0; s < 8; ++s) qf[s] = *(const GAS bf16x8*)(qrow + 16 * s + 8 * hi);
    v4u rk[T::NLD], rv[T::NLD];
    const float NEG = -__builtin_inff();
    if (b > 0) {
        tile_load<D>(rk, kmh, 128, tid); tile_load<D>(rv, kml, 128, tid);
        if (tid < 64) hist[tid] = 0u;
        __syncthreads(); tile_store<D>(kt, rk, tid); tile_store<D>(vt, rv, tid); __syncthreads();
        int nsel[3]; unsigned rnk[3];
        { f32x16 g0, g1; qk<D>(g0, g1, vt, qf, r32, hi); __builtin_amdgcn_sched_barrier(0); qk<D, false>(g0, g1, kt, qf, r32, hi);
#pragma unroll
          for (int i = 0; i < 16; ++i) { const int n0 = crow(i, hi); g0[i] = (n0 < b) ? g0[i] : NEG; g1[i] = (n0 + 32 < b) ? g1[i] : NEG; }
#pragma unroll
          for (int j = 0; j < 3; ++j) { float bv = NEG; int bi = 64;
#pragma unroll
              for (int i = 0; i < 16; ++i) { const int n0 = crow(i, hi); if (g0[i] > bv) { bv = g0[i]; bi = n0; } }
#pragma unroll
              for (int i = 0; i < 16; ++i) { const int n1 = 32 + crow(i, hi); if (g1[i] > bv) { bv = g1[i]; bi = n1; } }
              const float ov = __shfl_xor(bv, 32); const int oi = __shfl_xor(bi, 32);
              if (ov > bv || (ov == bv && oi < bi)) { bv = ov; bi = oi; }
              nsel[j] = (bv > NEG) ? bi : -1;
#pragma unroll
              for (int i = 0; i < 16; ++i) { const int n0 = crow(i, hi); g0[i] = (n0 == bi) ? NEG : g0[i]; g1[i] = (n0 + 32 == bi) ? NEG : g1[i]; } } }
#pragma unroll
        for (int j = 0; j < 3; ++j) { rnk[j] = 0u; if (hi == 0 && nsel[j] >= 0) rnk[j] = __hip_atomic_fetch_add(hist + nsel[j], 1u, __ATOMIC_RELAXED, __HIP_MEMORY_SCOPE_WORKGROUP); }
        __syncthreads();
        if (tid < 64) { const unsigned hc = hist[tid]; unsigned bs = 0u; if (hc) bs = __hip_atomic_fetch_add((unsigned*)(F.ctl + CW_CNT) + kvh * 64 + tid, hc, RLX_AGENT); bases[tid] = bs; }
        __syncthreads();
        unsigned* lst = (unsigned*)(F.ws + WS_LIST);
#pragma unroll
        for (int j = 0; j < 3; ++j) if (hi == 0 && nsel[j] >= 0) lst[moba_list_off(kvh, nsel[j]) + bases[nsel[j]] + rnk[j]] = ((unsigned)pair << 2) | (unsigned)j;
    }
    float m = -1e30f, l = 0.f; f32x16 o[4];
#pragma unroll
    for (int db = 0; db < 4; ++db)
#pragma unroll
        for (int i = 0; i < 16; ++i) o[db][i] = 0.f;
    tile_load<D>(rk, Kb + (size_t)(b * 256) * A_KVW, A_KVW, tid); tile_load<D>(rv, Vb + (size_t)(b * 256) * A_KVW, A_KVW, tid);
    for (int tt = 0; tt < 4; ++tt) {
        __syncthreads();
        tile_store<D>(kt, rk, tid); tile_store<D>(vt, rv, tid);
        __syncthreads();
        if (tt + 1 < 4) { const size_t r0 = (size_t)b * 256 + (tt + 1) * 64; tile_load<D>(rk, Kb + r0 * A_KVW, A_KVW, tid); tile_load<D>(rv, Vb + r0 * A_KVW, A_KVW, tid); }
        if (tt * 64 <= w * 32 + 31) {
            f32x16 p0, p1; qk<D>(p0, p1, kt, qf, r32, hi);
            const int qrel = w * 32 + r32, kb = tt * 64 + 4 * hi;
#pragma unroll
            for (int i = 0; i < 16; ++i) { const int kv = kb + (i & 3) + 8 * (i >> 2); p0[i] = (kv > qrel) ? NEG : p0[i]; p1[i] = (kv + 32 > qrel) ? NEG : p1[i]; }
            softmax_update<D>(p0, p1, m, l, o);
            pv<D>(o, vt, p0, p1, lane, hi);
        }
    }
    store_part<D>((bf16*)(F.ws + WS_PARTO) + ((size_t)pair * 4 + 3) * 128, (float*)(F.ws + WS_PARTML) + ((size_t)pair * 4 + 3) * 2, o, m, l, hi, true);
    __syncthreads();
}
DI void moba_own_phase(Frame& F) {
#pragma unroll 1
    for (int p2 = 2 * F.vcu; p2 < 2 * 32 * A_H; p2 += (p2 & 1) ? 2 * F.G - 1 : 1) { const int p = p2 >> 1, h = p >> 5, bp = p & 31; moba_own_item(F, (p2 & 1) ? bp : 63 - bp, h); }
}
DI void moba_past_phase(Frame& F) {
    constexpr int D = 128; typedef TL<D> T; constexpr int IMG = 256 * T::PITCH;
    LAS unsigned char* kt = F.lds + RING_OFF; LAS unsigned char* vt = kt + IMG;
    LAS int* sc = (LAS int*)(F.lds + RING_OFF + 2 * IMG); LAS int* pc = sc + 512;
    static_assert(2 * IMG + 4096 <= LDSCTL_OFF, "MoBA past phase LDS map");
    const int lane = F.lane, r32 = lane & 31, hi = lane >> 5, w = F.wave, tid = F.tid;
    { int cv = 0; if (tid < 504) cv = (int)__hip_atomic_load((unsigned*)(F.ctl + CW_CNT) + (tid / 63) * 64 + (tid % 63), RLX_AGENT);
      pc[tid] = cv; sc[tid] = (cv + 255) >> 8; __syncthreads();
      for (int off = 1; off < 512; off <<= 1) { const int x = sc[tid] + (tid >= off ? sc[tid - off] : 0); __syncthreads(); sc[tid] = x; __syncthreads(); } }
    const int total = sc[511];
    const unsigned* lst = (const unsigned*)(F.ws + WS_LIST); const bf16* Qg = (const bf16*)(F.ws + WS_Q);
    const int i_lo = (int)(((long)total * F.vcu) / F.G), i_hi = (int)(((long)total * (F.vcu + 1)) / F.G);
#define MOBA_QLOAD(QF, E) do { const int pr_ = (int)((E) >> 2); const bf16* qrow_ = Qg + (size_t)(pr_ >> 5) * DM + (pr_ & 31) * 128; \
        _Pragma("unroll") for (int s_ = 0; s_ < 8; ++s_) QF[s_] = *(const GAS bf16x8*)(qrow_ + 16 * s_ + 8 * hi); } while (0)
    int t = 0;
    if (i_lo < i_hi) { int lo_ = 0, hi_ = 511; while (lo_ < hi_) { const int mid_ = (lo_ + hi_) >> 1; if (sc[mid_] > i_lo) hi_ = mid_; else lo_ = mid_ + 1; } t = __builtin_amdgcn_readfirstlane(lo_); }
    int t_img = -1; bf16x8 qf[8]; unsigned e = 0u; bool valid = false;
#pragma unroll 1
    for (int idx = i_lo; idx < i_hi; ++idx) {
        while (sc[t] <= idx) ++t;
        t = __builtin_amdgcn_readfirstlane(t);
        const int cnt = pc[t], c = idx - (sc[t] - ((cnt + 255) >> 8)), kvh = t / 63, n = t % 63;
        const size_t lbase = moba_list_off(kvh, n);
        if (t != t_img) {
            const bf16* Kb = (const bf16*)(F.ws + WS_K) + kvh * 128 + (size_t)(n * 256) * A_KVW; const bf16* Vb = (const bf16*)(F.ws + WS_V) + kvh * 128 + (size_t)(n * 256) * A_KVW;
            __syncthreads();
            { v4u r8[8]; tile_load<D, 8>(r8, Kb, A_KVW, tid); tile_store<D, 8>(kt, r8, tid); }
            { v4u r8[8]; tile_load<D, 8>(r8, Vb, A_KVW, tid); tile_store<D, 8>(vt, r8, tid); }
            __syncthreads();
            t_img = t;
            const int ir0 = c * 256 + w * 32 + r32; valid = ir0 < cnt; e = lst[lbase + (valid ? ir0 : 0)]; MOBA_QLOAD(qf, e);
        }
        const bool nxt_same = (idx + 1 < i_hi) && (sc[t] > idx + 1);
        unsigned e2 = 0u; bool valid2 = false;
        if (nxt_same) { const int ir2 = (c + 1) * 256 + w * 32 + r32; valid2 = ir2 < cnt; e2 = lst[lbase + (valid2 ? ir2 : 0)]; }
        const bool wact = __any(valid ? 1 : 0) != 0;
        float m = -1e30f, l = 0.f; f32x16 o[4];
#pragma unroll
        for (int db = 0; db < 4; ++db)
#pragma unroll
            for (int i = 0; i < 16; ++i) o[db][i] = 0.f;
        const int pair = (int)(e >> 2), j = (int)(e & 3u);
#pragma unroll 1
        for (int ss = 0; ss < 4; ++ss) {
            f32x16 p0, p1;
            if (wact) qk<D>(p0, p1, kt + ss * 64 * T::PITCH, qf, r32, hi);
            if (ss == 3 && nxt_same) { __builtin_amdgcn_sched_barrier(0); MOBA_QLOAD(qf, e2); }
            if (wact) { softmax_update<D>(p0, p1, m, l, o); pv<D>(o, vt + ss * 64 * T::PITCH, p0, p1, lane, hi); }
        }
        store_part<D>((bf16*)(F.ws + WS_PARTO) + ((size_t)pair * 4 + j) * 128, (float*)(F.ws + WS_PARTML) + ((size_t)pair * 4 + j) * 2, o, m, l, hi, valid);
        e = e2; valid = valid2;
    }
    __syncthreads();
#undef MOBA_QLOAD
}
DI void moba_combine_phase(Frame& F) {
    const int gw = F.vcu * NWAVES + F.wave, NGW = F.G * NWAVES, sub = F.lane >> 4, ch = F.lane & 15;
    const bf16* po = (const bf16*)(F.ws + WS_PARTO); const float* pml = (const float*)(F.ws + WS_PARTML); bf16* ob = (bf16*)(F.ws + WS_O);
#pragma unroll 1
    for (int it = gw; it < (M * A_H) / 4; it += NGW) {
        const int pair = it * 4 + sub, tok = pair >> 5, h = pair & 31, b = tok >> 8, nv = b < 3 ? b : 3;
        const f32x4 ml01 = *(const GAS f32x4*)(pml + (size_t)pair * 8), ml23 = *(const GAS f32x4*)(pml + (size_t)pair * 8 + 4);
        float mm[4] = {ml01.x, ml01.z, ml23.x, ml23.z}, ll[4] = {ml01.y, ml01.w, ml23.y, ml23.w};
        float mx = mm[3];
#pragma unroll
        for (int s = 0; s < 3; ++s) if (s < nv) mx = __builtin_fmaxf(mx, mm[s]);
        float wgt[4], wsum = 0.f;
#pragma unroll
        for (int s = 0; s < 4; ++s) { const bool ok = (s == 3) || (s < nv); wgt[s] = ok ? __builtin_amdgcn_exp2f(mm[s] - mx) * ll[s] : 0.f; wsum += wgt[s]; }
        const float inv = 1.0f / wsum; float acc[8];
#pragma unroll
        for (int e = 0; e < 8; ++e) acc[e] = 0.f;
#pragma unroll
        for (int s = 0; s < 4; ++s) { const bool ok = (s == 3) || (s < nv);
            if (ok) { const v4u v = *(const GAS v4u*)(po + ((size_t)pair * 4 + s) * 128 + ch * 8); const float ws_ = wgt[s] * inv;
                acc[0] += ws_ * bf2f(v.x & 0xffffu); acc[1] += ws_ * bf2f(v.x >> 16); acc[2] += ws_ * bf2f(v.y & 0xffffu); acc[3] += ws_ * bf2f(v.y >> 16);
                acc[4] += ws_ * bf2f(v.z & 0xffffu); acc[5] += ws_ * bf2f(v.z >> 16); acc[6] += ws_ * bf2f(v.w & 0xffffu); acc[7] += ws_ * bf2f(v.w >> 16); } }
        v4u o; o.x = cvtpk(acc[0], acc[1]); o.y = cvtpk(acc[2], acc[3]); o.z = cvtpk(acc[4], acc[5]); o.w = cvtpk(acc[6], acc[7]);
        *(GAS v4u*)(ob + (size_t)tok * DM + h * 128 + ch * 8) = o;
    }
}

DI void swa_item(Frame& F, int qb, int kvh) {
    constexpr int D = 64; typedef TL<D> T; constexpr int IMG = 384 * T::PITCH;
    LAS unsigned char* kt = F.lds + RING_OFF; LAS unsigned char* vt = kt + IMG;
    const int lane = F.lane, r32 = lane & 31, hi = lane >> 5, w = F.wave, tid = F.tid;
    const long base = (long)qb * 256 - 128; const int tb = (qb == 0) ? 2 : 0;
    const bf16* Kb = (const bf16*)(F.ws + WS_KSH) + kvh * 64 + base * B_KVW; const bf16* Vb = (const bf16*)(F.ws + WS_VSH) + kvh * 64 + base * B_KVW;
    const int tok = qb * 256 + w * 32 + r32;
    const bf16* qrow = (const bf16*)(F.ws + WS_Q) + (size_t)tok * DM + kvh * 8 * 64;
    bf16x8 qf[4];
#pragma unroll
    for (int s = 0; s < 4; ++s) qf[s] = *(const GAS bf16x8*)(qrow + 16 * s + 8 * hi);
    { v4u rk[6], rv[6];
#pragma unroll
      for (int i = 0; i < 6; ++i) { const int c = tid + 512 * i, row = c >> 3, ch = c & 7; if (row >= 64 * tb) { rk[i] = *(const GAS v4u*)(Kb + (size_t)row * B_KVW + ch * 8); rv[i] = *(const GAS v4u*)(Vb + (size_t)row * B_KVW + ch * 8); } }
      __syncthreads();
#pragma unroll
      for (int i = 0; i < 6; ++i) { const int c = tid + 512 * i, row = c >> 3, ch = c & 7; if (row >= 64 * tb) { *(LAS v4u*)(kt + row * T::PITCH + ch * 16) = rk[i]; *(LAS v4u*)(vt + row * T::PITCH + ch * 16) = rv[i]; } }
      __syncthreads(); }
    const float NEG = -__builtin_inff(); const int qs = 32 * w, qrel = qs + r32;
#pragma unroll 1
    for (int g = 0; g < 8; ++g) {
        const int h = kvh * 8 + g;
        bf16x8 qn[4];
        if (g < 7) {
#pragma unroll
            for (int s = 0; s < 4; ++s) qn[s] = *(const GAS bf16x8*)(qrow + (g + 1) * 64 + 16 * s + 8 * hi); }
        float m = F.b_sinks[h] * LOG2E, l = (hi == 0) ? 1.0f : 0.f; f32x16 o[2];
#pragma unroll
        for (int db = 0; db < 2; ++db)
#pragma unroll
            for (int i = 0; i < 16; ++i) o[db][i] = 0.f;
#pragma unroll 1
        for (int tt = tb; tt < 6; ++tt) {
            const int kbr = -128 + 64 * tt;
            if ((kbr <= qs + 31) && (kbr + 63 >= qs - 127)) {
                f32x16 p0, p1; qk<D>(p0, p1, kt + tt * 64 * T::PITCH, qf, r32, hi);
                const int kb = kbr + 4 * hi;
#pragma unroll
                for (int i = 0; i < 16; ++i) { const int kv = kb + (i & 3) + 8 * (i >> 2);
                    p0[i] = (kv <= qrel && qrel - kv < 128) ? p0[i] : NEG; p1[i] = (kv + 32 <= qrel && qrel - kv - 32 < 128) ? p1[i] : NEG; }
                softmax_update<D>(p0, p1, m, l, o);
                pv<D>(o, vt + tt * 64 * T::PITCH, p0, p1, lane, hi);
            }
        }
        store_o<D>((bf16*)(F.ws + WS_O) + (size_t)tok * DM + h * 64, o, l, hi);
        if (g < 7) {
#pragma unroll
            for (int s = 0; s < 4; ++s) qf[s] = qn[s]; }
    }
}
DI void swa_phase(Frame& F) {
#pragma unroll 1
    for (int p = F.vcu; p < 64 * 8; p += F.G) swa_item(F, p & 63, p >> 6);
    __syncthreads();
}
#undef MFMA32
}
struct Args { const float* in[13]; float* out; unsigned char* ws; int ph_lo, ph_hi; };
__global__ void __launch_bounds__(NWAVES * 64, 2) yoco_fwd(Args args) {
    extern __shared__ __attribute__((aligned(16))) unsigned char lds[];
    Frame F;
    F.lds = (LAS unsigned char*)lds;
    F.MISC = (volatile LAS unsigned*)(F.lds + MISC_OFF);
    F.tid = threadIdx.x; F.lane = F.tid & 63; F.wave = __builtin_amdgcn_readfirstlane(F.tid >> 6);
    F.G = gridDim.x; { const int bx = blockIdx.x; F.vcu = (F.G % 8 == 0) ? (bx % 8) * (F.G / 8) + bx / 8 : bx; }
    F.ws = args.ws; F.ctl = (gu32*)(args.ws + WS_CTL);
    F.x = args.in[0]; F.ffn_norm = args.in[1]; F.ffn_w_in = args.in[2]; F.ffn_w_out = args.in[3]; F.attn_norm = args.in[4]; F.a_w_qkv = args.in[5]; F.a_w_o = args.in[6];
    F.kv_norm = args.in[7]; F.w_kv = args.in[8]; F.b_w_q = args.in[9]; F.b_sinks = args.in[10]; F.b_w_o = args.in[11]; F.final_norm = args.in[12]; F.out = args.out;
    for (int u = F.tid; u < (LDS_BYTES - LDSCTL_OFF) / 4; u += NWAVES * 64) ((LAS unsigned*)(F.lds + LDSCTL_OFF))[u] = 0u;
    __syncthreads();
    XcdBarrier bar; bar.bar = (unsigned*)(F.ctl + CW_BAR); bar.x = 0; bar.st = nullptr;
    if (!MK_SPLIT) bar = xcd_barrier_post((unsigned*)(F.ctl + CW_BAR), F.MISC + 8);
#define GRID_BAR(seam) do { if (MK_SPLIT) { if (F.tid == 0) __hip_atomic_store(F.ctl + CW_TMO, 0xBADBA0u | (unsigned)(seam), RLX_AGENT); } else { xcd_barrier(bar); } } while (0)
    const int lo = args.ph_lo, hi = args.ph_hi;
#ifndef PH_MASK
#define PH_MASK 0xffffffffu
#endif
#define IN(k) ((((PH_MASK) >> (k)) & 1u) && lo <= (k) && (k) < hi)
#define SEAM(k) do { if (IN(k) && IN((k) + 1)) GRID_BAR(k); } while (0)
    bf16* const W_IN = (bf16*)(F.ws + WS_WIN); bf16* const W_OUT = (bf16*)(F.ws + WS_WOUT);
    bf16* const W_QKV = (bf16*)(F.ws + WS_WQKV); bf16* const W_AO = (bf16*)(F.ws + WS_WAO); bf16* const W_KV = (bf16*)(F.ws + WS_WKV); bf16* const W_BQ = (bf16*)(F.ws + WS_WBQ); bf16* const W_BO = (bf16*)(F.ws + WS_WBO);
    bf16* const XN = (bf16*)(F.ws + WS_XN); bf16* const ACT = (bf16*)(F.ws + WS_ACT); bf16* const QB = (bf16*)(F.ws + WS_Q); bf16* const KB = (bf16*)(F.ws + WS_K); bf16* const VB = (bf16*)(F.ws + WS_V);
    bf16* const OB = (bf16*)(F.ws + WS_O); bf16* const KSH = (bf16*)(F.ws + WS_KSH); bf16* const VSH = (bf16*)(F.ws + WS_VSH);
    const float* const COSA = (const float*)(F.ws + WS_ROPEA); const float* const SINA = COSA + (size_t)M * 64; const float* const COSB = (const float*)(F.ws + WS_ROPEB); const float* const SINB = COSB + (size_t)M * 32;
    unsigned char* const W8 = (unsigned char*)(F.ws + WS_WIN); unsigned char* const XN8 = (unsigned char*)(F.ws + WS_XN8); float* const SA = (float*)(F.ws + WS_SA);
    float* const COLMAX = (float*)(F.ctl + CW_COLMAX); constexpr int CM_BQ = 4 * 2 * DFF, CM_KV = CM_BQ + DM, CM_AO = CM_KV + 2 * B_KVW, CM_BO = CM_AO + DM, CM_OUT = CM_BO + DM, CM_QKV = CM_OUT + 4 * DM;
    unsigned char* const ACT8 = (unsigned char*)(F.ws + WS_ACT8); float* const SACT = (float*)(F.ws + WS_SACT); unsigned char* const W8O = (unsigned char*)(F.ws + WS_WOUT);
    constexpr size_t E_WIN = (size_t)2 * DFF * DM, E_WOUT = (size_t)DFF * DM;

#define GEMM_PHASE_T(EPI_T, EPI_OBJ, A_, B_, N_, K_, TA_, TB_, WGM_) do { pg8::Gemm g_{(A_), (B_), M, (N_), (K_)}; pg8::StaticOrder S_; S_.init(M, (N_), F.G, (int)blockIdx.x, (WGM_)); \
        pg8::gemm_phase<EPI_T, pg8::StaticOrder, PG8_ALIGN, PG8_SP2, TA_, TB_>(F.lds + RING_OFF, g_, S_, (EPI_OBJ)); } while (0)
#ifndef XN_TILED
#define XN_TILED false
#endif
#define GEMM_PHASE_8(EPI_T, EPI_OBJ, A_, B_, N_, K_) do { pg8::Gemm g_{(const bf16*)(A_), (const bf16*)(B_), M, (N_), (K_)}; pg8::StaticOrder S_; S_.init(M, (N_), F.G, (int)blockIdx.x, 8); \
        pg8::gemm_phase<EPI_T, pg8::StaticOrder, PG8_ALIGN, PG8_SP2, false, true, true>(F.lds + RING_OFF, g_, S_, (EPI_OBJ)); } while (0)
#define GEMM_PHASE(EPI_T, EPI_OBJ, A_, B_, N_, K_) GEMM_PHASE_T(EPI_T, EPI_OBJ, A_, B_, N_, K_, false, true, 8)
#define GEMM_PHASE_X(EPI_T, EPI_OBJ, A_, B_, N_, K_) GEMM_PHASE_T(EPI_T, EPI_OBJ, A_, B_, N_, K_, XN_TILED, true, 8)
#ifndef DOWN_WGM
#define DOWN_WGM 2
#endif
#define FFN_UP(f)   do { pg8::EpiSwiGLU8 E_{ACT, DFF, SA, COLMAX + (size_t)(f) * 2 * DFF}; pg8::Gemm g_{(const bf16*)XN8, (const bf16*)(W8 + (size_t)(f) * E_WIN), M, 2 * DFF, DM}; \
        pg8::ClaimOrder S_; S_.init(M, 2 * DFF, F.G, (int)blockIdx.x, 8); S_.setup((unsigned*)(F.ctl + CW_CLAIM + 64 * (f)), F.MISC + 16); \
        pg8::gemm_phase<pg8::EpiSwiGLU8, pg8::ClaimOrder, PG8_ALIGN, PG8_SP2, false, true, true>(F.lds + RING_OFF, g_, S_, E_); } while (0)
#define FFN_DOWN(f, BASE_) do { pg8::EpiResid8 E_{(BASE_), F.out, DM, 0.5f, SACT, COLMAX + CM_OUT + (size_t)(f) * DM}; pg8::Gemm g_{(const bf16*)ACT8, (const bf16*)(W8O + (size_t)(f) * E_WOUT), M, DM, DFF}; \
        pg8::StaticOrder S_; S_.init(M, DM, F.G, (int)blockIdx.x, DOWN_WGM); pg8::gemm_phase<pg8::EpiResid8, pg8::StaticOrder, PG8_ALIGN, PG8_SP2, (ACT8_TILED != 0), true, true>(F.lds + RING_OFF, g_, S_, E_); } while (0)

    LAS float* const scr_ = (LAS float*)(F.lds + RING_OFF + F.wave * 16384);
#ifndef XN_FFN_DROP
#define XN_FFN_DROP 2
#endif
#ifndef FFN_W_DROP
#define FFN_W_DROP 2
#endif
#define TR_WXD(SRC, GAIN, DST, K_, N_, MODE_, LIM_, TL_, GW_, NGW_, DROP_) for (int it_ = (GW_); it_ < ((K_) / 64) * ((N_) / 32); it_ += (NGW_)) tr_item<TL_, DROP_>((SRC), (GAIN), (DST), (K_), (N_), (N_), (MODE_), (LIM_), scr_, it_, F.lane)
#define TR_WX(SRC, GAIN, DST, K_, N_, MODE_, LIM_, TL_, GW_, NGW_) for (int it_ = (GW_); it_ < ((K_) / 64) * ((N_) / 32); it_ += (NGW_)) tr_item<TL_>((SRC), (GAIN), (DST), (K_), (N_), (N_), (MODE_), (LIM_), scr_, it_, F.lane)
    const bool tailconv = false, tailwg = false;
    const int tw_ = ((int)blockIdx.x - 128) * NWAVES + F.wave, NTW_ = 128 * NWAVES;
    if (IN(0)) {
        {
        const int gw = F.vcu * NWAVES + F.wave, NGW = F.G * NWAVES;
#define TR_W(SRC, GAIN, DST, K_, N_, MODE_, LIM_, TL_) TR_WX(SRC, GAIN, DST, K_, N_, MODE_, LIM_, TL_, gw, NGW)
#define TR_WF(SRC, GAIN, DST, K_, N_, MODE_, LIM_, TL_) TR_WXD(SRC, GAIN, DST, K_, N_, MODE_, LIM_, TL_, gw, NGW, FFN_W_DROP)
        if (!tailconv) {
        }
#undef TR_W
#undef TR_WF
        { LAS unsigned* const cml_ = (LAS unsigned*)(F.lds + RING_BYTES); constexpr int S_IN = (2 * DFF) / 32, S_D = DM / 32, S_KV = (2 * B_KVW) / 32, S_QKV = NQKV / 32, S_TOT = 4 * S_IN + 3 * S_D + S_KV + S_QKV;
#pragma unroll 1
          for (int st_ = F.vcu; st_ < S_TOT; st_ += F.G) {
              const float* src_; const float* gn_; float* cm_; unsigned char* dst_; int n_, mode_, lim_, sl_;
              if (st_ < 4 * S_IN) { const int fw_ = st_ / S_IN; sl_ = st_ - fw_ * S_IN; src_ = F.ffn_w_in + (size_t)fw_ * E_WIN; gn_ = F.ffn_norm + (size_t)fw_ * DM; cm_ = COLMAX + (size_t)fw_ * 2 * DFF; dst_ = W8 + (size_t)fw_ * E_WIN; n_ = 2 * DFF; mode_ = 1; lim_ = 0; }
              else if (st_ < 4 * S_IN + S_D) { sl_ = st_ - 4 * S_IN; src_ = F.b_w_q; gn_ = F.attn_norm + DM; cm_ = COLMAX + CM_BQ; dst_ = (unsigned char*)W_BQ; n_ = DM; mode_ = 3; lim_ = 4096; }
              else if (st_ < 4 * S_IN + 2 * S_D) { sl_ = st_ - 4 * S_IN - S_D; src_ = F.a_w_o; gn_ = nullptr; cm_ = COLMAX + CM_AO; dst_ = (unsigned char*)W_AO; n_ = DM; mode_ = 0; lim_ = 0; }
              else if (st_ < 4 * S_IN + 3 * S_D) { sl_ = st_ - 4 * S_IN - 2 * S_D; src_ = F.b_w_o; gn_ = nullptr; cm_ = COLMAX + CM_BO; dst_ = (unsigned char*)W_BO; n_ = DM; mode_ = 0; lim_ = 0; }
              else if (st_ >= 4 * S_IN + 3 * S_D + S_KV) { sl_ = st_ - 4 * S_IN - 3 * S_D - S_KV; src_ = F.a_w_qkv; gn_ = F.attn_norm; cm_ = COLMAX + CM_QKV; dst_ = (unsigned char*)W_QKV; n_ = NQKV; mode_ = 2; lim_ = 5120; }
              else { sl_ = st_ - 4 * S_IN - 3 * S_D; src_ = F.w_kv; gn_ = F.kv_norm; cm_ = COLMAX + CM_KV; dst_ = (unsigned char*)W_KV; n_ = 2 * B_KVW; mode_ = 3; lim_ = 512; }
              strip_quant8(F, src_, gn_, cm_, dst_, DM, n_, mode_, lim_, sl_, scr_, cml_); } }
        { LAS unsigned* const cml_ = (LAS unsigned*)(F.lds + RING_BYTES);
#pragma unroll 1
          for (int st_ = F.vcu; st_ < 4 * (DM / 32); st_ += F.G) { const int fw_ = st_ / (DM / 32), sl_ = st_ - fw_ * (DM / 32);
              strip_quant8_rot(F, F.ffn_w_out + (size_t)fw_ * E_WOUT, COLMAX + CM_OUT + (size_t)fw_ * DM, W8O + (size_t)fw_ * E_WOUT, DFF, DM, sl_, scr_, cml_); } }
        rope_tables(F);
        norm_rows8<0>(F, F.x, XN8, SA, (bf16*)nullptr);
        }
    }
    if (IN(0) && IN(1)) GRID_BAR(0);
    if (IN(1)) { FFN_UP(0);
        if (tailwg) { TR_WX(F.a_w_qkv, F.attn_norm, W_QKV, DM, NQKV, 2, 5120, true, tw_, NTW_); } }
    if (IN(1) && IN(27)) GRID_BAR(1);
    if (IN(27)) act_quant_phase(F, ACT, ACT8, SACT);
    if (IN(27) && IN(2)) GRID_BAR(27);
    if (IN(2)) FFN_DOWN(0, F.x);
    SEAM(2);
    if (IN(3)) norm_rows8<0>(F, F.out, XN8, SA, (bf16*)nullptr);
    SEAM(3);
    if (IN(4)) { pg8::EpiRope8<128> E_{QB, KB, VB, DM, A_KVW, A_KVW, 16, 4, 0.08838834764831845f * LOG2E, COSA, SINA, SA, COLMAX + CM_QKV}; GEMM_PHASE_8(pg8::EpiRope8<128>, E_, XN8, W_QKV, NQKV, DM);
    }
    SEAM(4);
    if (IN(5)) kmean_phase(F);
    SEAM(5);
    if (IN(6)) att::moba_own_phase(F);
    SEAM(6);
    if (IN(22)) att::moba_past_phase(F);
    if (IN(22) && IN(23)) GRID_BAR(22);
    if (IN(23)) att::moba_combine_phase(F);
    if (IN(23) && IN(25)) GRID_BAR(23);
    if (IN(25)) quant_rows_bf16(F, OB, XN8, SA);
    if (IN(25) && IN(7)) GRID_BAR(25);
    if (IN(7)) { pg8::EpiResid8 E_{F.out, F.out, DM, 1.0f, SA, COLMAX + CM_AO}; GEMM_PHASE_8(pg8::EpiResid8, E_, XN8, W_AO, DM, DM); }
    SEAM(7);
    if (IN(8)) norm_rows8<0>(F, F.out, XN8, SA, (bf16*)nullptr);
    SEAM(8);
    if (IN(9)) { FFN_UP(1);
        if (tailwg) { } }
    if (IN(9) && IN(28)) GRID_BAR(9);
    if (IN(28)) act_quant_phase(F, ACT, ACT8, SACT);
    if (IN(28) && IN(10)) GRID_BAR(28);
    if (IN(10)) FFN_DOWN(1, F.out);
    SEAM(10);
    if (IN(11)) norm_rows8<0>(F, F.out, XN8, SA, (bf16*)nullptr);
    SEAM(11);
    if (IN(12)) { { pg8::EpiRope8<64> E_{KSH, KSH, VSH, B_KVW, B_KVW, B_KVW, 0, 2, 1.0f, COSB, SINB, SA, COLMAX + CM_KV}; GEMM_PHASE_8(pg8::EpiRope8<64>, E_, XN8, W_KV, 2 * B_KVW, DM); }
                  FFN_UP(2);
                  }
    if (IN(12) && IN(29)) GRID_BAR(12);
    if (IN(29)) act_quant_phase(F, ACT, ACT8, SACT);
    if (IN(29) && IN(13)) GRID_BAR(29);
    if (IN(13)) FFN_DOWN(2, F.out);
    SEAM(13);
    if (IN(14)) norm_rows8<0>(F, F.out, XN8, SA, (bf16*)nullptr);
    SEAM(14);
    if (IN(15)) { pg8::EpiRope8<64> E_{QB, QB, QB, DM, DM, DM, 16, 0, 0.125f * LOG2E, COSB, SINB, SA, COLMAX + CM_BQ}; GEMM_PHASE_8(pg8::EpiRope8<64>, E_, XN8, W_BQ, DM, DM); }
    SEAM(15);
    if (IN(16)) att::swa_phase(F);
    if (IN(16) && IN(26)) GRID_BAR(16);
    if (IN(26)) quant_rows_bf16(F, OB, XN8, SA);
    if (IN(26) && IN(17)) GRID_BAR(26);
    if (IN(17)) { pg8::EpiResid8 E_{F.out, F.out, DM, 1.0f, SA, COLMAX + CM_BO}; GEMM_PHASE_8(pg8::EpiResid8, E_, XN8, W_BO, DM, DM); }
    SEAM(17);
    if (IN(18)) norm_rows8<0>(F, F.out, XN8, SA, (bf16*)nullptr);
    SEAM(18);
    if (IN(19)) FFN_UP(3);
    if (IN(19) && IN(30)) GRID_BAR(19);
    if (IN(30)) act_quant_phase(F, ACT, ACT8, SACT);
    if (IN(30) && IN(20)) GRID_BAR(30);
    if (IN(20)) FFN_DOWN(3, F.out);
    SEAM(20);
    if (IN(21)) { bool poison = false; if (!MK_SPLIT) poison = __hip_atomic_load((gu32*)((unsigned*)(F.ctl + CW_BAR) + XB_TMO), RLX_AGENT) != 0u;
                  final_norm_rows(F, F.out, F.final_norm, poison); }
#undef IN
#undef SEAM
#undef GRID_BAR
}

extern "C" void kernel_launch(void* const* d_in, const int* in_sizes, int n_in, void* d_out, int out_size, void* d_ws, size_t ws_size, hipStream_t stream) {
    static int grid = 0;
    if (grid == 0) {
        if (n_in != 13 || in_sizes[0] != M * DM || out_size != M * DM || ws_size < WS_END) { fprintf(stderr, "kernel_launch: unexpected shapes: n_in %d, in0 %d, out %d, ws %zu (need %zu); nothing launched\n", n_in, n_in > 0 ? in_sizes[0] : -1, out_size, ws_size, (size_t)WS_END); grid = -1; return; }
        int dev = 0, cus = 0, per_cu = 0;
        if (hipGetDevice(&dev) != hipSuccess || hipDeviceGetAttribute(&cus, hipDeviceAttributeMultiprocessorCount, dev) != hipSuccess) { fprintf(stderr, "kernel_launch: device query failed\n"); grid = -1; return; }
        if (hipFuncSetAttribute((const void*)yoco_fwd, hipFuncAttributeMaxDynamicSharedMemorySize, LDS_BYTES) != hipSuccess) { fprintf(stderr, "kernel_launch: hipFuncSetAttribute failed\n"); grid = -1; return; }
        if (hipOccupancyMaxActiveBlocksPerMultiprocessor(&per_cu, (const void*)yoco_fwd, NWAVES * 64, LDS_BYTES) != hipSuccess || per_cu < 1)
            fprintf(stderr, "kernel_launch: note: occupancy query reports %d workgroups per CU\n", per_cu);
        (void)hipGetLastError();
        grid = cus;
    }
    if (grid < 0) return;
    if (hipMemsetAsync((char*)d_ws + WS_CTL, 0, CTL_ZERO_BYTES, stream) != hipSuccess) { fprintf(stderr, "kernel_launch: hipMemsetAsync failed\n"); return; }
    Args a{};
    for (int i = 0; i < 13; ++i) a.in[i] = (const float*)d_in[i];
    a.out = (float*)d_out; a.ws = (unsigned char*)d_ws;
#if MK_SPLIT
    static const int order[N_PHASES] = {0, 24, 1, 27, 2, 3, 4, 5, 6, 22, 23, 25, 7, 8, 9, 28, 10, 11, 12, 29, 13, 14, 15, 16, 26, 17, 18, 19, 30, 20, 21};
    for (int k = 0; k < N_PHASES; ++k) { a.ph_lo = order[k]; a.ph_hi = order[k] + 1; hipLaunchKernelGGL(yoco_fwd, dim3(grid), dim3(NWAVES * 64), LDS_BYTES, stream, a); }
#else
    a.ph_lo = 0; a.ph_hi = N_PHASES;
    hipLaunchKernelGGL(yoco_fwd, dim3(grid), dim3(NWAVES * 64), LDS_BYTES, stream, a);
#endif
    const hipError_t le = hipPeekAtLastError();
    if (le != hipSuccess) fprintf(stderr, "kernel_launch: launch failed: %s\n", hipGetErrorName(le));
}
```

```cpp
#include <hip/hip_runtime.h>
#include <cstdio>
#include <cstdint>
#include <cmath>
namespace pg8 {
#define PG8_LAS __attribute__((address_space(3)))
typedef unsigned short bf16_t;
typedef short bf16x8 __attribute__((ext_vector_type(8)));
typedef float f32x4 __attribute__((ext_vector_type(4)));
typedef unsigned u32x4 __attribute__((ext_vector_type(4)));
typedef unsigned u32x2 __attribute__((ext_vector_type(2)));
constexpr int BM = 256, BK = 64, HALF = 128, HTB = HALF * BK * 2  , STAGE_BYTES = 8 * HTB, NXCD = 8, WGM = 8;

__host__ __device__ __forceinline__ int lds_byte(int r, int c) { const int st = (r >> 4) * 2 + (c >> 5), rr = r & 15, cc = c & 31, ob = rr * 64 + cc * 2; return st * 1024 + (ob ^ (((ob >> 9) & 1) << 5)); }
__host__ __device__ __forceinline__ void stage_rc(int b, int& R, int& C) { const int st = b / 1024, sb = b % 1024, swz = sb ^ (((sb >> 9) & 1) << 5); R = (st >> 1) * 16 + swz / 64; C = (st & 1) * 32 + (swz % 64) / 2; }
__host__ __device__ __forceinline__ int perm32(int rho) { const int n = rho >> 4, i = rho & 15; return 8 * (i >> 2) + 4 * n + (i & 3); }

__host__ __device__ __forceinline__ size_t tiled_off(int r, int k, int K) { return (size_t)(r >> 8) * ((size_t)BM * K) + (size_t)(k >> 6) * (BM * BK) + (size_t)(r & 255) * BK + (k & 63); }
typedef int i32x4 __attribute__((ext_vector_type(4)));
template <bool I8> struct AccType { typedef f32x4 type; };
template <> struct AccType<true> { typedef i32x4 type; };
__device__ __forceinline__ f32x4 mma16(bf16x8 a, bf16x8 b, f32x4 c) { return __builtin_amdgcn_mfma_f32_16x16x32_bf16(a, b, c, 0, 0, 0); }
__device__ __forceinline__ i32x4 mma16(bf16x8 a, bf16x8 b, i32x4 c) { return __builtin_amdgcn_mfma_i32_16x16x64_i8(__builtin_bit_cast(i32x4, a), __builtin_bit_cast(i32x4, b), c, 0, 0, 0); }
struct Unit { int pm, pn; };
struct Gemm { const bf16_t* A; const bf16_t* Bt; int M, N, K; };

struct StaticOrder {
    int nM, nN, nwg, G, c, wgm, i0, i1;
    __host__ __device__ void init(int M, int N, int G_, int c_, int wgm_ = WGM, int i0_ = 0, int i1_ = 1 << 20) { nM = M / BM; nN = N / BM; nwg = nM * nN; G = G_; c = c_; wgm = wgm_; i0 = i0_; i1 = i1_; }
    __host__ __device__ void decode(long L, Unit& u) const {
        int wgid = (int)L; { const int q = nwg / NXCD, r = nwg % NXCD, xcd = wgid % NXCD, off = wgid / NXCD; wgid = (xcd < r ? xcd * (q + 1) : r * (q + 1) + (xcd - r) * q) + off; }
        const int nig = wgm * nN, gid = wgid / nig, fm = gid * wgm, gsz = (nM - fm) < wgm ? (nM - fm) : wgm;
        u.pm = fm + ((wgid % nig) % gsz); u.pn = (wgid % nig) / gsz;
    }
    __host__ __device__ bool next(int i, Unit& u) const {
        if (i + i0 >= i1) return false;
        const long L = (long)(i + i0) * G + c; if (L >= nwg) return false;
        decode(L, u); return true;
    }
    __device__ __forceinline__ void a_ready(const Unit&) const {}
    __device__ __forceinline__ void done(const Unit&) const {}
};
struct ClaimOrder : StaticOrder {
    int nfull, nleft; unsigned* ctr; volatile PG8_LAS unsigned* slot;
    __device__ void setup(unsigned* ctr_, volatile PG8_LAS unsigned* slot_) { nfull = nwg / G; nleft = nwg - nfull * G; ctr = ctr_; slot = slot_; }
    __device__ __forceinline__ bool next(int i, Unit& u) const {
        if (i < nfull) { decode((long)i * G + c, u); return true; }
        if (i > nfull || nleft == 0) return false;
        if (threadIdx.x == 0) { const unsigned id = __hip_atomic_fetch_add(ctr, 1u, __ATOMIC_RELAXED, __HIP_MEMORY_SCOPE_AGENT); *slot = id; }
        asm volatile("s_waitcnt lgkmcnt(0)" ::: "memory"); __builtin_amdgcn_s_barrier(); asm volatile("" ::: "memory");
        const unsigned id = *slot;
        if (id >= (unsigned)nleft) return false;
        decode((long)nfull * G + id, u); return true;
    }
};
__device__ __forceinline__ unsigned cvt_pk_bf16(float lo, float hi) { unsigned r; asm volatile("v_cvt_pk_bf16_f32 %0, %1, %2" : "=v"(r) : "v"(lo), "v"(hi)); return r; }
__device__ __forceinline__ float silu_mul(float g, float u) { return g * u * __builtin_amdgcn_rcpf(1.0f + __builtin_amdgcn_exp2f(g * -1.4426950408889634f)); }
#ifndef ACT_DROP
#define ACT_DROP 0
#endif
struct EpiSwiGLU {
    static constexpr bool PERM = true, AFTER_DRAIN = false;
    bf16_t* O; int ldc;
    __device__ __forceinline__ void operator()(const f32x4 (&acc)[2][2][4][2], const Unit& u, int wr, int wc, int fr, int fq) const {
        const int row0 = u.pm * BM + wr * 64 + fr, col0 = u.pn * HALF + wc * 32 + 8 * fq;
#pragma unroll
        for (int ai = 0; ai < 2; ++ai)
#pragma unroll
            for (int m = 0; m < 4; ++m) { bf16_t* p = O + tiled_off(row0 + ai * HALF + m * 16, col0, ldc);
                const f32x4 g0 = acc[ai][0][m][0], g1 = acc[ai][0][m][1], u0 = acc[ai][1][m][0], u1 = acc[ai][1][m][1];
                u32x4 w; w.x = cvt_pk_bf16(silu_mul(g0[0], u0[0]), silu_mul(g0[1], u0[1])); w.y = cvt_pk_bf16(silu_mul(g0[2], u0[2]), silu_mul(g0[3], u0[3]));
                w.z = cvt_pk_bf16(silu_mul(g1[0], u1[0]), silu_mul(g1[1], u1[1])); w.w = cvt_pk_bf16(silu_mul(g1[2], u1[2]), silu_mul(g1[3], u1[3]));
                if (ACT_DROP > 0) { constexpr unsigned add_ = ((1u << ACT_DROP) >> 1) * 0x00010001u, msk_ = ~(((1u << ACT_DROP) - 1u) * 0x00010001u);
                    w.x = (w.x + add_) & msk_; w.y = (w.y + add_) & msk_; w.z = (w.z + add_) & msk_; w.w = (w.w + add_) & msk_; }
                *(u32x4*)p = w; }
    }
};
struct EpiSwiGLU8 {
    static constexpr bool PERM = true, AFTER_DRAIN = false;
    bf16_t* O; int ldc; const float* sA; const float* colmax;
    __device__ __forceinline__ void operator()(const i32x4 (&acc)[2][2][4][2], const Unit& u, int wr, int wc, int fr, int fq) const {
        const int row0 = u.pm * BM + wr * 64 + fr, col0 = u.pn * HALF + wc * 32 + 8 * fq;
        const f32x4 sg0 = *(const f32x4*)(colmax + col0) * (1.0f / 127.0f), sg1 = *(const f32x4*)(colmax + col0 + 4) * (1.0f / 127.0f);
        const f32x4 su0 = *(const f32x4*)(colmax + ldc + col0) * (1.0f / 127.0f), su1 = *(const f32x4*)(colmax + ldc + col0 + 4) * (1.0f / 127.0f);
        float rs[2][4];
#pragma unroll
        for (int ai = 0; ai < 2; ++ai)
#pragma unroll
            for (int m = 0; m < 4; ++m) rs[ai][m] = sA[row0 + ai * HALF + m * 16];
#pragma unroll
        for (int ai = 0; ai < 2; ++ai)
#pragma unroll
            for (int m = 0; m < 4; ++m) { bf16_t* p = O + (size_t)(row0 + ai * HALF + m * 16) * ldc + col0; const float r = rs[ai][m];
                const f32x4 g0 = __builtin_convertvector(acc[ai][0][m][0], f32x4) * sg0 * r, g1 = __builtin_convertvector(acc[ai][0][m][1], f32x4) * sg1 * r;
                const f32x4 u0 = __builtin_convertvector(acc[ai][1][m][0], f32x4) * su0 * r, u1 = __builtin_convertvector(acc[ai][1][m][1], f32x4) * su1 * r;
                u32x4 w; w.x = cvt_pk_bf16(silu_mul(g0[0], u0[0]), silu_mul(g0[1], u0[1])); w.y = cvt_pk_bf16(silu_mul(g0[2], u0[2]), silu_mul(g0[3], u0[3]));
                w.z = cvt_pk_bf16(silu_mul(g1[0], u1[0]), silu_mul(g1[1], u1[1])); w.w = cvt_pk_bf16(silu_mul(g1[2], u1[2]), silu_mul(g1[3], u1[3]));
                *(u32x4*)p = w; }
    }
};
struct EpiResid {
    static constexpr bool PERM = false, AFTER_DRAIN = false;
    const float* base; float* out; int ldc; float alpha;
    __device__ __forceinline__ void operator()(const f32x4 (&acc)[2][2][4][2], const Unit& u, int wr, int wc, int fr, int fq) const {
        const int row0 = u.pm * BM + wr * 64 + fr, col0 = u.pn * BM + wc * 32 + 4 * fq;
#pragma unroll
        for (int ai = 0; ai < 2; ++ai)
#pragma unroll
            for (int m = 0; m < 4; ++m) { const size_t off = (size_t)(row0 + ai * HALF + m * 16) * ldc + col0;
#pragma unroll
                for (int bj = 0; bj < 2; ++bj)
#pragma unroll
                    for (int n = 0; n < 2; ++n) { const f32x4 b = *(const f32x4*)(base + off + bj * HALF + n * 16); *(f32x4*)(out + off + bj * HALF + n * 16) = b + acc[ai][bj][m][n] * alpha; }
                asm volatile("" ::: "memory"); }
    }
};
template <int DH> struct EpiRope {
    static constexpr bool PERM = true, AFTER_DRAIN = false;
    bf16_t *dq, *dk, *dv; int ldq, ldk, ldv, nq, nk; float qscale; const float *cosT, *sinT;
    __device__ __forceinline__ void operator()(const f32x4 (&acc)[2][2][4][2], const Unit& u, int wr, int wc, int fr, int fq) const {
        const int row0 = u.pm * BM + wr * 64 + fr;
        if (u.pn >= nq + nk) {
            const int col0 = (u.pn - nq - nk) * BM + wc * 32 + 8 * fq;
#pragma unroll
            for (int ai = 0; ai < 2; ++ai)
#pragma unroll
                for (int m = 0; m < 4; ++m) { bf16_t* p = dv + (size_t)(row0 + ai * HALF + m * 16) * ldv + col0;
#pragma unroll
                    for (int bj = 0; bj < 2; ++bj) { const f32x4 v0 = acc[ai][bj][m][0], v1 = acc[ai][bj][m][1];
                        u32x4 w; w.x = cvt_pk_bf16(v0[0], v0[1]); w.y = cvt_pk_bf16(v0[2], v0[3]); w.z = cvt_pk_bf16(v1[0], v1[1]); w.w = cvt_pk_bf16(v1[2], v1[3]);
                        *(u32x4*)(p + bj * HALF) = w; } }
            return;
        }
        const bool isq = u.pn < nq; bf16_t* dst = isq ? dq : dk; const int ld = isq ? ldq : ldk, pt = isq ? u.pn : u.pn - nq; const float sc = isq ? qscale : 1.0f;
        constexpr int HD2 = DH / 2, HPT = BM / DH;
        const int t = wc * 32 + 8 * fq, hl = t / HD2, i0 = t % HD2, col1 = (HPT * pt + hl) * DH + i0;
#pragma unroll
        for (int ai = 0; ai < 2; ++ai)
#pragma unroll
            for (int m = 0; m < 4; ++m) { const int row = row0 + ai * HALF + m * 16;
                const f32x4 c0 = *(const f32x4*)(cosT + (size_t)row * HD2 + i0), c1 = *(const f32x4*)(cosT + (size_t)row * HD2 + i0 + 4);
                const f32x4 s0 = *(const f32x4*)(sinT + (size_t)row * HD2 + i0), s1 = *(const f32x4*)(sinT + (size_t)row * HD2 + i0 + 4);
                const f32x4 xa0 = acc[ai][0][m][0], xa1 = acc[ai][0][m][1], xb0 = acc[ai][1][m][0], xb1 = acc[ai][1][m][1];
                const f32x4 o10 = (xa0 * c0 - xb0 * s0) * sc, o11 = (xa1 * c1 - xb1 * s1) * sc, o20 = (xb0 * c0 + xa0 * s0) * sc, o21 = (xb1 * c1 + xa1 * s1) * sc;
                bf16_t* p = dst + (size_t)row * ld + col1;
                u32x4 w; w.x = cvt_pk_bf16(o10[0], o10[1]); w.y = cvt_pk_bf16(o10[2], o10[3]); w.z = cvt_pk_bf16(o11[0], o11[1]); w.w = cvt_pk_bf16(o11[2], o11[3]);
                *(u32x4*)p = w;
                w.x = cvt_pk_bf16(o20[0], o20[1]); w.y = cvt_pk_bf16(o20[2], o20[3]); w.z = cvt_pk_bf16(o21[0], o21[1]); w.w = cvt_pk_bf16(o21[2], o21[3]);
                *(u32x4*)(p + HD2) = w;
                asm volatile("" ::: "memory"); }
    }
};
template <int DH> struct EpiRope8 {
    static constexpr bool PERM = true, AFTER_DRAIN = false;
    bf16_t *dq, *dk, *dv; int ldq, ldk, ldv, nq, nk; float qscale; const float *cosT, *sinT; const float* sA; const float* colmax;
    __device__ __forceinline__ void operator()(const i32x4 (&acc)[2][2][4][2], const Unit& u, int wr, int wc, int fr, int fq) const {
        const int row0 = u.pm * BM + wr * 64 + fr;
        float rs[2][4];
#pragma unroll
        for (int ai = 0; ai < 2; ++ai)
#pragma unroll
            for (int m = 0; m < 4; ++m) rs[ai][m] = sA[row0 + ai * HALF + m * 16];
        if (u.pn >= nq + nk) {
            const int col0 = (u.pn - nq - nk) * BM + wc * 32 + 8 * fq, src0 = u.pn * BM + wc * 32 + 8 * fq;
            f32x4 sc[2][2];
#pragma unroll
            for (int bj = 0; bj < 2; ++bj) { sc[bj][0] = *(const f32x4*)(colmax + src0 + bj * HALF) * (1.0f / 127.0f); sc[bj][1] = *(const f32x4*)(colmax + src0 + bj * HALF + 4) * (1.0f / 127.0f); }
#pragma unroll
            for (int ai = 0; ai < 2; ++ai)
#pragma unroll
                for (int m = 0; m < 4; ++m) { bf16_t* p = dv + (size_t)(row0 + ai * HALF + m * 16) * ldv + col0; const float r = rs[ai][m];
#pragma unroll
                    for (int bj = 0; bj < 2; ++bj) { const f32x4 v0 = __builtin_convertvector(acc[ai][bj][m][0], f32x4) * sc[bj][0] * r, v1 = __builtin_convertvector(acc[ai][bj][m][1], f32x4) * sc[bj][1] * r;
                        u32x4 w; w.x = cvt_pk_bf16(v0[0], v0[1]); w.y = cvt_pk_bf16(v0[2], v0[3]); w.z = cvt_pk_bf16(v1[0], v1[1]); w.w = cvt_pk_bf16(v1[2], v1[3]);
                        *(u32x4*)(p + bj * HALF) = w; } }
            return;
        }
        const bool isq = u.pn < nq; bf16_t* dst = isq ? dq : dk; const int ld = isq ? ldq : ldk, pt = isq ? u.pn : u.pn - nq; const float scq = isq ? qscale : 1.0f;
        constexpr int HD2 = DH / 2, HPT = BM / DH;
        const int t = wc * 32 + 8 * fq, hl = t / HD2, i0 = t % HD2, col1 = (HPT * pt + hl) * DH + i0, src1 = (HPT * u.pn + hl) * DH + i0;
        const f32x4 sa0 = *(const f32x4*)(colmax + src1) * (1.0f / 127.0f), sa1 = *(const f32x4*)(colmax + src1 + 4) * (1.0f / 127.0f);
        const f32x4 sb0 = *(const f32x4*)(colmax + src1 + HD2) * (1.0f / 127.0f), sb1 = *(const f32x4*)(colmax + src1 + HD2 + 4) * (1.0f / 127.0f);
#pragma unroll
        for (int ai = 0; ai < 2; ++ai)
#pragma unroll
            for (int m = 0; m < 4; ++m) { const int row = row0 + ai * HALF + m * 16; const float r = rs[ai][m];
                const f32x4 c0 = *(const f32x4*)(cosT + (size_t)row * HD2 + i0), c1 = *(const f32x4*)(cosT + (size_t)row * HD2 + i0 + 4);
                const f32x4 s0 = *(const f32x4*)(sinT + (size_t)row * HD2 + i0), s1 = *(const f32x4*)(sinT + (size_t)row * HD2 + i0 + 4);
                const f32x4 xa0 = __builtin_convertvector(acc[ai][0][m][0], f32x4) * sa0 * r, xa1 = __builtin_convertvector(acc[ai][0][m][1], f32x4) * sa1 * r;
                const f32x4 xb0 = __builtin_convertvector(acc[ai][1][m][0], f32x4) * sb0 * r, xb1 = __builtin_convertvector(acc[ai][1][m][1], f32x4) * sb1 * r;
                const f32x4 o10 = (xa0 * c0 - xb0 * s0) * scq, o11 = (xa1 * c1 - xb1 * s1) * scq, o20 = (xb0 * c0 + xa0 * s0) * scq, o21 = (xb1 * c1 + xa1 * s1) * scq;
                bf16_t* p = dst + (size_t)row * ld + col1;
                u32x4 w; w.x = cvt_pk_bf16(o10[0], o10[1]); w.y = cvt_pk_bf16(o10[2], o10[3]); w.z = cvt_pk_bf16(o11[0], o11[1]); w.w = cvt_pk_bf16(o11[2], o11[3]);
                *(u32x4*)p = w;
                w.x = cvt_pk_bf16(o20[0], o20[1]); w.y = cvt_pk_bf16(o20[2], o20[3]); w.z = cvt_pk_bf16(o21[0], o21[1]); w.w = cvt_pk_bf16(o21[2], o21[3]);
                *(u32x4*)(p + HD2) = w;
                asm volatile("" ::: "memory"); }
    }
};
struct EpiResid8 {
    static constexpr bool PERM = false, AFTER_DRAIN = false;
    const float* base; bf16_t* xr; int ldc; float alpha; const float* sA; const float* colmax;
    __device__ __forceinline__ void operator()(const i32x4 (&acc)[2][2][4][2], const Unit& u, int wr, int wc, int fr, int fq) const {
        const int row0 = u.pm * BM + wr * 64 + fr, col0 = u.pn * BM + wc * 32 + 4 * fq;
        f32x4 sc[2][2];
#pragma unroll
        for (int bj = 0; bj < 2; ++bj)
#pragma unroll
            for (int n = 0; n < 2; ++n) sc[bj][n] = *(const f32x4*)(colmax + col0 + bj * HALF + n * 16) * (alpha * (1.0f / 127.0f));
        float rs[2][4];
#pragma unroll
        for (int ai = 0; ai < 2; ++ai)
#pragma unroll
            for (int m = 0; m < 4; ++m) rs[ai][m] = sA[row0 + ai * HALF + m * 16];
#pragma unroll
        for (int ai = 0; ai < 2; ++ai)
#pragma unroll
            for (int m = 0; m < 4; ++m) { const size_t off = (size_t)(row0 + ai * HALF + m * 16) * ldc + col0; const float r = rs[ai][m];
#pragma unroll
                for (int bj = 0; bj < 2; ++bj)
#pragma unroll
                    for (int n = 0; n < 2; ++n) { f32x4 b;
                        if (base) b = *(const f32x4*)(base + off + bj * HALF + n * 16);
                        else { const u32x2 w = *(const u32x2*)(xr + off + bj * HALF + n * 16); b[0] = __builtin_bit_cast(float, w.x << 16); b[1] = __builtin_bit_cast(float, w.x & 0xffff0000u); b[2] = __builtin_bit_cast(float, w.y << 16); b[3] = __builtin_bit_cast(float, w.y & 0xffff0000u); }
                        const f32x4 o = b + __builtin_convertvector(acc[ai][bj][m][n], f32x4) * sc[bj][n] * r;
                        u32x2 y; y.x = cvt_pk_bf16(o[0], o[1]); y.y = cvt_pk_bf16(o[2], o[3]); *(u32x2*)(xr + off + bj * HALF + n * 16) = y; }
                asm volatile("" ::: "memory"); }
    }
};
template <class Epi, class Sched, bool ALIGN_EPI = false, bool SP2 = false, bool TA = false, bool TB = false, bool I8 = false>
__device__ __forceinline__ void gemm_phase(PG8_LAS unsigned char* lds, const Gemm g, const Sched& S, const Epi& E) {
    const int tid = threadIdx.x, wid = __builtin_amdgcn_readfirstlane(tid >> 6), lane = tid & 63, wr = wid >> 2, wc = wid & 3, fr = lane & 15, fq = lane >> 4;
    const int KB = I8 ? g.K : 2 * g.K, nt = KB / (BK * 2);
    unsigned voffA[2], voffB[2];
#pragma unroll
    for (int i = 0; i < 2; ++i) { int R, C; stage_rc(tid * 16 + i * 8192, R, C); const int Rb = Epi::PERM ? ((R & ~31) + perm32(R & 31)) : R;
        voffA[i] = (unsigned)(R * (TA ? BK * 2 : KB) + C * 2); voffB[i] = (unsigned)(Rb * (TB ? BK * 2 : KB) + C * 2); }
    const size_t kstepA = TA ? (size_t)(BM * BK * 2) : (size_t)(BK * 2), kstepB = TB ? (size_t)(BM * BK * 2) : (size_t)(BK * 2);
    const size_t hstepA = TA ? (size_t)(HALF * BK * 2) : (size_t)HALF * KB, hstepB = TB ? (size_t)(HALF * BK * 2) : (size_t)HALF * KB;
    const size_t tstep = (size_t)BM * KB;
    const unsigned ldsw = (unsigned)wid * 1024u;
    const int aoff = lds_byte(wr * 64 + fr, fq * 8), boff = lds_byte(wc * 32 + fr, fq * 8);
#define PG8_SA(b, h) (((b) * 2 + (h)) * HTB)
#define PG8_SB(b, h) ((4 + (b) * 2 + (h)) * HTB)
#define PG8_STAGE(bufoff, gbase, voff) do { _Pragma("unroll") for (int _i = 0; _i < 2; ++_i) \
        __builtin_amdgcn_global_load_lds((const unsigned*)((const char*)(gbase) + (voff)[_i]), (PG8_LAS unsigned*)(lds + (bufoff) + ldsw + _i * 8192), 16, 0, 0); } while (0)
#define PG8_LDA(dst, b, h) do { _Pragma("unroll") for (int m = 0; m < 4; ++m) _Pragma("unroll") for (int k = 0; k < 2; ++k) dst[m][k] = *(const PG8_LAS bf16x8*)(lds + PG8_SA(b, h) + aoff + m * 2048 + k * 1024); } while (0)
#define PG8_LDB(dst, b, h) do { _Pragma("unroll") for (int n = 0; n < 2; ++n) _Pragma("unroll") for (int k = 0; k < 2; ++k) dst[n][k] = *(const PG8_LAS bf16x8*)(lds + PG8_SB(b, h) + boff + n * 2048 + k * 1024); } while (0)
#define PG8_MMA(ai, bj, At, Bt) do { __builtin_amdgcn_s_setprio(1); _Pragma("unroll") for (int m = 0; m < 4; ++m) _Pragma("unroll") for (int n = 0; n < 2; ++n) _Pragma("unroll") for (int k = 0; k < 2; ++k) \
        acc[ai][bj][m][n] = mma16(Bt[n][k], At[m][k], acc[ai][bj][m][n]); __builtin_amdgcn_s_setprio(0); } while (0)
#define PG8_WAIT_V(n) asm volatile("s_waitcnt vmcnt(" #n ")" ::: "memory")
#define PG8_WAIT_L(n) asm volatile("s_waitcnt lgkmcnt(" #n ")" ::: "memory")
#define PG8_BAR __builtin_amdgcn_s_barrier()
#define PG8_SCHED __builtin_amdgcn_sched_barrier(0)
    Unit cur, nxt; int ui = 0;
    if (!S.next(0, cur)) return;
    typedef typename AccType<I8>::type accv;
    accv acc[2][2][4][2];
#pragma unroll
    for (int a = 0; a < 2; ++a)
#pragma unroll
        for (int b = 0; b < 2; ++b)
#pragma unroll
            for (int m = 0; m < 4; ++m)
#pragma unroll
                for (int n = 0; n < 2; ++n) acc[a][b][m][n] = (accv){0, 0, 0, 0};
    bf16x8 At[4][2], B0[2][2], B1[2][2];
    const char* cA = (const char*)g.A + (size_t)cur.pm * tstep; const char* cB = (const char*)g.Bt + (size_t)cur.pn * tstep;
    S.a_ready(cur);
    if constexpr (SP2) {
        PG8_STAGE(PG8_SB(0, 0), cB, voffB); PG8_STAGE(PG8_SB(0, 1), cB + hstepB, voffB); PG8_STAGE(PG8_SA(0, 0), cA, voffA); PG8_STAGE(PG8_SA(0, 1), cA + hstepA, voffA);
        if (wr == 1) PG8_BAR;
        PG8_WAIT_V(2); PG8_BAR;
        PG8_STAGE(PG8_SB(1, 0), cB + kstepB, voffB); PG8_STAGE(PG8_SA(1, 0), cA + kstepA, voffA); PG8_STAGE(PG8_SB(1, 1), cB + hstepB + kstepB, voffB);
        PG8_WAIT_V(6); PG8_BAR;
    } else {
        PG8_STAGE(PG8_SB(0, 0), cB, voffB); PG8_STAGE(PG8_SA(0, 0), cA, voffA); PG8_STAGE(PG8_SB(0, 1), cB + hstepB, voffB); PG8_STAGE(PG8_SA(0, 1), cA + hstepA, voffA);
        if (wr == 1) PG8_BAR;
        PG8_WAIT_V(4); PG8_BAR;
        PG8_STAGE(PG8_SB(1, 0), cB + kstepB, voffB); PG8_STAGE(PG8_SA(1, 0), cA + kstepA, voffA); PG8_STAGE(PG8_SB(1, 1), cB + hstepB + kstepB, voffB);
        PG8_WAIT_V(6); PG8_BAR;
    }
    for (;;) {
        const bool has_next = S.next(ui + 1, nxt);
        const char* nA = has_next ? (const char*)g.A + (size_t)nxt.pm * tstep : cA; const char* nB = has_next ? (const char*)g.Bt + (size_t)nxt.pn * tstep : cB;
        for (int t = 0; t < nt; t += 2) {
            const bool last = (t == nt - 2);
            const char* a1 = cA + (size_t)(t + 1) * kstepA;
            const char* a2 = last ? nA : cA + (size_t)(t + 2) * kstepA; const char* b2 = last ? nB : cB + (size_t)(t + 2) * kstepB;
            const char* a3 = a2 + kstepA; const char* b3 = b2 + kstepB;
            if (last && has_next) S.a_ready(nxt);
            if constexpr (SP2) {
            PG8_LDB(B0, 0, 0); PG8_LDB(B1, 0, 1); PG8_SCHED; PG8_LDA(At, 0, 0); PG8_STAGE(PG8_SA(1, 1), a1 + hstepA, voffA);
            PG8_WAIT_V(8); PG8_WAIT_L(0); PG8_BAR; PG8_MMA(0, 0, At, B0); PG8_MMA(0, 1, At, B1); PG8_BAR; PG8_SCHED;
            PG8_LDA(At, 0, 1); PG8_STAGE(PG8_SB(0, 0), b2, voffB); PG8_STAGE(PG8_SB(0, 1), b2 + hstepB, voffB); PG8_STAGE(PG8_SA(0, 0), a2, voffA);
            PG8_WAIT_V(8); PG8_WAIT_L(0); PG8_BAR; PG8_MMA(1, 0, At, B0); PG8_MMA(1, 1, At, B1); PG8_BAR; PG8_SCHED;
            PG8_LDB(B0, 1, 0); PG8_LDB(B1, 1, 1); PG8_SCHED; PG8_LDA(At, 1, 0); PG8_STAGE(PG8_SA(0, 1), a2 + hstepA, voffA);
            PG8_WAIT_V(8); PG8_WAIT_L(0); PG8_BAR; PG8_MMA(0, 0, At, B0); PG8_MMA(0, 1, At, B1); PG8_BAR; PG8_SCHED;
            PG8_LDA(At, 1, 1); PG8_STAGE(PG8_SB(1, 0), b3, voffB); PG8_STAGE(PG8_SB(1, 1), b3 + hstepB, voffB); PG8_STAGE(PG8_SA(1, 0), a3, voffA);
            PG8_WAIT_V(8); PG8_WAIT_L(0); PG8_BAR; PG8_MMA(1, 0, At, B0); PG8_MMA(1, 1, At, B1); PG8_BAR; PG8_SCHED;
            } else {
            PG8_LDB(B0, 0, 0); PG8_SCHED; PG8_LDA(At, 0, 0); PG8_STAGE(PG8_SA(1, 1), a1 + hstepA, voffA);
            PG8_WAIT_L(8); PG8_BAR; PG8_WAIT_L(0); PG8_MMA(0, 0, At, B0); PG8_BAR; PG8_SCHED;
            PG8_LDB(B1, 0, 1); PG8_STAGE(PG8_SB(0, 0), b2, voffB);
            PG8_BAR; PG8_WAIT_L(0); PG8_MMA(0, 1, At, B1); PG8_BAR;
            PG8_LDA(At, 0, 1); PG8_STAGE(PG8_SA(0, 0), a2, voffA);
            PG8_BAR; PG8_WAIT_L(0); PG8_MMA(1, 0, At, B0); PG8_BAR; PG8_SCHED;
            PG8_STAGE(PG8_SB(0, 1), b2 + hstepB, voffB);
            PG8_WAIT_V(6); PG8_BAR; PG8_MMA(1, 1, At, B1); PG8_BAR;
            PG8_LDB(B0, 1, 0); PG8_SCHED; PG8_LDA(At, 1, 0); PG8_STAGE(PG8_SA(0, 1), a2 + hstepA, voffA);
            PG8_WAIT_L(8); PG8_BAR; PG8_WAIT_L(0); PG8_MMA(0, 0, At, B0); PG8_BAR; PG8_SCHED;
            PG8_LDB(B1, 1, 1); PG8_STAGE(PG8_SB(1, 0), b3, voffB);
            PG8_BAR; PG8_WAIT_L(0); PG8_MMA(0, 1, At, B1); PG8_BAR;
            PG8_LDA(At, 1, 1); PG8_STAGE(PG8_SA(1, 0), a3, voffA);
            PG8_BAR; PG8_WAIT_L(0); PG8_MMA(1, 0, At, B0); PG8_BAR; PG8_SCHED;
            PG8_STAGE(PG8_SB(1, 1), b3 + hstepB, voffB);
            PG8_WAIT_V(6); PG8_BAR; PG8_MMA(1, 1, At, B1); PG8_BAR;
            }
        }
        if constexpr (ALIGN_EPI) { if (wr == 0) PG8_BAR; }
        if constexpr (!Epi::AFTER_DRAIN) { E(acc, cur, wr, wc, fr, fq); S.done(cur); }
        if (!has_next) break;
#pragma unroll
        for (int a = 0; a < 2; ++a)
#pragma unroll
            for (int b = 0; b < 2; ++b)
#pragma unroll
                for (int m = 0; m < 4; ++m)
#pragma unroll
                    for (int n = 0; n < 2; ++n) acc[a][b][m][n] = (accv){0, 0, 0, 0};
        cur = nxt; cA = nA; cB = nB; ++ui;
        if constexpr (ALIGN_EPI) { if (wr == 1) PG8_BAR; }
    }
    PG8_WAIT_V(0);
    if constexpr (!ALIGN_EPI) { if (wr == 0) PG8_BAR; }
    PG8_BAR;
    if constexpr (Epi::AFTER_DRAIN) { E.fused(acc, cur, wr, wc, fr, fq, lds, wid, lane); S.done(cur); }
#undef PG8_SA
#undef PG8_SB
#undef PG8_STAGE
#undef PG8_LDA
#undef PG8_LDB
#undef PG8_MMA
#undef PG8_WAIT_V
#undef PG8_WAIT_L
#undef PG8_BAR
#undef PG8_SCHED
}
}
constexpr int NWAVES = 8;
#ifndef MK_SPLIT
#define MK_SPLIT 0
#endif
#ifndef PG8_SP2
#define PG8_SP2 true
#endif
#ifndef PG8_ALIGN
#define PG8_ALIGN true
#endif
#ifndef XN_TILED
#define XN_TILED false
#endif
constexpr int N_PHASES = 31;

constexpr int SEQ = 16384, DM = 4096, DFF = 11008, M = SEQ;
constexpr int A_H = 32, A_D = 128, A_KVW = 1024, NQKV = 6144;
constexpr int B_H = 64, B_D = 64, B_KVW = 512;
constexpr int NBLK = 64;
constexpr float RMS_EPS = 1e-6f;
constexpr float LOG2E = 1.4426950408889634f;

constexpr size_t MiB = 1u << 20;
constexpr size_t WS_CTL = 0, CTL_ZERO_BYTES = 1 * MiB;
constexpr size_t SZ_WIN = 172 * MiB, SZ_WOUT = 86 * MiB;
constexpr size_t WS_WIN = 1 * MiB;
constexpr size_t WS_WOUT = WS_WIN + 4 * SZ_WIN;
constexpr size_t WS_WQKV = WS_WOUT + 4 * SZ_WOUT;
constexpr size_t WS_WAO = WS_WQKV + 48 * MiB;
constexpr size_t WS_WKV = WS_WAO + 32 * MiB;
constexpr size_t WS_WBQ = WS_WKV + 8 * MiB;
constexpr size_t WS_WBO = WS_WBQ + 32 * MiB;
constexpr size_t WS_XN = WS_WBO + 32 * MiB;
constexpr size_t WS_ACT = WS_XN + 128 * MiB;
constexpr size_t WS_Q = WS_ACT + 344 * MiB;
constexpr size_t WS_K = WS_Q + 128 * MiB;
constexpr size_t WS_V = WS_K + 32 * MiB;
constexpr size_t WS_O = WS_V + 32 * MiB;
constexpr size_t WS_KSH = WS_O + 128 * MiB;
constexpr size_t WS_VSH = WS_KSH + 16 * MiB;
constexpr size_t WS_ROPEA = WS_VSH + 16 * MiB;
constexpr size_t WS_ROPEB = WS_ROPEA + 8 * MiB;
constexpr size_t WS_KMEAN = WS_ROPEB + 4 * MiB;
constexpr size_t WS_LIST = WS_KMEAN + 1 * MiB;
constexpr size_t WS_PARTO = WS_LIST + 63 * MiB;
constexpr size_t WS_PARTML = WS_PARTO + 512 * MiB;
constexpr size_t WS_XN8 = WS_PARTML + 16 * MiB;
constexpr size_t WS_SA = WS_XN8 + 64 * MiB;
constexpr size_t WS_ACT8 = WS_SA + 1 * MiB;
constexpr size_t WS_SACT = WS_ACT8 + 172 * MiB;
constexpr size_t WS_END = WS_SACT + 1 * MiB;
static_assert(SZ_WIN == (size_t)22016 * 4096 * 2 && SZ_WOUT == (size_t)4096 * 11008 * 2, "weight sizes");
constexpr int CW_TMO = 0, CW_CODE = 1;
constexpr int CW_BAR = 4096;
constexpr int CW_CLAIM = 12288;
constexpr int CW_COLMAX = 32768;
constexpr int CW_CNT = 8192;

constexpr int RING_OFF = 0, RING_BYTES = 131072;
constexpr int LDSCTL_OFF = 146944, MISC_OFF = LDSCTL_OFF + 256;
constexpr int LDS_BYTES = 147456;
static_assert(MISC_OFF + 128 <= 147456 && RING_BYTES <= LDSCTL_OFF, "LDS map");

#define GAS __attribute__((address_space(1)))
#define LAS __attribute__((address_space(3)))
#define DI __device__ __forceinline__
typedef unsigned short bf16;
typedef unsigned v4u __attribute__((ext_vector_type(4)));
typedef unsigned v2u __attribute__((ext_vector_type(2)));
typedef float f32x4 __attribute__((ext_vector_type(4)));
typedef float f32x16 __attribute__((ext_vector_type(16)));
typedef short bf16x8 __attribute__((ext_vector_type(8)));
typedef short s16x4 __attribute__((ext_vector_type(4)));
typedef GAS unsigned gu32;
#define RLX_AGENT __ATOMIC_RELAXED, __HIP_MEMORY_SCOPE_AGENT
#define LDS_WAIT() asm volatile("s_waitcnt lgkmcnt(0)" ::: "memory")
#define VM_WAIT() asm volatile("s_waitcnt vmcnt(0)" ::: "memory")
DI unsigned f2bf(float f) { unsigned u = __builtin_bit_cast(unsigned, f); return (u + 0x7fffu + ((u >> 16) & 1u)) >> 16; }
DI unsigned pk2(float lo, float hi) { return f2bf(lo) | (f2bf(hi) << 16); }
DI float bf2f(unsigned b) { return __builtin_bit_cast(float, b << 16); }
#define XB_TMO      128
#define XB_XCNT(j)  (256  + 64 * (j))
#define XB_XSUB(j)  (1280 + 64 * (j))
#define XB_XGEN(j)  (2304 + 64 * (j))
#define XB_TOP      3328
#define XB_TOPGEN   3392
#define XCD_BAR_WORDS 3456
#define XB_SPIN_CAP (1u << 18)

__device__ __forceinline__ unsigned xb_ld(unsigned* p)              { return __hip_atomic_load(p, __ATOMIC_RELAXED, __HIP_MEMORY_SCOPE_AGENT); }
__device__ __forceinline__ unsigned xb_add(unsigned* p, unsigned v) { return __hip_atomic_fetch_add(p, v, __ATOMIC_RELAXED, __HIP_MEMORY_SCOPE_AGENT); }
__device__ __forceinline__ unsigned xb_xcc_id() { return (unsigned)__builtin_amdgcn_s_getreg((3 << 11) | 20) & 0xFu; }
#define XB_SPIN(cond, bar) do { unsigned _sp = 0; while (cond) { __builtin_amdgcn_s_sleep(1); \
    if ((++_sp & 255u) == 0u) { if (xb_ld(&(bar)[XB_TMO])) break; if (_sp > XB_SPIN_CAP) { atomicAdd(&(bar)[XB_TMO], 1u); break; } } } } while (0)

struct XcdBarrier {
    unsigned* bar; unsigned x;
    volatile LAS unsigned* st;
};

__device__ __forceinline__ XcdBarrier xcd_barrier_post(unsigned* bar, volatile LAS unsigned* st) {
    XcdBarrier b; b.bar = bar; b.x = xb_xcc_id(); b.st = st;
    if (threadIdx.x == 0) (void)xb_add(&bar[XB_XCNT(b.x)], 1u);
    return b;
}
__device__ __forceinline__ void xcd_barrier_complete(unsigned* bar, unsigned x, unsigned& nloc, unsigned& nx) {
    const unsigned G = gridDim.x * gridDim.y * gridDim.z;
    unsigned sum, cnt, mine, sp = 0u;
    for (;;) {
        sum = 0u; cnt = 0u; mine = 0u;
#pragma unroll
        for (unsigned j = 0; j < 16; ++j) { const unsigned c = xb_ld(&bar[XB_XCNT(j)]); sum += c; cnt += (c > 0u) ? 1u : 0u; mine = (j == x) ? c : mine; }
        if (sum == G) break;
        __builtin_amdgcn_s_sleep(1);
        if ((++sp & 255u) == 0u) { if (xb_ld(&bar[XB_TMO])) break; if (sp > XB_SPIN_CAP) { atomicAdd(&bar[XB_TMO], 1u); break; } }
    }
    nloc = mine > 0u ? mine : 1u; nx = cnt > 0u ? cnt : 1u;
}

__device__ __forceinline__ void xcd_barrier(const XcdBarrier& b) {
    asm volatile("s_waitcnt vmcnt(0)" ::: "memory");
    __syncthreads();
    if (threadIdx.x == 0) {
        unsigned* bar = b.bar;
        __builtin_amdgcn_s_waitcnt(0);
        unsigned nloc = b.st[0], nx = b.st[1];
        if (nloc == 0u) { xcd_barrier_complete(bar, b.x, nloc, nx); b.st[0] = nloc; b.st[1] = nx; }
        const unsigned old = xb_add(&bar[XB_XSUB(b.x)], 1u);
        const unsigned gen = old / nloc;
        if (old + 1u == (gen + 1u) * nloc) {
            __builtin_amdgcn_fence(__ATOMIC_RELEASE, "agent");
            asm volatile("s_waitcnt vmcnt(0)" ::: "memory");
            const unsigned og = xb_add(&bar[XB_TOP], 1u);
            const unsigned tg = og / nx;
            if (og + 1u == (tg + 1u) * nx) xb_add(&bar[XB_TOPGEN], 1u);
            else XB_SPIN(xb_ld(&bar[XB_TOPGEN]) == tg, bar);
            __builtin_amdgcn_fence(__ATOMIC_ACQUIRE, "agent");
            xb_add(&bar[XB_XGEN(b.x)], 1u);
            asm volatile("s_waitcnt vmcnt(0)" ::: "memory");
        } else {
            XB_SPIN(xb_ld(&bar[XB_XGEN(b.x)]) == gen, bar);
            __builtin_amdgcn_fence(__ATOMIC_ACQUIRE, "agent");
            asm volatile("s_waitcnt vmcnt(0)" ::: "memory");
        }
    }
    __syncthreads();
}
struct Frame {
    LAS unsigned char* lds;
    volatile LAS unsigned* MISC;
    gu32* ctl;
    int tid, lane, wave;
    int vcu, G;
    unsigned char* ws;
    const float* x; const float* ffn_norm; const float* ffn_w_in; const float* ffn_w_out; const float* attn_norm; const float* a_w_qkv; const float* a_w_o;
    const float* kv_norm; const float* w_kv; const float* b_w_q; const float* b_sinks; const float* b_w_o; const float* final_norm;
    float* out;
};
DI float wave_sum(float v) {
#pragma unroll
    for (int o = 1; o < 64; o <<= 1) v += __shfl_xor(v, o);
    return v;
}
__device__ const float ROPE_INV[64] = {
1.000000000e+00f, 8.659643531e-01f, 7.498942018e-01f, 6.493816376e-01f, 5.623413324e-01f, 4.869675338e-01f, 4.216965139e-01f, 3.651741147e-01f, 3.162277639e-01f, 2.738419771e-01f, 2.371373922e-01f, 2.053525001e-01f, 1.778279394e-01f, 1.539926529e-01f, 1.333521456e-01f, 1.154782027e-01f,
1.000000015e-01f, 8.659642935e-02f, 7.498941571e-02f, 6.493816525e-02f, 5.623412877e-02f, 4.869675264e-02f, 4.216964915e-02f, 3.651741147e-02f, 3.162277862e-02f, 2.738419734e-02f, 2.371373586e-02f, 2.053524926e-02f, 1.778279431e-02f, 1.539926510e-02f, 1.333521493e-02f, 1.154781971e-02f,
9.999999776e-03f, 8.659643121e-03f, 7.498942316e-03f, 6.493816618e-03f, 5.623413250e-03f, 4.869675264e-03f, 4.216964822e-03f, 3.651741426e-03f, 3.162277862e-03f, 2.738419687e-03f, 2.371373819e-03f, 2.053525066e-03f, 1.778279431e-03f, 1.539926627e-03f, 1.333521446e-03f, 1.154781901e-03f,
1.000000047e-03f, 8.659643354e-04f, 7.498941850e-04f, 6.493816618e-04f, 5.623413017e-04f, 4.869675031e-04f, 4.216965463e-04f, 3.651741135e-04f, 3.162277862e-04f, 2.738419571e-04f, 2.371373848e-04f, 2.053525241e-04f, 1.778279402e-04f, 1.539926452e-04f, 1.333521504e-04f, 1.154782076e-04f };

template <int DROP> DI unsigned f2bf_drop(float f) { unsigned u = __builtin_bit_cast(unsigned, f); constexpr int sh = 16 + DROP; u += ((1u << (sh - 1)) - 1u) + ((u >> sh) & 1u); return ((u >> sh) << DROP) & 0xffffu; }

DI int map_col(int mode, int lim, int c) {
    const int pn = c >> 8, bj = (c >> 7) & 1, t = c & 127;
    if (mode == 1) return bj * DFF + 128 * pn + t;
    if (mode == 2 && c < lim) return (2 * pn + (t >> 6)) * 128 + 64 * bj + (t & 63);
    if (mode == 3 && c < lim) return (4 * pn + (t >> 5)) * 64 + 32 * bj + (t & 31);
    return c;
}
template <bool TILED, int DROP = 0> DI void tr_item(const float* __restrict__ src, const float* __restrict__ gain, bf16* __restrict__ dst, int K, int N, int ld, int mode, int lim, LAS float* scr, int item, int lane) {
    const int nblk = N >> 5, kb = item / nblk, nb = item - kb * nblk, k0 = kb << 6, n0 = nb << 5, s0 = map_col(mode, lim, n0);
    const int kr = lane >> 3, c4 = lane & 7;
    f32x4 v[8]; float g[8];
#pragma unroll
    for (int it = 0; it < 8; ++it) { v[it] = *(const GAS f32x4*)(src + (size_t)(k0 + 8 * it + kr) * ld + s0 + 4 * c4); g[it] = gain ? gain[k0 + 8 * it + kr] : 1.0f; }
#pragma unroll
    for (int it = 0; it < 8; ++it) { LAS float* p = scr + (8 * it + kr) * 33 + 4 * c4; p[0] = v[it].x * g[it]; p[1] = v[it].y * g[it]; p[2] = v[it].z * g[it]; p[3] = v[it].w * g[it]; }
    LDS_WAIT(); asm volatile("" ::: "memory");
#pragma unroll
    for (int j = 0; j < 4; ++j) { const int n = kr + 8 * j; const LAS float* s = scr + (8 * c4) * 33 + n;
#define PKW(a_, b_) (DROP > 0 ? (f2bf_drop<DROP>(a_) | (f2bf_drop<DROP>(b_) << 16)) : pk2(a_, b_))
        v4u o; o.x = PKW(s[0 * 33], s[1 * 33]); o.y = PKW(s[2 * 33], s[3 * 33]); o.z = PKW(s[4 * 33], s[5 * 33]); o.w = PKW(s[6 * 33], s[7 * 33]);
#undef PKW
        *(GAS v4u*)(dst + (TILED ? pg8::tiled_off(n0 + n, k0 + 8 * c4, K) : (size_t)(n0 + n) * K + k0 + 8 * c4)) = o; }
    LDS_WAIT(); asm volatile("" ::: "memory");
}
DI void sincos_acc(float angf, float& s, float& c) {
    const double x = (double)angf, q = __builtin_rint(x * 0.63661977236758134308);
    double r = __builtin_fma(-q, 1.57079632679489655800e+00, x); r = __builtin_fma(-q, 6.12323399573676603587e-17, r);
    const int qi = (int)q & 3; const double r2 = r * r;
    const double sp = r + r * r2 * (-1.0 / 6 + r2 * (1.0 / 120 + r2 * (-1.0 / 5040 + r2 * (1.0 / 362880 + r2 * (-1.0 / 39916800 + r2 * (1.0 / 6227020800.0))))));
    const double cp = 1.0 + r2 * (-0.5 + r2 * (1.0 / 24 + r2 * (-1.0 / 720 + r2 * (1.0 / 40320 + r2 * (-1.0 / 3628800 + r2 * (1.0 / 479001600 + r2 * (-1.0 / 87178291200.0)))))));
    const double ss = (qi & 1) ? cp : sp, cc = (qi & 1) ? sp : cp;
    s = (float)((qi & 2) ? -ss : ss); c = (float)(((qi + 1) & 2) ? -cc : cc);
}
DI void rope_tables(Frame& F) {
    const int gt = (F.vcu * NWAVES + F.wave) * 64 + F.lane, NT = F.G * NWAVES * 64;
    float* ca = (float*)(F.ws + WS_ROPEA); float* sa = ca + (size_t)M * 64; float* cb = (float*)(F.ws + WS_ROPEB); float* sb = cb + (size_t)M * 32;
    for (int e = gt; e < M * 64; e += NT) { const int pos = e >> 6, i = e & 63; float s, c; sincos_acc((float)pos * ROPE_INV[i], s, c); ca[e] = c; sa[e] = s; }
    for (int e = gt; e < M * 32; e += NT) { const int pos = e >> 5, i = e & 31; float s, c; sincos_acc((float)pos * ROPE_INV[2 * i], s, c); cb[e] = c; sb[e] = s; }
}
template <int DROP = 0> DI void norm_rows(Frame& F, const float* x, bf16* xn) {
    const int gw = F.vcu * NWAVES + F.wave, NGW = F.G * NWAVES;
    for (int m = gw; m < M; m += NGW) {
        const GAS f32x4* xr = (const GAS f32x4*)(x + (size_t)m * DM) + F.lane;
        f32x4 v[16]; float s = 0.f;
#pragma unroll
        for (int j = 0; j < 16; ++j) { v[j] = xr[64 * j]; s += (v[j].x * v[j].x + v[j].y * v[j].y) + (v[j].z * v[j].z + v[j].w * v[j].w); }
        const float r = 1.0f / sqrtf(wave_sum(s) * (1.0f / DM) + RMS_EPS);
#pragma unroll
        for (int j = 0; j < 16; ++j) { v2u w; if (DROP > 0) { w.x = f2bf_drop<DROP>(v[j].x * r) | (f2bf_drop<DROP>(v[j].y * r) << 16); w.y = f2bf_drop<DROP>(v[j].z * r) | (f2bf_drop<DROP>(v[j].w * r) << 16); }
            else { w.x = pk2(v[j].x * r, v[j].y * r); w.y = pk2(v[j].z * r, v[j].w * r); } const int col = 256 * j + 4 * F.lane;
            *(GAS v2u*)(xn + (XN_TILED ? pg8::tiled_off(m, col, DM) : (size_t)m * DM + col)) = w; }
    }
}
DI void colmax_item(const float* __restrict__ src, const float* __restrict__ gain, unsigned* cm, int N, int item, int lane) {
    const int ncg = N >> 8, rb = item / ncg, cg = item - rb * ncg; const int c0 = cg * 256 + 4 * lane;
    f32x4 mx = {0.f, 0.f, 0.f, 0.f};
#pragma unroll 8
    for (int r = 0; r < 256; ++r) { const int k = rb * 256 + r; const f32x4 v = *(const GAS f32x4*)(src + (size_t)k * N + c0) * (gain ? gain[k] : 1.0f);
        mx.x = __builtin_fmaxf(mx.x, __builtin_fabsf(v.x)); mx.y = __builtin_fmaxf(mx.y, __builtin_fabsf(v.y)); mx.z = __builtin_fmaxf(mx.z, __builtin_fabsf(v.z)); mx.w = __builtin_fmaxf(mx.w, __builtin_fabsf(v.w)); }
    __hip_atomic_fetch_max(cm + c0 + 0, __builtin_bit_cast(unsigned, mx.x), RLX_AGENT); __hip_atomic_fetch_max(cm + c0 + 1, __builtin_bit_cast(unsigned, mx.y), RLX_AGENT);
    __hip_atomic_fetch_max(cm + c0 + 2, __builtin_bit_cast(unsigned, mx.z), RLX_AGENT); __hip_atomic_fetch_max(cm + c0 + 3, __builtin_bit_cast(unsigned, mx.w), RLX_AGENT);
}
DI unsigned q8x4(float a, float b, float c, float d, float inv) { unsigned w = 0u;
    w = __builtin_amdgcn_cvt_pk_u8_f32(__builtin_rintf(__builtin_fmaf(a, inv, 128.f)), 0, w); w = __builtin_amdgcn_cvt_pk_u8_f32(__builtin_rintf(__builtin_fmaf(b, inv, 128.f)), 1, w);
    w = __builtin_amdgcn_cvt_pk_u8_f32(__builtin_rintf(__builtin_fmaf(c, inv, 128.f)), 2, w); w = __builtin_amdgcn_cvt_pk_u8_f32(__builtin_rintf(__builtin_fmaf(d, inv, 128.f)), 3, w); return w ^ 0x80808080u; }
DI unsigned q8(float v) { const float r = __builtin_rintf(v); const int i = (int)__builtin_fminf(__builtin_fmaxf(r, -127.f), 127.f); return (unsigned)i & 0xffu; }
DI void tr_item8(const float* __restrict__ src, const float* __restrict__ gain, const float* __restrict__ cm, unsigned char* __restrict__ dst, int K, int N, int mode, int lim, int item, LAS float* scr, int lane) {
    const int nblk = N >> 5, kb = item / nblk, nb = item - kb * nblk, k0 = kb << 6, n0 = nb << 5, s0 = map_col(mode, lim, n0);
    const int kr = lane >> 3, c4 = lane & 7;
    f32x4 v[8]; float g[8];
#pragma unroll
    for (int it = 0; it < 8; ++it) { v[it] = *(const GAS f32x4*)(src + (size_t)(k0 + 8 * it + kr) * N + s0 + 4 * c4); g[it] = gain ? gain[k0 + 8 * it + kr] : 1.0f; }
#pragma unroll
    for (int it = 0; it < 8; ++it) { LAS float* p = scr + (8 * it + kr) * 33 + 4 * c4; p[0] = v[it].x * g[it]; p[1] = v[it].y * g[it]; p[2] = v[it].z * g[it]; p[3] = v[it].w * g[it]; }
    LDS_WAIT(); asm volatile("" ::: "memory");
#pragma unroll
    for (int j = 0; j < 4; ++j) { const int n = kr + 8 * j; const LAS float* s = scr + (8 * c4) * 33 + n;
        const float cmx = cm[s0 + n], inv = cmx > 0.f ? 127.0f / cmx : 0.f;
        v2u o; o.x = q8x4(s[0 * 33], s[1 * 33], s[2 * 33], s[3 * 33], inv);
        o.y = q8x4(s[4 * 33], s[5 * 33], s[6 * 33], s[7 * 33], inv);
        const int nn = n0 + n, kk = k0 + 8 * c4;
        *(GAS v2u*)(dst + (size_t)(nn >> 8) * ((size_t)256 * K) + (size_t)(kk >> 7) * (256 * 128) + (size_t)(nn & 255) * 128 + (kk & 127)) = o; }
    LDS_WAIT(); asm volatile("" ::: "memory");
}
DI void strip_quant8(Frame& F, const float* __restrict__ src, const float* __restrict__ gain, float* __restrict__ cm, unsigned char* __restrict__ dst, int K, int N, int mode, int lim, int strip, LAS float* scr, LAS unsigned* cml) {
    const int n0 = strip << 5, s0 = map_col(mode, lim, n0), lane = F.lane, kr = lane >> 3, c4 = lane & 7, nkb = K >> 6;
    if (F.tid < 32) cml[F.tid] = 0u;
    __syncthreads();
    f32x4 mx = {0.f, 0.f, 0.f, 0.f};
#pragma unroll 1
    for (int kb = F.wave; kb < nkb; kb += NWAVES) {
#pragma unroll
        for (int it = 0; it < 8; ++it) { const int k = (kb << 6) + 8 * it + kr; const f32x4 v = *(const GAS f32x4*)(src + (size_t)k * N + s0 + 4 * c4) * (gain ? gain[k] : 1.0f);
            mx.x = __builtin_fmaxf(mx.x, __builtin_fabsf(v.x)); mx.y = __builtin_fmaxf(mx.y, __builtin_fabsf(v.y)); mx.z = __builtin_fmaxf(mx.z, __builtin_fabsf(v.z)); mx.w = __builtin_fmaxf(mx.w, __builtin_fabsf(v.w)); } }
#pragma unroll
    for (int o = 8; o < 64; o <<= 1) { mx.x = __builtin_fmaxf(mx.x, __shfl_xor(mx.x, o)); mx.y = __builtin_fmaxf(mx.y, __shfl_xor(mx.y, o)); mx.z = __builtin_fmaxf(mx.z, __shfl_xor(mx.z, o)); mx.w = __builtin_fmaxf(mx.w, __shfl_xor(mx.w, o)); }
    if (lane < 8) { __hip_atomic_fetch_max(cml + 4 * lane + 0, __builtin_bit_cast(unsigned, mx.x), __ATOMIC_RELAXED, __HIP_MEMORY_SCOPE_WORKGROUP); __hip_atomic_fetch_max(cml + 4 * lane + 1, __builtin_bit_cast(unsigned, mx.y), __ATOMIC_RELAXED, __HIP_MEMORY_SCOPE_WORKGROUP);
                    __hip_atomic_fetch_max(cml + 4 * lane + 2, __builtin_bit_cast(unsigned, mx.z), __ATOMIC_RELAXED, __HIP_MEMORY_SCOPE_WORKGROUP); __hip_atomic_fetch_max(cml + 4 * lane + 3, __builtin_bit_cast(unsigned, mx.w), __ATOMIC_RELAXED, __HIP_MEMORY_SCOPE_WORKGROUP); }
    __syncthreads();
#pragma unroll 1
    for (int kb = F.wave; kb < nkb; kb += NWAVES) { const int k0 = kb << 6;
        f32x4 v[8]; float g[8];
#pragma unroll
        for (int it = 0; it < 8; ++it) { v[it] = *(const GAS f32x4*)(src + (size_t)(k0 + 8 * it + kr) * N + s0 + 4 * c4); g[it] = gain ? gain[k0 + 8 * it + kr] : 1.0f; }
#pragma unroll
        for (int it = 0; it < 8; ++it) { LAS float* p = scr + (8 * it + kr) * 33 + 4 * c4; p[0] = v[it].x * g[it]; p[1] = v[it].y * g[it]; p[2] = v[it].z * g[it]; p[3] = v[it].w * g[it]; }
        LDS_WAIT(); asm volatile("" ::: "memory");
#pragma unroll
        for (int j = 0; j < 4; ++j) { const int n = kr + 8 * j; const LAS float* s = scr + (8 * c4) * 33 + n;
            const float cmx = __builtin_bit_cast(float, cml[n]), inv = cmx > 0.f ? 127.0f / cmx : 0.f;
            v2u o; o.x = q8x4(s[0 * 33], s[1 * 33], s[2 * 33], s[3 * 33], inv);
            o.y = q8x4(s[4 * 33], s[5 * 33], s[6 * 33], s[7 * 33], inv);
            const int nn = n0 + n, kk = k0 + 8 * c4;
            *(GAS v2u*)(dst + (size_t)(nn >> 8) * ((size_t)256 * K) + (size_t)(kk >> 7) * (256 * 128) + (size_t)(nn & 255) * 128 + (kk & 127)) = o; }
        LDS_WAIT(); asm volatile("" ::: "memory"); }
    if (F.tid < 32) cm[s0 + F.tid] = __builtin_bit_cast(float, cml[F.tid]);
    __syncthreads();
}
#ifndef HAD_ON
#define HAD_ON 1
#endif
#ifndef ACT8_TILED
#define ACT8_TILED 0
#endif
DI void fwht_inlane8(float (&v)[8]) {
#pragma unroll
    for (int b = 1; b < 8; b <<= 1)
#pragma unroll
        for (int i = 0; i < 8; ++i) if (!(i & b)) { const float lo = v[i], hi = v[i | b]; v[i] = lo + hi; v[i | b] = lo - hi; }
}
template <int CTRL> DI float dpp_f(float v) { return __builtin_bit_cast(float, __builtin_amdgcn_update_dpp(0, __builtin_bit_cast(int, v), CTRL, 0xf, 0xf, false)); }
DI float swz_xor4(float v) { return __builtin_bit_cast(float, __builtin_amdgcn_ds_swizzle(__builtin_bit_cast(int, v), 0x101f)); }
constexpr int AQ_NIT = 11;
DI void aq_load(const bf16* act, int m, int sub, int lane, v4u (&t)[AQ_NIT]) {
    const bf16* row = act + (size_t)m * DFF + sub * (AQ_NIT * 512) + lane * 8;
#pragma unroll
    for (int it = 0; it < AQ_NIT; ++it) { t[it] = v4u{0u, 0u, 0u, 0u}; if (sub * (AQ_NIT * 512) + it * 512 + lane * 8 < DFF) t[it] = *(const GAS v4u*)(row + it * 512); }
}
DI void act_quant_phase(Frame& F, const bf16* act, unsigned char* aq, float* sact) {
    const int lane = F.lane, pair = F.wave >> 1, sub = F.wave & 1, step = F.G * (NWAVES / 2);
    LAS float* const smx = (LAS float*)(F.lds + RING_BYTES);
    const float s1 = (lane & 1) ? -1.f : 1.f, s2 = (lane & 2) ? -1.f : 1.f, s4 = (lane & 4) ? -1.f : 1.f;
    int par = 0;
    v4u t[AQ_NIT];
    { const int m = F.vcu * (NWAVES / 2) + pair; aq_load(act, m < M ? m : 0, sub, lane, t); }
#pragma unroll 1
    for (int m0 = F.vcu * (NWAVES / 2); m0 < M; m0 += step, par ^= 8) {
        const int m = m0 + pair; const bool rowok = m < M;
        float r[AQ_NIT][8]; float mx = 0.f;
#pragma unroll
        for (int it = 0; it < AQ_NIT; ++it) {
            float v[8] = {bf2f(t[it].x & 0xffffu), __builtin_bit_cast(float, t[it].x & 0xffff0000u), bf2f(t[it].y & 0xffffu), __builtin_bit_cast(float, t[it].y & 0xffff0000u),
                          bf2f(t[it].z & 0xffffu), __builtin_bit_cast(float, t[it].z & 0xffff0000u), bf2f(t[it].w & 0xffffu), __builtin_bit_cast(float, t[it].w & 0xffff0000u)};
            if (HAD_ON) { fwht_inlane8(v);
#pragma unroll
                for (int i = 0; i < 8; ++i) v[i] = __builtin_fmaf(v[i], s1, dpp_f<0xB1>(v[i]));
#pragma unroll
                for (int i = 0; i < 8; ++i) v[i] = __builtin_fmaf(v[i], s2, dpp_f<0x4E>(v[i]));
#pragma unroll
                for (int i = 0; i < 8; ++i) v[i] = __builtin_fmaf(v[i], s4, swz_xor4(v[i])); }
#pragma unroll
            for (int i = 0; i < 8; ++i) { mx = __builtin_fmaxf(mx, __builtin_fabsf(v[i])); r[it][i] = v[i]; } }
        { const int mn = m + step; aq_load(act, mn < M ? mn : 0, sub, lane, t); }
#pragma unroll
        for (int s = 1; s < 64; s <<= 1) mx = __builtin_fmaxf(mx, __shfl_xor(mx, s));
        if (lane == 0) smx[par + F.wave] = mx;
        __syncthreads();
        mx = __builtin_fmaxf(smx[par + 2 * pair], smx[par + 2 * pair + 1]);
        const float inv = mx > 0.f ? 127.0f / mx : 0.f;
#pragma unroll
        for (int it = 0; it < AQ_NIT; ++it) { const int e0 = sub * (AQ_NIT * 512) + it * 512 + lane * 8;
            v2u w = {0u, 0u};
#pragma unroll
            for (int i = 0; i < 4; ++i) { w.x = __builtin_amdgcn_cvt_pk_u8_f32(__builtin_rintf(__builtin_fmaf(r[it][i], inv, 128.f)), i, w.x);
                                          w.y = __builtin_amdgcn_cvt_pk_u8_f32(__builtin_rintf(__builtin_fmaf(r[it][4 + i], inv, 128.f)), i, w.y); }
            w.x ^= 0x80808080u; w.y ^= 0x80808080u;
            if (rowok && e0 < DFF) *(GAS v2u*)(aq + (ACT8_TILED ? (size_t)(m >> 8) * ((size_t)256 * DFF) + (size_t)(e0 >> 7) * (256 * 128) + (size_t)(m & 255) * 128 + (e0 & 127) : (size_t)m * DFF + e0)) = w; }
        if (rowok && sub == 0 && lane == 0) sact[m] = mx * (HAD_ON ? 0.125f / 127.0f : 1.0f / 127.0f);
    }
    __syncthreads();
}
DI void rot_tile_col(const LAS float* scr, int lane, float (&v)[32]) {
    const int n = lane & 31, half = lane >> 5;
#pragma unroll
    for (int i = 0; i < 32; ++i) v[i] = scr[(32 * half + i) * 33 + n];
    if (HAD_ON) {
#pragma unroll
        for (int b = 1; b < 32; b <<= 1)
#pragma unroll
            for (int i = 0; i < 32; ++i) if (!(i & b)) { const float lo = v[i], hi = v[i | b]; v[i] = lo + hi; v[i | b] = lo - hi; }
#pragma unroll
        for (int i = 0; i < 32; ++i) { const float p = __shfl_xor(v[i], 32); v[i] = (half ? p - v[i] : v[i] + p) * 0.125f; } }
}
DI void strip_quant8_rot(Frame& F, const float* __restrict__ src, float* __restrict__ cm, unsigned char* __restrict__ dst, int K, int N, int strip, LAS float* scr, LAS unsigned* cml) {
    const int n0 = strip << 5, lane = F.lane, kr = lane >> 3, c4 = lane & 7, nkb = K >> 6, n = lane & 31, half = lane >> 5;
    if (F.tid < 32) cml[F.tid] = 0u;
    __syncthreads();
    float mxc = 0.f;
#pragma unroll 1
    for (int pass = 0; pass < 2; ++pass) {
        float inv = 0.f; if (pass) { const float cmx = __builtin_bit_cast(float, cml[n]); inv = cmx > 0.f ? 127.0f / cmx : 0.f; }
#pragma unroll 1
        for (int kb = F.wave; kb < nkb; kb += NWAVES) { const int k0 = kb << 6;
            f32x4 t[8];
#pragma unroll
            for (int it = 0; it < 8; ++it) t[it] = *(const GAS f32x4*)(src + (size_t)(k0 + 8 * it + kr) * N + n0 + 4 * c4);
#pragma unroll
            for (int it = 0; it < 8; ++it) { LAS float* p = scr + (8 * it + kr) * 33 + 4 * c4; p[0] = t[it].x; p[1] = t[it].y; p[2] = t[it].z; p[3] = t[it].w; }
            LDS_WAIT(); asm volatile("" ::: "memory");
            float v[32]; rot_tile_col(scr, lane, v);
            if (!pass) {
#pragma unroll
                for (int i = 0; i < 32; ++i) mxc = __builtin_fmaxf(mxc, __builtin_fabsf(v[i])); }
            else { v4u o[2];
#pragma unroll
                for (int h = 0; h < 2; ++h)
#pragma unroll
                    for (int c = 0; c < 4; ++c) { const int i = 16 * h + 4 * c; o[h][c] = q8x4(v[i], v[i + 1], v[i + 2], v[i + 3], inv); }
                const int nn = n0 + n, kk = k0 + 32 * half;
                unsigned char* p = dst + (size_t)(nn >> 8) * ((size_t)256 * K) + (size_t)(kk >> 7) * (256 * 128) + (size_t)(nn & 255) * 128 + (kk & 127);
                *(GAS v4u*)p = o[0]; *(GAS v4u*)(p + 16) = o[1]; }
            LDS_WAIT(); asm volatile("" ::: "memory"); }
        if (!pass) { mxc = __builtin_fmaxf(mxc, __shfl_xor(mxc, 32)); if (half == 0) __hip_atomic_fetch_max(cml + n, __builtin_bit_cast(unsigned, mxc), __ATOMIC_RELAXED, __HIP_MEMORY_SCOPE_WORKGROUP); __syncthreads(); }
    }
    if (F.tid < 32) cm[n0 + F.tid] = __builtin_bit_cast(float, cml[F.tid]);
    __syncthreads();
}
template <int DROP> DI void norm_rows8(Frame& F, const float* x, unsigned char* xq, float* sA, bf16* xb) {
    const int gw = F.vcu * NWAVES + F.wave, NGW = F.G * NWAVES;
    for (int m = gw; m < M; m += NGW) {
        const GAS f32x4* xr = (const GAS f32x4*)(x + (size_t)m * DM) + 4 * F.lane;
        f32x4 v[16]; float s = 0.f, mx = 0.f;
#pragma unroll
        for (int j = 0; j < 4; ++j)
#pragma unroll
            for (int i = 0; i < 4; ++i) { const f32x4 t = xr[256 * j + i]; v[4 * j + i] = t; s += (t.x * t.x + t.y * t.y) + (t.z * t.z + t.w * t.w);
                mx = __builtin_fmaxf(mx, __builtin_fmaxf(__builtin_fmaxf(__builtin_fabsf(t.x), __builtin_fabsf(t.y)), __builtin_fmaxf(__builtin_fabsf(t.z), __builtin_fabsf(t.w)))); }
        const float r = 1.0f / sqrtf(wave_sum(s) * (1.0f / DM) + RMS_EPS);
#pragma unroll
        for (int o = 1; o < 64; o <<= 1) mx = __builtin_fmaxf(mx, __shfl_xor(mx, o));
        const float inv = mx > 0.f ? 127.0f / mx : 0.f;
#pragma unroll
        for (int j = 0; j < 4; ++j) { v4u w;
#pragma unroll
            for (int i = 0; i < 4; ++i) { const f32x4 t = v[4 * j + i]; w[i] = q8x4(t.x, t.y, t.z, t.w, inv); }
            *(GAS v4u*)(xq + (size_t)m * DM + 1024 * j + 16 * F.lane) = w;
            if (xb) {
#pragma unroll
                for (int h = 0; h < 2; ++h) { const f32x4 a = v[4 * j + 2 * h] * r, b = v[4 * j + 2 * h + 1] * r; v4u y;
                    if (DROP > 0) { y.x = f2bf_drop<DROP>(a.x) | (f2bf_drop<DROP>(a.y) << 16); y.y = f2bf_drop<DROP>(a.z) | (f2bf_drop<DROP>(a.w) << 16); y.z = f2bf_drop<DROP>(b.x) | (f2bf_drop<DROP>(b.y) << 16); y.w = f2bf_drop<DROP>(b.z) | (f2bf_drop<DROP>(b.w) << 16); }
                    else { y.x = pk2(a.x, a.y); y.y = pk2(a.z, a.w); y.z = pk2(b.x, b.y); y.w = pk2(b.z, b.w); }
                    *(GAS v4u*)(xb + (size_t)m * DM + 1024 * j + 16 * F.lane + 8 * h) = y; } } }
        if (F.lane == 0) sA[m] = mx * r * (1.0f / 127.0f);
    }
}
DI void quant_rows_bf16(Frame& F, const bf16* o, unsigned char* oq, float* sO) {
    const int gw = F.vcu * NWAVES + F.wave, NGW = F.G * NWAVES;
    for (int m = gw; m < M; m += NGW) {
        const GAS v4u* orow = (const GAS v4u*)(o + (size_t)m * DM) + 2 * F.lane;
        v4u v[8]; float mx = 0.f;
#pragma unroll
        for (int j = 0; j < 4; ++j)
#pragma unroll
            for (int h = 0; h < 2; ++h) { const v4u t = orow[128 * j + h]; v[2 * j + h] = t;
#pragma unroll
                for (int c = 0; c < 4; ++c) mx = __builtin_fmaxf(mx, __builtin_fmaxf(__builtin_fabsf(bf2f(t[c] & 0xffffu)), __builtin_fabsf(bf2f(t[c] >> 16)))); }
#pragma unroll
        for (int s = 1; s < 64; s <<= 1) mx = __builtin_fmaxf(mx, __shfl_xor(mx, s));
        const float inv = mx > 0.f ? 127.0f / mx : 0.f;
#pragma unroll
        for (int j = 0; j < 4; ++j) { v4u w;
#pragma unroll
            for (int h = 0; h < 2; ++h) { const v4u t = v[2 * j + h];
                w[2 * h] = q8x4(bf2f(t[0] & 0xffffu), bf2f(t[0] >> 16), bf2f(t[1] & 0xffffu), bf2f(t[1] >> 16), inv);
                w[2 * h + 1] = q8x4(bf2f(t[2] & 0xffffu), bf2f(t[2] >> 16), bf2f(t[3] & 0xffffu), bf2f(t[3] >> 16), inv); }
            *(GAS v4u*)(oq + (size_t)m * DM + 1024 * j + 16 * F.lane) = w; }
        if (F.lane == 0) sO[m] = mx * (1.0f / 127.0f);
    }
}
DI void norm_rows8_b(Frame& F, const bf16* x, unsigned char* xq, float* sA) {
    const int gw = F.vcu * NWAVES + F.wave, NGW = F.G * NWAVES;
    for (int m = gw; m < M; m += NGW) {
        const GAS v4u* xr = (const GAS v4u*)(x + (size_t)m * DM) + 2 * F.lane;
        v4u t[8]; float s = 0.f, mx = 0.f;
#pragma unroll
        for (int j = 0; j < 4; ++j) { t[2 * j] = xr[128 * j]; t[2 * j + 1] = xr[128 * j + 1]; }
#pragma unroll
        for (int j = 0; j < 8; ++j)
#pragma unroll
            for (int i = 0; i < 4; ++i) { const float a = __builtin_bit_cast(float, t[j][i] << 16), b = __builtin_bit_cast(float, t[j][i] & 0xffff0000u); s += a * a + b * b; mx = __builtin_fmaxf(mx, __builtin_fmaxf(__builtin_fabsf(a), __builtin_fabsf(b))); }
        const float r = 1.0f / sqrtf(wave_sum(s) * (1.0f / DM) + RMS_EPS);
#pragma unroll
        for (int o = 1; o < 64; o <<= 1) mx = __builtin_fmaxf(mx, __shfl_xor(mx, o));
        const float inv = mx > 0.f ? 127.0f / mx : 0.f;
#pragma unroll
        for (int j = 0; j < 4; ++j) { v4u w;
#pragma unroll
            for (int i = 0; i < 4; ++i) { const unsigned w0 = t[2 * j + (i >> 1)][2 * (i & 1)], w1 = t[2 * j + (i >> 1)][2 * (i & 1) + 1];
                w[i] = q8x4(__builtin_bit_cast(float, w0 << 16), __builtin_bit_cast(float, w0 & 0xffff0000u), __builtin_bit_cast(float, w1 << 16), __builtin_bit_cast(float, w1 & 0xffff0000u), inv); }
            *(GAS v4u*)(xq + (size_t)m * DM + 1024 * j + 16 * F.lane) = w; }
        if (F.lane == 0) sA[m] = mx * r * (1.0f / 127.0f);
    }
}
DI void final_norm_rows_b(Frame& F, const bf16* x, float* out, const float* gain, bool poison) {
    const int gw = F.vcu * NWAVES + F.wave, NGW = F.G * NWAVES;
    for (int m = gw; m < M; m += NGW) {
        const GAS v4u* xr = (const GAS v4u*)(x + (size_t)m * DM) + F.lane; GAS f32x4* orow = (GAS f32x4*)(out + (size_t)m * DM) + 2 * F.lane; const GAS f32x4* gr = (const GAS f32x4*)gain + 2 * F.lane;
        v4u t[8]; float s = 0.f;
#pragma unroll
        for (int j = 0; j < 8; ++j) t[j] = xr[64 * j];
#pragma unroll
        for (int j = 0; j < 8; ++j)
#pragma unroll
            for (int i = 0; i < 4; ++i) { const float a = __builtin_bit_cast(float, t[j][i] << 16), b = __builtin_bit_cast(float, t[j][i] & 0xffff0000u); s += a * a + b * b; }
        float r = 1.0f / sqrtf(wave_sum(s) * (1.0f / DM) + RMS_EPS); if (poison) r = __builtin_nanf("");
#pragma unroll
        for (int j = 0; j < 8; ++j) { f32x4 a, b;
            a.x = __builtin_bit_cast(float, t[j].x << 16); a.y = __builtin_bit_cast(float, t[j].x & 0xffff0000u); a.z = __builtin_bit_cast(float, t[j].y << 16); a.w = __builtin_bit_cast(float, t[j].y & 0xffff0000u);
            b.x = __builtin_bit_cast(float, t[j].z << 16); b.y = __builtin_bit_cast(float, t[j].z & 0xffff0000u); b.z = __builtin_bit_cast(float, t[j].w << 16); b.w = __builtin_bit_cast(float, t[j].w & 0xffff0000u);
            orow[128 * j] = a * r * gr[128 * j]; orow[128 * j + 1] = b * r * gr[128 * j + 1]; }
    }
}
DI void final_norm_rows(Frame& F, float* x, const float* gain, bool poison) {
    const int gw = F.vcu * NWAVES + F.wave, NGW = F.G * NWAVES;
    for (int m = gw; m < M; m += NGW) {
        GAS f32x4* xr = (GAS f32x4*)(x + (size_t)m * DM) + F.lane; const GAS f32x4* gr = (const GAS f32x4*)gain + F.lane;
        f32x4 v[16]; float s = 0.f;
#pragma unroll
        for (int j = 0; j < 16; ++j) { v[j] = xr[64 * j]; s += (v[j].x * v[j].x + v[j].y * v[j].y) + (v[j].z * v[j].z + v[j].w * v[j].w); }
        float r = 1.0f / sqrtf(wave_sum(s) * (1.0f / DM) + RMS_EPS); if (poison) r = __builtin_nanf("");
#pragma unroll
        for (int j = 0; j < 16; ++j) xr[64 * j] = v[j] * r * gr[64 * j];
    }
}
DI void kmean_phase(Frame& F) {
    const bf16* Kb = (const bf16*)(F.ws + WS_K); bf16* kh = (bf16*)(F.ws + WS_KMEAN); bf16* kl = kh + 8 * 64 * 128;
    LAS float* red = (LAS float*)(F.lds + RING_OFF);
    const int c = F.tid & 15, rg = F.tid >> 4;
    for (int it = F.vcu; it < 8 * NBLK; it += F.G) {
        const int kvh = it >> 6, n = it & 63; float a[8];
#pragma unroll
        for (int e = 0; e < 8; ++e) a[e] = 0.f;
#pragma unroll
        for (int r = 0; r < 8; ++r) { const v4u w = *(const GAS v4u*)(Kb + (size_t)(n * 256 + rg + 32 * r) * A_KVW + kvh * 128 + c * 8);
            a[0] += bf2f(w.x & 0xffffu); a[1] += bf2f(w.x >> 16); a[2] += bf2f(w.y & 0xffffu); a[3] += bf2f(w.y >> 16); a[4] += bf2f(w.z & 0xffffu); a[5] += bf2f(w.z >> 16); a[6] += bf2f(w.w & 0xffffu); a[7] += bf2f(w.w >> 16); }
#pragma unroll
        for (int e = 0; e < 8; ++e) red[rg * 128 + c * 8 + e] = a[e];
        __syncthreads();
        if (F.tid < 128) { float s = 0.f;
#pragma unroll 8
            for (int g = 0; g < 32; ++g) s += red[g * 128 + F.tid];
            s *= (1.0f / 256.0f); const unsigned h = f2bf(s); const float l = s - bf2f(h);
            kh[(size_t)it * 128 + F.tid] = (bf16)h; kl[(size_t)it * 128 + F.tid] = (bf16)f2bf(l); }
        __syncthreads();
    }
}
namespace att {
template <int D> struct TL { static constexpr int PITCH = D * 2 + 16, BYTES = 64 * PITCH, NCH = D / 8, NLD = (64 * NCH) / 512; };
DI int crow(int reg, int h) { return (reg & 3) + 8 * (reg >> 2) + 4 * h; }
typedef float f32x2_t __attribute__((ext_vector_type(2))); typedef __bf16 bf16x2_t __attribute__((ext_vector_type(2)));
DI unsigned cvtpk(float lo, float hi) { f32x2_t v = {lo, hi}; bf16x2_t b = __builtin_convertvector(v, bf16x2_t); return __builtin_bit_cast(unsigned, b); }
typedef short v4i16_t __attribute__((ext_vector_type(4)));
DI s16x4 vtr(const LAS unsigned char* p) { return __builtin_bit_cast(s16x4, __builtin_amdgcn_ds_read_tr16_b64_v4i16((LAS v4i16_t*)p)); }
#define MFMA32(a, b, c) __builtin_amdgcn_mfma_f32_32x32x16_bf16((a), (b), (c), 0, 0, 0)

template <int D, int NL = TL<D>::NLD> DI void tile_load(v4u (&r)[NL], const bf16* g, int pitch, int tid) {
#pragma unroll
    for (int i = 0; i < NL; ++i) { const int c = tid + 512 * i, row = c / TL<D>::NCH, ch = c % TL<D>::NCH; r[i] = *(const GAS v4u*)(g + (size_t)row * pitch + ch * 8); }
}
template <int D, int NL = TL<D>::NLD> DI void tile_store(LAS unsigned char* t, const v4u (&r)[NL], int tid) {
#pragma unroll
    for (int i = 0; i < NL; ++i) { const int c = tid + 512 * i, row = c / TL<D>::NCH, ch = c % TL<D>::NCH; *(LAS v4u*)(t + row * TL<D>::PITCH + ch * 16) = r[i]; }
}
template <int D, bool INIT = true> DI void qk(f32x16& p0, f32x16& p1, const LAS unsigned char* kt, const bf16x8 (&qf)[D / 16], int r32, int hi) {
    const LAS unsigned char* a = kt + r32 * TL<D>::PITCH + hi * 16;
    if (INIT) {
#pragma unroll
        for (int i = 0; i < 16; ++i) { p0[i] = 0.f; p1[i] = 0.f; } }
#pragma unroll
    for (int s = 0; s < D / 16; ++s) { const bf16x8 a0 = *(const LAS bf16x8*)(a + s * 32), a1 = *(const LAS bf16x8*)(a + 32 * TL<D>::PITCH + s * 32);
        p0 = MFMA32(a0, qf[s], p0); p1 = MFMA32(a1, qf[s], p1); if ((s & 3) == 3) __builtin_amdgcn_sched_barrier(0); }
}
DI bf16x8 pack8(const f32x16& x, int s) {
    v4u p; p.x = cvtpk(x[8 * s], x[8 * s + 1]); p.y = cvtpk(x[8 * s + 2], x[8 * s + 3]); p.z = cvtpk(x[8 * s + 4], x[8 * s + 5]); p.w = cvtpk(x[8 * s + 6], x[8 * s + 7]);
    return __builtin_bit_cast(bf16x8, p);
}
template <int D> DI void pv(f32x16 (&o)[D / 32], const LAS unsigned char* vt, const f32x16& p0, const f32x16& p1, int lane, int hi) {
    bf16x8 pf[4]; pf[0] = pack8(p0, 0); pf[1] = pack8(p0, 1); pf[2] = pack8(p1, 0); pf[3] = pack8(p1, 1);
    const LAS unsigned char* vb = vt + (4 * hi + ((lane & 15) >> 2)) * TL<D>::PITCH + ((lane >> 4) & 1) * 32 + (lane & 3) * 8;
#pragma unroll
    for (int db = 0; db < D / 32; ++db)
#pragma unroll
        for (int ks = 0; ks < 4; ++ks) { const s16x4 lo = vtr(vb + (16 * ks) * TL<D>::PITCH + db * 64), hh = vtr(vb + (16 * ks + 8) * TL<D>::PITCH + db * 64);
            const bf16x8 va = (bf16x8){lo[0], lo[1], lo[2], lo[3], hh[0], hh[1], hh[2], hh[3]};
            o[db] = MFMA32(va, pf[ks], o[db]); if (ks == 3) __builtin_amdgcn_sched_barrier(0); }
}
template <int D> DI void softmax_update(f32x16& p0, f32x16& p1, float& m, float& l, f32x16 (&o)[D / 32]) {
    float mx = __builtin_fmaxf(p0[0], p1[0]);
#pragma unroll
    for (int i = 1; i < 16; ++i) mx = __builtin_fmaxf(mx, __builtin_fmaxf(p0[i], p1[i]));
    mx = __builtin_fmaxf(mx, __shfl_xor(mx, 32));
    const float mn = __builtin_fmaxf(m, mx), al = __builtin_amdgcn_exp2f(m - mn);
    float s = 0.f;
#pragma unroll
    for (int i = 0; i < 16; ++i) { p0[i] = __builtin_amdgcn_exp2f(p0[i] - mn); p1[i] = __builtin_amdgcn_exp2f(p1[i] - mn); s += p0[i] + p1[i]; }
    l = l * al + s; m = mn;
#pragma unroll
    for (int db = 0; db < D / 32; ++db)
#pragma unroll
        for (int i = 0; i < 16; ++i) o[db][i] *= al;
}
template <int D> DI void store_rows16(bf16* orow, const f32x16 (&o)[D / 32], float inv, int hi, bool valid) {
#pragma unroll
    for (int db = 0; db < D / 32; ++db)
#pragma unroll
        for (int gp = 0; gp < 2; ++gp) { const int ge = 8 * gp, go = 8 * gp + 4;
            const unsigned ex = cvtpk(o[db][ge] * inv, o[db][ge + 1] * inv), ey = cvtpk(o[db][ge + 2] * inv, o[db][ge + 3] * inv);
            const unsigned ox = cvtpk(o[db][go] * inv, o[db][go + 1] * inv), oy = cvtpk(o[db][go + 2] * inv, o[db][go + 3] * inv);
            const auto sx = __builtin_amdgcn_permlane32_swap(ex, ox, false, false), sy = __builtin_amdgcn_permlane32_swap(ey, oy, false, false);
            v4u w; w.x = sx[0]; w.y = sy[0]; w.z = sx[1]; w.w = sy[1];
            if (valid) *(GAS v4u*)(orow + db * 32 + 16 * gp + 8 * hi) = w; }
}
template <int D> DI void store_o(bf16* orow  , const f32x16 (&o)[D / 32], float l, int hi) {
    const float L = l + __shfl_xor(l, 32), inv = 1.0f / L;
    store_rows16<D>(orow, o, inv, hi, true);
}

constexpr int MOBA_HIST_OFF = 36864, MOBA_SCAN_OFF = 40960;
DI size_t moba_list_off(int kvh, int n) { return (size_t)kvh * 2064384 + (size_t)1024 * (63 * n - (n * (n - 1)) / 2); }
template <int D> DI void store_part(bf16* po  , float* pml, const f32x16 (&o)[D / 32], float m, float l, int hi, bool valid) {
    const float L = l + __shfl_xor(l, 32), inv = 1.0f / L;
    store_rows16<D>(po, o, inv, hi, valid);
    if (valid && hi == 0) { pml[0] = m; pml[1] = L; }
}
DI void moba_own_item(Frame& F, int b, int h) {
    constexpr int D = 128; typedef TL<D> T;
    LAS unsigned char* kt = F.lds + RING_OFF; LAS unsigned char* vt = kt + T::BYTES;
    LAS unsigned* hist = (LAS unsigned*)(F.lds + RING_OFF + MOBA_HIST_OFF); LAS unsigned* bases = hist + 64;
    const int lane = F.lane, r32 = lane & 31, hi = lane >> 5, w = F.wave, kvh = h >> 2, tid = F.tid;
    const bf16* Kb = (const bf16*)(F.ws + WS_K) + kvh * 128; const bf16* Vb = (const bf16*)(F.ws + WS_V) + kvh * 128;
    const bf16* kmh = (const bf16*)(F.ws + WS_KMEAN) + (size_t)kvh * 64 * 128; const bf16* kml = kmh + 8 * 64 * 128;
    const int tok = b * 256 + w * 32 + r32, pair = tok * 32 + h;
    const bf16* qrow = (const bf16*)(F.ws + WS_Q) + (size_t)tok * DM + h * 128;
    bf16x8 qf[8];
#pragma unroll
    for (int s = 0; s < 8; ++s) qf[s] = *(const GAS bf16x8*)(qrow + 16 * s + 8 * hi);
    v4u rk[T::NLD], rv[T::NLD];
    const float NEG = -__builtin_inff();
    if (b > 0) {
        tile_load<D>(rk, kmh, 128, tid); tile_load<D>(rv, kml, 128, tid);
        if (tid < 64) hist[tid] = 0u;
        __syncthreads(); tile_store<D>(kt, rk, tid); tile_store<D>(vt, rv, tid); __syncthreads();
        int nsel[3]; unsigned rnk[3];
        { f32x16 g0, g1; qk<D>(g0, g1, vt, qf, r32, hi); __builtin_amdgcn_sched_barrier(0); qk<D, false>(g0, g1, kt, qf, r32, hi);
#pragma unroll
          for (int i = 0; i < 16; ++i) { const int n0 = crow(i, hi); g0[i] = (n0 < b) ? g0[i] : NEG; g1[i] = (n0 + 32 < b) ? g1[i] : NEG; }
#pragma unroll
          for (int j = 0; j < 3; ++j) { float bv = NEG; int bi = 64;
#pragma unroll
              for (int i = 0; i < 16; ++i) { const int n0 = crow(i, hi); if (g0[i] > bv) { bv = g0[i]; bi = n0; } }
#pragma unroll
              for (int i = 0; i < 16; ++i) { const int n1 = 32 + crow(i, hi); if (g1[i] > bv) { bv = g1[i]; bi = n1; } }
              const float ov = __shfl_xor(bv, 32); const int oi = __shfl_xor(bi, 32);
              if (ov > bv || (ov == bv && oi < bi)) { bv = ov; bi = oi; }
              nsel[j] = (bv > NEG) ? bi : -1;
#pragma unroll
              for (int i = 0; i < 16; ++i) { const int n0 = crow(i, hi); g0[i] = (n0 == bi) ? NEG : g0[i]; g1[i] = (n0 + 32 == bi) ? NEG : g1[i]; } } }
#pragma unroll
        for (int j = 0; j < 3; ++j) { rnk[j] = 0u; if (hi == 0 && nsel[j] >= 0) rnk[j] = __hip_atomic_fetch_add(hist + nsel[j], 1u, __ATOMIC_RELAXED, __HIP_MEMORY_SCOPE_WORKGROUP); }
        __syncthreads();
        if (tid < 64) { const unsigned hc = hist[tid]; unsigned bs = 0u; if (hc) bs = __hip_atomic_fetch_add((unsigned*)(F.ctl + CW_CNT) + kvh * 64 + tid, hc, RLX_AGENT); bases[tid] = bs; }
        __syncthreads();
        unsigned* lst = (unsigned*)(F.ws + WS_LIST);
#pragma unroll
        for (int j = 0; j < 3; ++j) if (hi == 0 && nsel[j] >= 0) lst[moba_list_off(kvh, nsel[j]) + bases[nsel[j]] + rnk[j]] = ((unsigned)pair << 2) | (unsigned)j;
    }
    float m = -1e30f, l = 0.f; f32x16 o[4];
#pragma unroll
    for (int db = 0; db < 4; ++db)
#pragma unroll
        for (int i = 0; i < 16; ++i) o[db][i] = 0.f;
    tile_load<D>(rk, Kb + (size_t)(b * 256) * A_KVW, A_KVW, tid); tile_load<D>(rv, Vb + (size_t)(b * 256) * A_KVW, A_KVW, tid);
    for (int tt = 0; tt < 4; ++tt) {
        __syncthreads();
        tile_store<D>(kt, rk, tid); tile_store<D>(vt, rv, tid);
        __syncthreads();
        if (tt + 1 < 4) { const size_t r0 = (size_t)b * 256 + (tt + 1) * 64; tile_load<D>(rk, Kb + r0 * A_KVW, A_KVW, tid); tile_load<D>(rv, Vb + r0 * A_KVW, A_KVW, tid); }
        if (tt * 64 <= w * 32 + 31) {
            f32x16 p0, p1; qk<D>(p0, p1, kt, qf, r32, hi);
            const int qrel = w * 32 + r32, kb = tt * 64 + 4 * hi;
#pragma unroll
            for (int i = 0; i < 16; ++i) { const int kv = kb + (i & 3) + 8 * (i >> 2); p0[i] = (kv > qrel) ? NEG : p0[i]; p1[i] = (kv + 32 > qrel) ? NEG : p1[i]; }
            softmax_update<D>(p0, p1, m, l, o);
            pv<D>(o, vt, p0, p1, lane, hi);
        }
    }
    store_part<D>((bf16*)(F.ws + WS_PARTO) + ((size_t)pair * 4 + 3) * 128, (float*)(F.ws + WS_PARTML) + ((size_t)pair * 4 + 3) * 2, o, m, l, hi, true);
    __syncthreads();
}
DI void moba_own_phase(Frame& F) {
#pragma unroll 1
    for (int p2 = 2 * F.vcu; p2 < 2 * 32 * A_H; p2 += (p2 & 1) ? 2 * F.G - 1 : 1) { const int p = p2 >> 1, h = p >> 5, bp = p & 31; moba_own_item(F, (p2 & 1) ? bp : 63 - bp, h); }
}
DI void moba_past_phase(Frame& F) {
    constexpr int D = 128; typedef TL<D> T; constexpr int IMG = 256 * T::PITCH;
    LAS unsigned char* kt = F.lds + RING_OFF; LAS unsigned char* vt = kt + IMG;
    LAS int* sc = (LAS int*)(F.lds + RING_OFF + 2 * IMG); LAS int* pc = sc + 512;
    static_assert(2 * IMG + 4096 <= LDSCTL_OFF, "MoBA past phase LDS map");
    const int lane = F.lane, r32 = lane & 31, hi = lane >> 5, w = F.wave, tid = F.tid;
    { int cv = 0; if (tid < 504) cv = (int)__hip_atomic_load((unsigned*)(F.ctl + CW_CNT) + (tid / 63) * 64 + (tid % 63), RLX_AGENT);
      pc[tid] = cv; sc[tid] = (cv + 255) >> 8; __syncthreads();
      for (int off = 1; off < 512; off <<= 1) { const int x = sc[tid] + (tid >= off ? sc[tid - off] : 0); __syncthreads(); sc[tid] = x; __syncthreads(); } }
    const int total = sc[511];
    const unsigned* lst = (const unsigned*)(F.ws + WS_LIST); const bf16* Qg = (const bf16*)(F.ws + WS_Q);
    const int i_lo = (int)(((long)total * F.vcu) / F.G), i_hi = (int)(((long)total * (F.vcu + 1)) / F.G);
#define MOBA_QLOAD(QF, E) do { const int pr_ = (int)((E) >> 2); const bf16* qrow_ = Qg + (size_t)(pr_ >> 5) * DM + (pr_ & 31) * 128; \
        _Pragma("unroll") for (int s_ = 0; s_ < 8; ++s_) QF[s_] = *(const GAS bf16x8*)(qrow_ + 16 * s_ + 8 * hi); } while (0)
    int t = 0;
    if (i_lo < i_hi) { int lo_ = 0, hi_ = 511; while (lo_ < hi_) { const int mid_ = (lo_ + hi_) >> 1; if (sc[mid_] > i_lo) hi_ = mid_; else lo_ = mid_ + 1; } t = __builtin_amdgcn_readfirstlane(lo_); }
    int t_img = -1; bf16x8 qf[8]; unsigned e = 0u; bool valid = false;
#pragma unroll 1
    for (int idx = i_lo; idx < i_hi; ++idx) {
        while (sc[t] <= idx) ++t;
        t = __builtin_amdgcn_readfirstlane(t);
        const int cnt = pc[t], c = idx - (sc[t] - ((cnt + 255) >> 8)), kvh = t / 63, n = t % 63;
        const size_t lbase = moba_list_off(kvh, n);
        if (t != t_img) {
            const bf16* Kb = (const bf16*)(F.ws + WS_K) + kvh * 128 + (size_t)(n * 256) * A_KVW; const bf16* Vb = (const bf16*)(F.ws + WS_V) + kvh * 128 + (size_t)(n * 256) * A_KVW;
            __syncthreads();
            { v4u r8[8]; tile_load<D, 8>(r8, Kb, A_KVW, tid); tile_store<D, 8>(kt, r8, tid); }
            { v4u r8[8]; tile_load<D, 8>(r8, Vb, A_KVW, tid); tile_store<D, 8>(vt, r8, tid); }
            __syncthreads();
            t_img = t;
            const int ir0 = c * 256 + w * 32 + r32; valid = ir0 < cnt; e = lst[lbase + (valid ? ir0 : 0)]; MOBA_QLOAD(qf, e);
        }
        const bool nxt_same = (idx + 1 < i_hi) && (sc[t] > idx + 1);
        unsigned e2 = 0u; bool valid2 = false;
        if (nxt_same) { const int ir2 = (c + 1) * 256 + w * 32 + r32; valid2 = ir2 < cnt; e2 = lst[lbase + (valid2 ? ir2 : 0)]; }
        const bool wact = __any(valid ? 1 : 0) != 0;
        float m = -1e30f, l = 0.f; f32x16 o[4];
#pragma unroll
        for (int db = 0; db < 4; ++db)
#pragma unroll
            for (int i = 0; i < 16; ++i) o[db][i] = 0.f;
        const int pair = (int)(e >> 2), j = (int)(e & 3u);
#pragma unroll 1
        for (int ss = 0; ss < 4; ++ss) {
            f32x16 p0, p1;
            if (wact) qk<D>(p0, p1, kt + ss * 64 * T::PITCH, qf, r32, hi);
            if (ss == 3 && nxt_same) { __builtin_amdgcn_sched_barrier(0); MOBA_QLOAD(qf, e2); }
            if (wact) { softmax_update<D>(p0, p1, m, l, o); pv<D>(o, vt + ss * 64 * T::PITCH, p0, p1, lane, hi); }
        }
        store_part<D>((bf16*)(F.ws + WS_PARTO) + ((size_t)pair * 4 + j) * 128, (float*)(F.ws + WS_PARTML) + ((size_t)pair * 4 + j) * 2, o, m, l, hi, valid);
        e = e2; valid = valid2;
    }
    __syncthreads();
#undef MOBA_QLOAD
}
DI void moba_combine_phase(Frame& F) {
    const int gw = F.vcu * NWAVES + F.wave, NGW = F.G * NWAVES, sub = F.lane >> 4, ch = F.lane & 15;
    const bf16* po = (const bf16*)(F.ws + WS_PARTO); const float* pml = (const float*)(F.ws + WS_PARTML); bf16* ob = (bf16*)(F.ws + WS_O);
#pragma unroll 1
    for (int it = gw; it < (M * A_H) / 4; it += NGW) {
        const int pair = it * 4 + sub, tok = pair >> 5, h = pair & 31, b = tok >> 8, nv = b < 3 ? b : 3;
        const f32x4 ml01 = *(const GAS f32x4*)(pml + (size_t)pair * 8), ml23 = *(const GAS f32x4*)(pml + (size_t)pair * 8 + 4);
        float mm[4] = {ml01.x, ml01.z, ml23.x, ml23.z}, ll[4] = {ml01.y, ml01.w, ml23.y, ml23.w};
        float mx = mm[3];
#pragma unroll
        for (int s = 0; s < 3; ++s) if (s < nv) mx = __builtin_fmaxf(mx, mm[s]);
        float wgt[4], wsum = 0.f;
#pragma unroll
        for (int s = 0; s < 4; ++s) { const bool ok = (s == 3) || (s < nv); wgt[s] = ok ? __builtin_amdgcn_exp2f(mm[s] - mx) * ll[s] : 0.f; wsum += wgt[s]; }
        const float inv = 1.0f / wsum; float acc[8];
#pragma unroll
        for (int e = 0; e < 8; ++e) acc[e] = 0.f;
#pragma unroll
        for (int s = 0; s < 4; ++s) { const bool ok = (s == 3) || (s < nv);
            if (ok) { const v4u v = *(const GAS v4u*)(po + ((size_t)pair * 4 + s) * 128 + ch * 8); const float ws_ = wgt[s] * inv;
                acc[0] += ws_ * bf2f(v.x & 0xffffu); acc[1] += ws_ * bf2f(v.x >> 16); acc[2] += ws_ * bf2f(v.y & 0xffffu); acc[3] += ws_ * bf2f(v.y >> 16);
                acc[4] += ws_ * bf2f(v.z & 0xffffu); acc[5] += ws_ * bf2f(v.z >> 16); acc[6] += ws_ * bf2f(v.w & 0xffffu); acc[7] += ws_ * bf2f(v.w >> 16); } }
        v4u o; o.x = cvtpk(acc[0], acc[1]); o.y = cvtpk(acc[2], acc[3]); o.z = cvtpk(acc[4], acc[5]); o.w = cvtpk(acc[6], acc[7]);
        *(GAS v4u*)(ob + (size_t)tok * DM + h * 128 + ch * 8) = o;
    }
}

DI void swa_item(Frame& F, int qb, int kvh) {
    constexpr int D = 64; typedef TL<D> T; constexpr int IMG = 384 * T::PITCH;
    LAS unsigned char* kt = F.lds + RING_OFF; LAS unsigned char* vt = kt + IMG;
    const int lane = F.lane, r32 = lane & 31, hi = lane >> 5, w = F.wave, tid = F.tid;
    const long base = (long)qb * 256 - 128; const int tb = (qb == 0) ? 2 : 0;
    const bf16* Kb = (const bf16*)(F.ws + WS_KSH) + kvh * 64 + base * B_KVW; const bf16* Vb = (const bf16*)(F.ws + WS_VSH) + kvh * 64 + base * B_KVW;
    const int tok = qb * 256 + w * 32 + r32;
    const bf16* qrow = (const bf16*)(F.ws + WS_Q) + (size_t)tok * DM + kvh * 8 * 64;
    bf16x8 qf[4];
#pragma unroll
    for (int s = 0; s < 4; ++s) qf[s] = *(const GAS bf16x8*)(qrow + 16 * s + 8 * hi);
    { v4u rk[6], rv[6];
#pragma unroll
      for (int i = 0; i < 6; ++i) { const int c = tid + 512 * i, row = c >> 3, ch = c & 7; if (row >= 64 * tb) { rk[i] = *(const GAS v4u*)(Kb + (size_t)row * B_KVW + ch * 8); rv[i] = *(const GAS v4u*)(Vb + (size_t)row * B_KVW + ch * 8); } }
      __syncthreads();
#pragma unroll
      for (int i = 0; i < 6; ++i) { const int c = tid + 512 * i, row = c >> 3, ch = c & 7; if (row >= 64 * tb) { *(LAS v4u*)(kt + row * T::PITCH + ch * 16) = rk[i]; *(LAS v4u*)(vt + row * T::PITCH + ch * 16) = rv[i]; } }
      __syncthreads(); }
    const float NEG = -__builtin_inff(); const int qs = 32 * w, qrel = qs + r32;
#pragma unroll 1
    for (int g = 0; g < 8; ++g) {
        const int h = kvh * 8 + g;
        bf16x8 qn[4];
        if (g < 7) {
#pragma unroll
            for (int s = 0; s < 4; ++s) qn[s] = *(const GAS bf16x8*)(qrow + (g + 1) * 64 + 16 * s + 8 * hi); }
        float m = F.b_sinks[h] * LOG2E, l = (hi == 0) ? 1.0f : 0.f; f32x16 o[2];
#pragma unroll
        for (int db = 0; db < 2; ++db)
#pragma unroll
            for (int i = 0; i < 16; ++i) o[db][i] = 0.f;
#pragma unroll 1
        for (int tt = tb; tt < 6; ++tt) {
            const int kbr = -128 + 64 * tt;
            if ((kbr <= qs + 31) && (kbr + 63 >= qs - 127)) {
                f32x16 p0, p1; qk<D>(p0, p1, kt + tt * 64 * T::PITCH, qf, r32, hi);
                const int kb = kbr + 4 * hi;
#pragma unroll
                for (int i = 0; i < 16; ++i) { const int kv = kb + (i & 3) + 8 * (i >> 2);
                    p0[i] = (kv <= qrel && qrel - kv < 128) ? p0[i] : NEG; p1[i] = (kv + 32 <= qrel && qrel - kv - 32 < 128) ? p1[i] : NEG; }
                softmax_update<D>(p0, p1, m, l, o);
                pv<D>(o, vt + tt * 64 * T::PITCH, p0, p1, lane, hi);
            }
        }
        store_o<D>((bf16*)(F.ws + WS_O) + (size_t)tok * DM + h * 64, o, l, hi);
        if (g < 7) {
#pragma unroll
            for (int s = 0; s < 4; ++s) qf[s] = qn[s]; }
    }
}
DI void swa_phase(Frame& F) {
#pragma unroll 1
    for (int p = F.vcu; p < 64 * 8; p += F.G) swa_item(F, p & 63, p >> 6);
    __syncthreads();
}
#undef MFMA32
}
struct Args { const float* in[13]; float* out; unsigned char* ws; int ph_lo, ph_hi; };
__global__ void __launch_bounds__(NWAVES * 64, 2) yoco_fwd(Args args) {
    extern __shared__ __attribute__((aligned(16))) unsigned char lds[];
    Frame F;
    F.lds = (LAS unsigned char*)lds;
    F.MISC = (volatile LAS unsigned*)(F.lds + MISC_OFF);
    F.tid = threadIdx.x; F.lane = F.tid & 63; F.wave = __builtin_amdgcn_readfirstlane(F.tid >> 6);
    F.G = gridDim.x; { const int bx = blockIdx.x; F.vcu = (F.G % 8 == 0) ? (bx % 8) * (F.G / 8) + bx / 8 : bx; }
    F.ws = args.ws; F.ctl = (gu32*)(args.ws + WS_CTL);
    F.x = args.in[0]; F.ffn_norm = args.in[1]; F.ffn_w_in = args.in[2]; F.ffn_w_out = args.in[3]; F.attn_norm = args.in[4]; F.a_w_qkv = args.in[5]; F.a_w_o = args.in[6];
    F.kv_norm = args.in[7]; F.w_kv = args.in[8]; F.b_w_q = args.in[9]; F.b_sinks = args.in[10]; F.b_w_o = args.in[11]; F.final_norm = args.in[12]; F.out = args.out;
    for (int u = F.tid; u < (LDS_BYTES - LDSCTL_OFF) / 4; u += NWAVES * 64) ((LAS unsigned*)(F.lds + LDSCTL_OFF))[u] = 0u;
    __syncthreads();
    XcdBarrier bar; bar.bar = (unsigned*)(F.ctl + CW_BAR); bar.x = 0; bar.st = nullptr;
    if (!MK_SPLIT) bar = xcd_barrier_post((unsigned*)(F.ctl + CW_BAR), F.MISC + 8);
#define GRID_BAR(seam) do { if (MK_SPLIT) { if (F.tid == 0) __hip_atomic_store(F.ctl + CW_TMO, 0xBADBA0u | (unsigned)(seam), RLX_AGENT); } else { xcd_barrier(bar); } } while (0)
    const int lo = args.ph_lo, hi = args.ph_hi;
#ifndef PH_MASK
#define PH_MASK 0xffffffffu
#endif
#define IN(k) ((((PH_MASK) >> (k)) & 1u) && lo <= (k) && (k) < hi)
#define SEAM(k) do { if (IN(k) && IN((k) + 1)) GRID_BAR(k); } while (0)
    bf16* const W_IN = (bf16*)(F.ws + WS_WIN); bf16* const W_OUT = (bf16*)(F.ws + WS_WOUT);
    bf16* const W_QKV = (bf16*)(F.ws + WS_WQKV); bf16* const W_AO = (bf16*)(F.ws + WS_WAO); bf16* const W_KV = (bf16*)(F.ws + WS_WKV); bf16* const W_BQ = (bf16*)(F.ws + WS_WBQ); bf16* const W_BO = (bf16*)(F.ws + WS_WBO);
    bf16* const XN = (bf16*)(F.ws + WS_XN); bf16* const ACT = (bf16*)(F.ws + WS_ACT); bf16* const QB = (bf16*)(F.ws + WS_Q); bf16* const KB = (bf16*)(F.ws + WS_K); bf16* const VB = (bf16*)(F.ws + WS_V);
    bf16* const OB = (bf16*)(F.ws + WS_O); bf16* const KSH = (bf16*)(F.ws + WS_KSH); bf16* const VSH = (bf16*)(F.ws + WS_VSH);
    const float* const COSA = (const float*)(F.ws + WS_ROPEA); const float* const SINA = COSA + (size_t)M * 64; const float* const COSB = (const float*)(F.ws + WS_ROPEB); const float* const SINB = COSB + (size_t)M * 32;
    unsigned char* const W8 = (unsigned char*)(F.ws + WS_WIN); unsigned char* const XN8 = (unsigned char*)(F.ws + WS_XN8); float* const SA = (float*)(F.ws + WS_SA);
    float* const COLMAX = (float*)(F.ctl + CW_COLMAX); constexpr int CM_BQ = 4 * 2 * DFF, CM_KV = CM_BQ + DM, CM_AO = CM_KV + 2 * B_KVW, CM_BO = CM_AO + DM, CM_OUT = CM_BO + DM, CM_QKV = CM_OUT + 4 * DM;
    bf16* const XRES = (bf16*)(F.ws + WS_XN);
    unsigned char* const ACT8 = (unsigned char*)(F.ws + WS_ACT8); float* const SACT = (float*)(F.ws + WS_SACT); unsigned char* const W8O = (unsigned char*)(F.ws + WS_WOUT);
    constexpr size_t E_WIN = (size_t)2 * DFF * DM, E_WOUT = (size_t)DFF * DM;

#define GEMM_PHASE_T(EPI_T, EPI_OBJ, A_, B_, N_, K_, TA_, TB_, WGM_) do { pg8::Gemm g_{(A_), (B_), M, (N_), (K_)}; pg8::StaticOrder S_; S_.init(M, (N_), F.G, (int)blockIdx.x, (WGM_)); \
        pg8::gemm_phase<EPI_T, pg8::StaticOrder, PG8_ALIGN, PG8_SP2, TA_, TB_>(F.lds + RING_OFF, g_, S_, (EPI_OBJ)); } while (0)
#ifndef XN_TILED
#define XN_TILED false
#endif
#define GEMM_PHASE_8(EPI_T, EPI_OBJ, A_, B_, N_, K_) do { pg8::Gemm g_{(const bf16*)(A_), (const bf16*)(B_), M, (N_), (K_)}; pg8::StaticOrder S_; S_.init(M, (N_), F.G, (int)blockIdx.x, 8); \
        pg8::gemm_phase<EPI_T, pg8::StaticOrder, PG8_ALIGN, PG8_SP2, false, true, true>(F.lds + RING_OFF, g_, S_, (EPI_OBJ)); } while (0)
#define GEMM_PHASE(EPI_T, EPI_OBJ, A_, B_, N_, K_) GEMM_PHASE_T(EPI_T, EPI_OBJ, A_, B_, N_, K_, false, true, 8)
#define GEMM_PHASE_X(EPI_T, EPI_OBJ, A_, B_, N_, K_) GEMM_PHASE_T(EPI_T, EPI_OBJ, A_, B_, N_, K_, XN_TILED, true, 8)
#ifndef DOWN_WGM
#define DOWN_WGM 2
#endif
#define FFN_UP(f)   do { pg8::EpiSwiGLU8 E_{ACT, DFF, SA, COLMAX + (size_t)(f) * 2 * DFF}; pg8::Gemm g_{(const bf16*)XN8, (const bf16*)(W8 + (size_t)(f) * E_WIN), M, 2 * DFF, DM}; \
        pg8::ClaimOrder S_; S_.init(M, 2 * DFF, F.G, (int)blockIdx.x, 8); S_.setup((unsigned*)(F.ctl + CW_CLAIM + 64 * (f)), F.MISC + 16); \
        pg8::gemm_phase<pg8::EpiSwiGLU8, pg8::ClaimOrder, PG8_ALIGN, PG8_SP2, false, true, true>(F.lds + RING_OFF, g_, S_, E_); } while (0)
#define FFN_DOWN(f, BASE_) do { pg8::EpiResid8 E_{(BASE_), (pg8::bf16_t*)XRES, DM, 0.5f, SACT, COLMAX + CM_OUT + (size_t)(f) * DM}; pg8::Gemm g_{(const bf16*)ACT8, (const bf16*)(W8O + (size_t)(f) * E_WOUT), M, DM, DFF}; \
        pg8::StaticOrder S_; S_.init(M, DM, F.G, (int)blockIdx.x, DOWN_WGM); pg8::gemm_phase<pg8::EpiResid8, pg8::StaticOrder, PG8_ALIGN, PG8_SP2, (ACT8_TILED != 0), true, true>(F.lds + RING_OFF, g_, S_, E_); } while (0)

    LAS float* const scr_ = (LAS float*)(F.lds + RING_OFF + F.wave * 16384);
#ifndef XN_FFN_DROP
#define XN_FFN_DROP 2
#endif
#ifndef FFN_W_DROP
#define FFN_W_DROP 2
#endif
#define TR_WXD(SRC, GAIN, DST, K_, N_, MODE_, LIM_, TL_, GW_, NGW_, DROP_) for (int it_ = (GW_); it_ < ((K_) / 64) * ((N_) / 32); it_ += (NGW_)) tr_item<TL_, DROP_>((SRC), (GAIN), (DST), (K_), (N_), (N_), (MODE_), (LIM_), scr_, it_, F.lane)
#define TR_WX(SRC, GAIN, DST, K_, N_, MODE_, LIM_, TL_, GW_, NGW_) for (int it_ = (GW_); it_ < ((K_) / 64) * ((N_) / 32); it_ += (NGW_)) tr_item<TL_>((SRC), (GAIN), (DST), (K_), (N_), (N_), (MODE_), (LIM_), scr_, it_, F.lane)
    const bool tailconv = false, tailwg = false;
    const int tw_ = ((int)blockIdx.x - 128) * NWAVES + F.wave, NTW_ = 128 * NWAVES;
    if (IN(0)) {
        {
        const int gw = F.vcu * NWAVES + F.wave, NGW = F.G * NWAVES;
#define TR_W(SRC, GAIN, DST, K_, N_, MODE_, LIM_, TL_) TR_WX(SRC, GAIN, DST, K_, N_, MODE_, LIM_, TL_, gw, NGW)
#define TR_WF(SRC, GAIN, DST, K_, N_, MODE_, LIM_, TL_) TR_WXD(SRC, GAIN, DST, K_, N_, MODE_, LIM_, TL_, gw, NGW, FFN_W_DROP)
        if (!tailconv) {
        }
#undef TR_W
#undef TR_WF
        { LAS unsigned* const cml_ = (LAS unsigned*)(F.lds + RING_BYTES); constexpr int S_IN = (2 * DFF) / 32, S_D = DM / 32, S_KV = (2 * B_KVW) / 32, S_QKV = NQKV / 32, S_TOT = 4 * S_IN + 3 * S_D + S_KV + S_QKV;
#pragma unroll 1
          for (int st_ = F.vcu; st_ < S_TOT; st_ += F.G) {
              const float* src_; const float* gn_; float* cm_; unsigned char* dst_; int n_, mode_, lim_, sl_;
              if (st_ < 4 * S_IN) { const int fw_ = st_ / S_IN; sl_ = st_ - fw_ * S_IN; src_ = F.ffn_w_in + (size_t)fw_ * E_WIN; gn_ = F.ffn_norm + (size_t)fw_ * DM; cm_ = COLMAX + (size_t)fw_ * 2 * DFF; dst_ = W8 + (size_t)fw_ * E_WIN; n_ = 2 * DFF; mode_ = 1; lim_ = 0; }
              else if (st_ < 4 * S_IN + S_D) { sl_ = st_ - 4 * S_IN; src_ = F.b_w_q; gn_ = F.attn_norm + DM; cm_ = COLMAX + CM_BQ; dst_ = (unsigned char*)W_BQ; n_ = DM; mode_ = 3; lim_ = 4096; }
              else if (st_ < 4 * S_IN + 2 * S_D) { sl_ = st_ - 4 * S_IN - S_D; src_ = F.a_w_o; gn_ = nullptr; cm_ = COLMAX + CM_AO; dst_ = (unsigned char*)W_AO; n_ = DM; mode_ = 0; lim_ = 0; }
              else if (st_ < 4 * S_IN + 3 * S_D) { sl_ = st_ - 4 * S_IN - 2 * S_D; src_ = F.b_w_o; gn_ = nullptr; cm_ = COLMAX + CM_BO; dst_ = (unsigned char*)W_BO; n_ = DM; mode_ = 0; lim_ = 0; }
              else if (st_ >= 4 * S_IN + 3 * S_D + S_KV) { sl_ = st_ - 4 * S_IN - 3 * S_D - S_KV; src_ = F.a_w_qkv; gn_ = F.attn_norm; cm_ = COLMAX + CM_QKV; dst_ = (unsigned char*)W_QKV; n_ = NQKV; mode_ = 2; lim_ = 5120; }
              else { sl_ = st_ - 4 * S_IN - 3 * S_D; src_ = F.w_kv; gn_ = F.kv_norm; cm_ = COLMAX + CM_KV; dst_ = (unsigned char*)W_KV; n_ = 2 * B_KVW; mode_ = 3; lim_ = 512; }
              strip_quant8(F, src_, gn_, cm_, dst_, DM, n_, mode_, lim_, sl_, scr_, cml_); } }
        { LAS unsigned* const cml_ = (LAS unsigned*)(F.lds + RING_BYTES);
#pragma unroll 1
          for (int st_ = F.vcu; st_ < 4 * (DM / 32); st_ += F.G) { const int fw_ = st_ / (DM / 32), sl_ = st_ - fw_ * (DM / 32);
              strip_quant8_rot(F, F.ffn_w_out + (size_t)fw_ * E_WOUT, COLMAX + CM_OUT + (size_t)fw_ * DM, W8O + (size_t)fw_ * E_WOUT, DFF, DM, sl_, scr_, cml_); } }
        rope_tables(F);
        norm_rows8<0>(F, F.x, XN8, SA, (bf16*)nullptr);
        }
    }
    if (IN(0) && IN(1)) GRID_BAR(0);
    if (IN(1)) { FFN_UP(0);
        if (tailwg) { TR_WX(F.a_w_qkv, F.attn_norm, W_QKV, DM, NQKV, 2, 5120, true, tw_, NTW_); } }
    if (IN(1) && IN(27)) GRID_BAR(1);
    if (IN(27)) act_quant_phase(F, ACT, ACT8, SACT);
    if (IN(27) && IN(2)) GRID_BAR(27);
    if (IN(2)) FFN_DOWN(0, F.x);
    SEAM(2);
    if (IN(3)) norm_rows8_b(F, XRES, XN8, SA);
    SEAM(3);
    if (IN(4)) { pg8::EpiRope8<128> E_{QB, KB, VB, DM, A_KVW, A_KVW, 16, 4, 0.08838834764831845f * LOG2E, COSA, SINA, SA, COLMAX + CM_QKV}; GEMM_PHASE_8(pg8::EpiRope8<128>, E_, XN8, W_QKV, NQKV, DM);
    }
    SEAM(4);
    if (IN(5)) kmean_phase(F);
    SEAM(5);
    if (IN(6)) att::moba_own_phase(F);
    SEAM(6);
    if (IN(22)) att::moba_past_phase(F);
    if (IN(22) && IN(23)) GRID_BAR(22);
    if (IN(23)) att::moba_combine_phase(F);
    if (IN(23) && IN(25)) GRID_BAR(23);
    if (IN(25)) quant_rows_bf16(F, OB, XN8, SA);
    if (IN(25) && IN(7)) GRID_BAR(25);
    if (IN(7)) { pg8::EpiResid8 E_{nullptr, (pg8::bf16_t*)XRES, DM, 1.0f, SA, COLMAX + CM_AO}; GEMM_PHASE_8(pg8::EpiResid8, E_, XN8, W_AO, DM, DM); }
    SEAM(7);
    if (IN(8)) norm_rows8_b(F, XRES, XN8, SA);
    SEAM(8);
    if (IN(9)) { FFN_UP(1);
        if (tailwg) { } }
    if (IN(9) && IN(28)) GRID_BAR(9);
    if (IN(28)) act_quant_phase(F, ACT, ACT8, SACT);
    if (IN(28) && IN(10)) GRID_BAR(28);
    if (IN(10)) FFN_DOWN(1, (const float*)nullptr);
    SEAM(10);
    if (IN(11)) norm_rows8_b(F, XRES, XN8, SA);
    SEAM(11);
    if (IN(12)) { { pg8::EpiRope8<64> E_{KSH, KSH, VSH, B_KVW, B_KVW, B_KVW, 0, 2, 1.0f, COSB, SINB, SA, COLMAX + CM_KV}; GEMM_PHASE_8(pg8::EpiRope8<64>, E_, XN8, W_KV, 2 * B_KVW, DM); }
                  FFN_UP(2);
                  }
    if (IN(12) && IN(29)) GRID_BAR(12);
    if (IN(29)) act_quant_phase(F, ACT, ACT8, SACT);
    if (IN(29) && IN(13)) GRID_BAR(29);
    if (IN(13)) FFN_DOWN(2, (const float*)nullptr);
    SEAM(13);
    if (IN(14)) norm_rows8_b(F, XRES, XN8, SA);
    SEAM(14);
    if (IN(15)) { pg8::EpiRope8<64> E_{QB, QB, QB, DM, DM, DM, 16, 0, 0.125f * LOG2E, COSB, SINB, SA, COLMAX + CM_BQ}; GEMM_PHASE_8(pg8::EpiRope8<64>, E_, XN8, W_BQ, DM, DM); }
    SEAM(15);
    if (IN(16)) att::swa_phase(F);
    if (IN(16) && IN(26)) GRID_BAR(16);
    if (IN(26)) quant_rows_bf16(F, OB, XN8, SA);
    if (IN(26) && IN(17)) GRID_BAR(26);
    if (IN(17)) { pg8::EpiResid8 E_{nullptr, (pg8::bf16_t*)XRES, DM, 1.0f, SA, COLMAX + CM_BO}; GEMM_PHASE_8(pg8::EpiResid8, E_, XN8, W_BO, DM, DM); }
    SEAM(17);
    if (IN(18)) norm_rows8_b(F, XRES, XN8, SA);
    SEAM(18);
    if (IN(19)) FFN_UP(3);
    if (IN(19) && IN(30)) GRID_BAR(19);
    if (IN(30)) act_quant_phase(F, ACT, ACT8, SACT);
    if (IN(30) && IN(20)) GRID_BAR(30);
    if (IN(20)) FFN_DOWN(3, (const float*)nullptr);
    SEAM(20);
    if (IN(21)) { bool poison = false; if (!MK_SPLIT) poison = __hip_atomic_load((gu32*)((unsigned*)(F.ctl + CW_BAR) + XB_TMO), RLX_AGENT) != 0u;
                  final_norm_rows_b(F, XRES, F.out, F.final_norm, poison); }
#undef IN
#undef SEAM
#undef GRID_BAR
}

extern "C" void kernel_launch(void* const* d_in, const int* in_sizes, int n_in, void* d_out, int out_size, void* d_ws, size_t ws_size, hipStream_t stream) {
    static int grid = 0;
    if (grid == 0) {
        if (n_in != 13 || in_sizes[0] != M * DM || out_size != M * DM || ws_size < WS_END) { fprintf(stderr, "kernel_launch: unexpected shapes: n_in %d, in0 %d, out %d, ws %zu (need %zu); nothing launched\n", n_in, n_in > 0 ? in_sizes[0] : -1, out_size, ws_size, (size_t)WS_END); grid = -1; return; }
        int dev = 0, cus = 0, per_cu = 0;
        if (hipGetDevice(&dev) != hipSuccess || hipDeviceGetAttribute(&cus, hipDeviceAttributeMultiprocessorCount, dev) != hipSuccess) { fprintf(stderr, "kernel_launch: device query failed\n"); grid = -1; return; }
        if (hipFuncSetAttribute((const void*)yoco_fwd, hipFuncAttributeMaxDynamicSharedMemorySize, LDS_BYTES) != hipSuccess) { fprintf(stderr, "kernel_launch: hipFuncSetAttribute failed\n"); grid = -1; return; }
        if (hipOccupancyMaxActiveBlocksPerMultiprocessor(&per_cu, (const void*)yoco_fwd, NWAVES * 64, LDS_BYTES) != hipSuccess || per_cu < 1)
            fprintf(stderr, "kernel_launch: note: occupancy query reports %d workgroups per CU\n", per_cu);
        (void)hipGetLastError();
        grid = cus;
    }
    if (grid < 0) return;
    if (hipMemsetAsync((char*)d_ws + WS_CTL, 0, CTL_ZERO_BYTES, stream) != hipSuccess) { fprintf(stderr, "kernel_launch: hipMemsetAsync failed\n"); return; }
    Args a{};
    for (int i = 0; i < 13; ++i) a.in[i] = (const float*)d_in[i];
    a.out = (float*)d_out; a.ws = (unsigned char*)d_ws;
#if MK_SPLIT
    static const int order[N_PHASES] = {0, 24, 1, 27, 2, 3, 4, 5, 6, 22, 23, 25, 7, 8, 9, 28, 10, 11, 12, 29, 13, 14, 15, 16, 26, 17, 18, 19, 30, 20, 21};
    for (int k = 0; k < N_PHASES; ++k) { a.ph_lo = order[k]; a.ph_hi = order[k] + 1; hipLaunchKernelGGL(yoco_fwd, dim3(grid), dim3(NWAVES * 64), LDS_BYTES, stream, a); }
#else
    a.ph_lo = 0; a.ph_hi = N_PHASES;
    hipLaunchKernelGGL(yoco_fwd, dim3(grid), dim3(NWAVES * 64), LDS_BYTES, stream, a);
#endif
    const hipError_t le = hipPeekAtLastError();
    if (le != hipSuccess) fprintf(stderr, "kernel_launch: launch failed: %s\n", hipGetErrorName(le));
}
```

```cpp
#include <hip/hip_runtime.h>
#include <cstdio>
#include <cstdint>
#include <cmath>
namespace pg8 {
#define PG8_LAS __attribute__((address_space(3)))
typedef unsigned short bf16_t;
typedef short bf16x8 __attribute__((ext_vector_type(8)));
typedef float f32x4 __attribute__((ext_vector_type(4)));
typedef unsigned u32x4 __attribute__((ext_vector_type(4)));
typedef unsigned u32x2 __attribute__((ext_vector_type(2)));
constexpr int BM = 256, BK = 64, HALF = 128, HTB = HALF * BK * 2  , STAGE_BYTES = 8 * HTB, NXCD = 8, WGM = 8;

__host__ __device__ __forceinline__ int lds_byte(int r, int c) { const int st = (r >> 4) * 2 + (c >> 5), rr = r & 15, cc = c & 31, ob = rr * 64 + cc * 2; return st * 1024 + (ob ^ (((ob >> 9) & 1) << 5)); }
__host__ __device__ __forceinline__ void stage_rc(int b, int& R, int& C) { const int st = b / 1024, sb = b % 1024, swz = sb ^ (((sb >> 9) & 1) << 5); R = (st >> 1) * 16 + swz / 64; C = (st & 1) * 32 + (swz % 64) / 2; }
__host__ __device__ __forceinline__ int perm32(int rho) { const int n = rho >> 4, i = rho & 15; return 8 * (i >> 2) + 4 * n + (i & 3); }

__host__ __device__ __forceinline__ size_t tiled_off(int r, int k, int K) { return (size_t)(r >> 8) * ((size_t)BM * K) + (size_t)(k >> 6) * (BM * BK) + (size_t)(r & 255) * BK + (k & 63); }
typedef int i32x4 __attribute__((ext_vector_type(4)));
template <bool I8> struct AccType { typedef f32x4 type; };
template <> struct AccType<true> { typedef i32x4 type; };
__device__ __forceinline__ f32x4 mma16(bf16x8 a, bf16x8 b, f32x4 c) { return __builtin_amdgcn_mfma_f32_16x16x32_bf16(a, b, c, 0, 0, 0); }
__device__ __forceinline__ i32x4 mma16(bf16x8 a, bf16x8 b, i32x4 c) { return __builtin_amdgcn_mfma_i32_16x16x64_i8(__builtin_bit_cast(i32x4, a), __builtin_bit_cast(i32x4, b), c, 0, 0, 0); }
struct Unit { int pm, pn; };
struct Gemm { const bf16_t* A; const bf16_t* Bt; int M, N, K; };

struct StaticOrder {
    int nM, nN, nwg, G, c, wgm, i0, i1;
    __host__ __device__ void init(int M, int N, int G_, int c_, int wgm_ = WGM, int i0_ = 0, int i1_ = 1 << 20) { nM = M / BM; nN = N / BM; nwg = nM * nN; G = G_; c = c_; wgm = wgm_; i0 = i0_; i1 = i1_; }
    __host__ __device__ void decode(long L, Unit& u) const {
        int wgid = (int)L; { const int q = nwg / NXCD, r = nwg % NXCD, xcd = wgid % NXCD, off = wgid / NXCD; wgid = (xcd < r ? xcd * (q + 1) : r * (q + 1) + (xcd - r) * q) + off; }
        const int nig = wgm * nN, gid = wgid / nig, fm = gid * wgm, gsz = (nM - fm) < wgm ? (nM - fm) : wgm;
        u.pm = fm + ((wgid % nig) % gsz); u.pn = (wgid % nig) / gsz;
    }
    __host__ __device__ bool next(int i, Unit& u) const {
        if (i + i0 >= i1) return false;
        const long L = (long)(i + i0) * G + c; if (L >= nwg) return false;
        decode(L, u); return true;
    }
    __device__ __forceinline__ void a_ready(const Unit&) const {}
    __device__ __forceinline__ void done(const Unit&) const {}
};
struct ClaimOrder : StaticOrder {
    int nfull, nleft; unsigned* ctr; volatile PG8_LAS unsigned* slot;
    __device__ void setup(unsigned* ctr_, volatile PG8_LAS unsigned* slot_) { nfull = nwg / G; nleft = nwg - nfull * G; ctr = ctr_; slot = slot_; }
    __device__ __forceinline__ bool next(int i, Unit& u) const {
        if (i < nfull) { decode((long)i * G + c, u); return true; }
        if (i > nfull || nleft == 0) return false;
        if (threadIdx.x == 0) { const unsigned id = __hip_atomic_fetch_add(ctr, 1u, __ATOMIC_RELAXED, __HIP_MEMORY_SCOPE_AGENT); *slot = id; }
        asm volatile("s_waitcnt lgkmcnt(0)" ::: "memory"); __builtin_amdgcn_s_barrier(); asm volatile("" ::: "memory");
        const unsigned id = *slot;
        if (id >= (unsigned)nleft) return false;
        decode((long)nfull * G + id, u); return true;
    }
};
__device__ __forceinline__ unsigned cvt_pk_bf16(float lo, float hi) { unsigned r; asm volatile("v_cvt_pk_bf16_f32 %0, %1, %2" : "=v"(r) : "v"(lo), "v"(hi)); return r; }
__device__ __forceinline__ float silu_mul(float g, float u) { return g * u * __builtin_amdgcn_rcpf(1.0f + __builtin_amdgcn_exp2f(g * -1.4426950408889634f)); }
#ifndef ACT_DROP
#define ACT_DROP 0
#endif
struct EpiSwiGLU {
    static constexpr bool PERM = true, AFTER_DRAIN = false;
    bf16_t* O; int ldc;
    __device__ __forceinline__ void operator()(const f32x4 (&acc)[2][2][4][2], const Unit& u, int wr, int wc, int fr, int fq) const {
        const int row0 = u.pm * BM + wr * 64 + fr, col0 = u.pn * HALF + wc * 32 + 8 * fq;
#pragma unroll
        for (int ai = 0; ai < 2; ++ai)
#pragma unroll
            for (int m = 0; m < 4; ++m) { bf16_t* p = O + tiled_off(row0 + ai * HALF + m * 16, col0, ldc);
                const f32x4 g0 = acc[ai][0][m][0], g1 = acc[ai][0][m][1], u0 = acc[ai][1][m][0], u1 = acc[ai][1][m][1];
                u32x4 w; w.x = cvt_pk_bf16(silu_mul(g0[0], u0[0]), silu_mul(g0[1], u0[1])); w.y = cvt_pk_bf16(silu_mul(g0[2], u0[2]), silu_mul(g0[3], u0[3]));
                w.z = cvt_pk_bf16(silu_mul(g1[0], u1[0]), silu_mul(g1[1], u1[1])); w.w = cvt_pk_bf16(silu_mul(g1[2], u1[2]), silu_mul(g1[3], u1[3]));
                if (ACT_DROP > 0) { constexpr unsigned add_ = ((1u << ACT_DROP) >> 1) * 0x00010001u, msk_ = ~(((1u << ACT_DROP) - 1u) * 0x00010001u);
                    w.x = (w.x + add_) & msk_; w.y = (w.y + add_) & msk_; w.z = (w.z + add_) & msk_; w.w = (w.w + add_) & msk_; }
                *(u32x4*)p = w; }
    }
};
struct EpiSwiGLU8 {
    static constexpr bool PERM = true, AFTER_DRAIN = false;
    bf16_t* O; int ldc; const float* sA; const float* colmax;
    __device__ __forceinline__ void operator()(const i32x4 (&acc)[2][2][4][2], const Unit& u, int wr, int wc, int fr, int fq) const {
        const int row0 = u.pm * BM + wr * 64 + fr, col0 = u.pn * HALF + wc * 32 + 8 * fq;
        const f32x4 sg0 = *(const f32x4*)(colmax + col0) * (1.0f / 127.0f), sg1 = *(const f32x4*)(colmax + col0 + 4) * (1.0f / 127.0f);
        const f32x4 su0 = *(const f32x4*)(colmax + ldc + col0) * (1.0f / 127.0f), su1 = *(const f32x4*)(colmax + ldc + col0 + 4) * (1.0f / 127.0f);
        float rs[2][4];
#pragma unroll
        for (int ai = 0; ai < 2; ++ai)
#pragma unroll
            for (int m = 0; m < 4; ++m) rs[ai][m] = sA[row0 + ai * HALF + m * 16];
#pragma unroll
        for (int ai = 0; ai < 2; ++ai)
#pragma unroll
            for (int m = 0; m < 4; ++m) { bf16_t* p = O + (size_t)(row0 + ai * HALF + m * 16) * ldc + col0; const float r = rs[ai][m];
                const f32x4 g0 = __builtin_convertvector(acc[ai][0][m][0], f32x4) * sg0 * r, g1 = __builtin_convertvector(acc[ai][0][m][1], f32x4) * sg1 * r;
                const f32x4 u0 = __builtin_convertvector(acc[ai][1][m][0], f32x4) * su0 * r, u1 = __builtin_convertvector(acc[ai][1][m][1], f32x4) * su1 * r;
                u32x4 w; w.x = cvt_pk_bf16(silu_mul(g0[0], u0[0]), silu_mul(g0[1], u0[1])); w.y = cvt_pk_bf16(silu_mul(g0[2], u0[2]), silu_mul(g0[3], u0[3]));
                w.z = cvt_pk_bf16(silu_mul(g1[0], u1[0]), silu_mul(g1[1], u1[1])); w.w = cvt_pk_bf16(silu_mul(g1[2], u1[2]), silu_mul(g1[3], u1[3]));
                *(u32x4*)p = w; }
    }
};
struct EpiResid {
    static constexpr bool PERM = false, AFTER_DRAIN = false;
    const float* base; float* out; int ldc; float alpha;
    __device__ __forceinline__ void operator()(const f32x4 (&acc)[2][2][4][2], const Unit& u, int wr, int wc, int fr, int fq) const {
        const int row0 = u.pm * BM + wr * 64 + fr, col0 = u.pn * BM + wc * 32 + 4 * fq;
#pragma unroll
        for (int ai = 0; ai < 2; ++ai)
#pragma unroll
            for (int m = 0; m < 4; ++m) { const size_t off = (size_t)(row0 + ai * HALF + m * 16) * ldc + col0;
#pragma unroll
                for (int bj = 0; bj < 2; ++bj)
#pragma unroll
                    for (int n = 0; n < 2; ++n) { const f32x4 b = *(const f32x4*)(base + off + bj * HALF + n * 16); *(f32x4*)(out + off + bj * HALF + n * 16) = b + acc[ai][bj][m][n] * alpha; }
                asm volatile("" ::: "memory"); }
    }
};
template <int DH> struct EpiRope {
    static constexpr bool PERM = true, AFTER_DRAIN = false;
    bf16_t *dq, *dk, *dv; int ldq, ldk, ldv, nq, nk; float qscale; const float *cosT, *sinT;
    __device__ __forceinline__ void operator()(const f32x4 (&acc)[2][2][4][2], const Unit& u, int wr, int wc, int fr, int fq) const {
        const int row0 = u.pm * BM + wr * 64 + fr;
        if (u.pn >= nq + nk) {
            const int col0 = (u.pn - nq - nk) * BM + wc * 32 + 8 * fq;
#pragma unroll
            for (int ai = 0; ai < 2; ++ai)
#pragma unroll
                for (int m = 0; m < 4; ++m) { bf16_t* p = dv + (size_t)(row0 + ai * HALF + m * 16) * ldv + col0;
#pragma unroll
                    for (int bj = 0; bj < 2; ++bj) { const f32x4 v0 = acc[ai][bj][m][0], v1 = acc[ai][bj][m][1];
                        u32x4 w; w.x = cvt_pk_bf16(v0[0], v0[1]); w.y = cvt_pk_bf16(v0[2], v0[3]); w.z = cvt_pk_bf16(v1[0], v1[1]); w.w = cvt_pk_bf16(v1[2], v1[3]);
                        *(u32x4*)(p + bj * HALF) = w; } }
            return;
        }
        const bool isq = u.pn < nq; bf16_t* dst = isq ? dq : dk; const int ld = isq ? ldq : ldk, pt = isq ? u.pn : u.pn - nq; const float sc = isq ? qscale : 1.0f;
        constexpr int HD2 = DH / 2, HPT = BM / DH;
        const int t = wc * 32 + 8 * fq, hl = t / HD2, i0 = t % HD2, col1 = (HPT * pt + hl) * DH + i0;
#pragma unroll
        for (int ai = 0; ai < 2; ++ai)
#pragma unroll
            for (int m = 0; m < 4; ++m) { const int row = row0 + ai * HALF + m * 16;
                const f32x4 c0 = *(const f32x4*)(cosT + (size_t)row * HD2 + i0), c1 = *(const f32x4*)(cosT + (size_t)row * HD2 + i0 + 4);
                const f32x4 s0 = *(const f32x4*)(sinT + (size_t)row * HD2 + i0), s1 = *(const f32x4*)(sinT + (size_t)row * HD2 + i0 + 4);
                const f32x4 xa0 = acc[ai][0][m][0], xa1 = acc[ai][0][m][1], xb0 = acc[ai][1][m][0], xb1 = acc[ai][1][m][1];
                const f32x4 o10 = (xa0 * c0 - xb0 * s0) * sc, o11 = (xa1 * c1 - xb1 * s1) * sc, o20 = (xb0 * c0 + xa0 * s0) * sc, o21 = (xb1 * c1 + xa1 * s1) * sc;
                bf16_t* p = dst + (size_t)row * ld + col1;
                u32x4 w; w.x = cvt_pk_bf16(o10[0], o10[1]); w.y = cvt_pk_bf16(o10[2], o10[3]); w.z = cvt_pk_bf16(o11[0], o11[1]); w.w = cvt_pk_bf16(o11[2], o11[3]);
                *(u32x4*)p = w;
                w.x = cvt_pk_bf16(o20[0], o20[1]); w.y = cvt_pk_bf16(o20[2], o20[3]); w.z = cvt_pk_bf16(o21[0], o21[1]); w.w = cvt_pk_bf16(o21[2], o21[3]);
                *(u32x4*)(p + HD2) = w;
                asm volatile("" ::: "memory"); }
    }
};
template <int DH> struct EpiRope8 {
    static constexpr bool PERM = true, AFTER_DRAIN = false;
    bf16_t *dq, *dk, *dv; int ldq, ldk, ldv, nq, nk; float qscale; const float *cosT, *sinT; const float* sA; const float* colmax;
    __device__ __forceinline__ void operator()(const i32x4 (&acc)[2][2][4][2], const Unit& u, int wr, int wc, int fr, int fq) const {
        const int row0 = u.pm * BM + wr * 64 + fr;
        float rs[2][4];
#pragma unroll
        for (int ai = 0; ai < 2; ++ai)
#pragma unroll
            for (int m = 0; m < 4; ++m) rs[ai][m] = sA[row0 + ai * HALF + m * 16];
        if (u.pn >= nq + nk) {
            const int col0 = (u.pn - nq - nk) * BM + wc * 32 + 8 * fq, src0 = u.pn * BM + wc * 32 + 8 * fq;
            f32x4 sc[2][2];
#pragma unroll
            for (int bj = 0; bj < 2; ++bj) { sc[bj][0] = *(const f32x4*)(colmax + src0 + bj * HALF) * (1.0f / 127.0f); sc[bj][1] = *(const f32x4*)(colmax + src0 + bj * HALF + 4) * (1.0f / 127.0f); }
#pragma unroll
            for (int ai = 0; ai < 2; ++ai)
#pragma unroll
                for (int m = 0; m < 4; ++m) { bf16_t* p = dv + (size_t)(row0 + ai * HALF + m * 16) * ldv + col0; const float r = rs[ai][m];
#pragma unroll
                    for (int bj = 0; bj < 2; ++bj) { const f32x4 v0 = __builtin_convertvector(acc[ai][bj][m][0], f32x4) * sc[bj][0] * r, v1 = __builtin_convertvector(acc[ai][bj][m][1], f32x4) * sc[bj][1] * r;
                        u32x4 w; w.x = cvt_pk_bf16(v0[0], v0[1]); w.y = cvt_pk_bf16(v0[2], v0[3]); w.z = cvt_pk_bf16(v1[0], v1[1]); w.w = cvt_pk_bf16(v1[2], v1[3]);
                        *(u32x4*)(p + bj * HALF) = w; } }
            return;
        }
        const bool isq = u.pn < nq; bf16_t* dst = isq ? dq : dk; const int ld = isq ? ldq : ldk, pt = isq ? u.pn : u.pn - nq; const float scq = isq ? qscale : 1.0f;
        constexpr int HD2 = DH / 2, HPT = BM / DH;
        const int t = wc * 32 + 8 * fq, hl = t / HD2, i0 = t % HD2, col1 = (HPT * pt + hl) * DH + i0, src1 = (HPT * u.pn + hl) * DH + i0;
        const f32x4 sa0 = *(const f32x4*)(colmax + src1) * (1.0f / 127.0f), sa1 = *(const f32x4*)(colmax + src1 + 4) * (1.0f / 127.0f);
        const f32x4 sb0 = *(const f32x4*)(colmax + src1 + HD2) * (1.0f / 127.0f), sb1 = *(const f32x4*)(colmax + src1 + HD2 + 4) * (1.0f / 127.0f);
#pragma unroll
        for (int ai = 0; ai < 2; ++ai)
#pragma unroll
            for (int m = 0; m < 4; ++m) { const int row = row0 + ai * HALF + m * 16; const float r = rs[ai][m];
                const f32x4 c0 = *(const f32x4*)(cosT + (size_t)row * HD2 + i0), c1 = *(const f32x4*)(cosT + (size_t)row * HD2 + i0 + 4);
                const f32x4 s0 = *(const f32x4*)(sinT + (size_t)row * HD2 + i0), s1 = *(const f32x4*)(sinT + (size_t)row * HD2 + i0 + 4);
                const f32x4 xa0 = __builtin_convertvector(acc[ai][0][m][0], f32x4) * sa0 * r, xa1 = __builtin_convertvector(acc[ai][0][m][1], f32x4) * sa1 * r;
                const f32x4 xb0 = __builtin_convertvector(acc[ai][1][m][0], f32x4) * sb0 * r, xb1 = __builtin_convertvector(acc[ai][1][m][1], f32x4) * sb1 * r;
                const f32x4 o10 = (xa0 * c0 - xb0 * s0) * scq, o11 = (xa1 * c1 - xb1 * s1) * scq, o20 = (xb0 * c0 + xa0 * s0) * scq, o21 = (xb1 * c1 + xa1 * s1) * scq;
                bf16_t* p = dst + (size_t)row * ld + col1;
                u32x4 w; w.x = cvt_pk_bf16(o10[0], o10[1]); w.y = cvt_pk_bf16(o10[2], o10[3]); w.z = cvt_pk_bf16(o11[0], o11[1]); w.w = cvt_pk_bf16(o11[2], o11[3]);
                *(u32x4*)p = w;
                w.x = cvt_pk_bf16(o20[0], o20[1]); w.y = cvt_pk_bf16(o20[2], o20[3]); w.z = cvt_pk_bf16(o21[0], o21[1]); w.w = cvt_pk_bf16(o21[2], o21[3]);
                *(u32x4*)(p + HD2) = w;
                asm volatile("" ::: "memory"); }
    }
};
struct EpiResid8 {
    static constexpr bool PERM = false, AFTER_DRAIN = false;
    const float* base; bf16_t* xr; int ldc; float alpha; const float* sA; const float* colmax;
    __device__ __forceinline__ void operator()(const i32x4 (&acc)[2][2][4][2], const Unit& u, int wr, int wc, int fr, int fq) const {
        const int row0 = u.pm * BM + wr * 64 + fr, col0 = u.pn * BM + wc * 32 + 4 * fq;
        f32x4 sc[2][2];
#pragma unroll
        for (int bj = 0; bj < 2; ++bj)
#pragma unroll
            for (int n = 0; n < 2; ++n) sc[bj][n] = *(const f32x4*)(colmax + col0 + bj * HALF + n * 16) * (alpha * (1.0f / 127.0f));
        float rs[2][4];
#pragma unroll
        for (int ai = 0; ai < 2; ++ai)
#pragma unroll
            for (int m = 0; m < 4; ++m) rs[ai][m] = sA[row0 + ai * HALF + m * 16];
#pragma unroll
        for (int ai = 0; ai < 2; ++ai)
#pragma unroll
            for (int m = 0; m < 4; ++m) { const size_t off = (size_t)(row0 + ai * HALF + m * 16) * ldc + col0; const float r = rs[ai][m];
#pragma unroll
                for (int bj = 0; bj < 2; ++bj)
#pragma unroll
                    for (int n = 0; n < 2; ++n) { f32x4 b;
                        if (base) b = *(const f32x4*)(base + off + bj * HALF + n * 16);
                        else { const u32x2 w = *(const u32x2*)(xr + off + bj * HALF + n * 16); b[0] = __builtin_bit_cast(float, w.x << 16); b[1] = __builtin_bit_cast(float, w.x & 0xffff0000u); b[2] = __builtin_bit_cast(float, w.y << 16); b[3] = __builtin_bit_cast(float, w.y & 0xffff0000u); }
                        const f32x4 o = b + __builtin_convertvector(acc[ai][bj][m][n], f32x4) * sc[bj][n] * r;
                        u32x2 y; y.x = cvt_pk_bf16(o[0], o[1]); y.y = cvt_pk_bf16(o[2], o[3]); *(u32x2*)(xr + off + bj * HALF + n * 16) = y; }
                asm volatile("" ::: "memory"); }
    }
};
template <class Epi, class Sched, bool ALIGN_EPI = false, bool SP2 = false, bool TA = false, bool TB = false, bool I8 = false>
__device__ __forceinline__ void gemm_phase(PG8_LAS unsigned char* lds, const Gemm g, const Sched& S, const Epi& E) {
    const int tid = threadIdx.x, wid = __builtin_amdgcn_readfirstlane(tid >> 6), lane = tid & 63, wr = wid >> 2, wc = wid & 3, fr = lane & 15, fq = lane >> 4;
    const int KB = I8 ? g.K : 2 * g.K, nt = KB / (BK * 2);
    unsigned voffA[2], voffB[2];
#pragma unroll
    for (int i = 0; i < 2; ++i) { int R, C; stage_rc(tid * 16 + i * 8192, R, C); const int Rb = Epi::PERM ? ((R & ~31) + perm32(R & 31)) : R;
        voffA[i] = (unsigned)(R * (TA ? BK * 2 : KB) + C * 2); voffB[i] = (unsigned)(Rb * (TB ? BK * 2 : KB) + C * 2); }
    const size_t kstepA = TA ? (size_t)(BM * BK * 2) : (size_t)(BK * 2), kstepB = TB ? (size_t)(BM * BK * 2) : (size_t)(BK * 2);
    const size_t hstepA = TA ? (size_t)(HALF * BK * 2) : (size_t)HALF * KB, hstepB = TB ? (size_t)(HALF * BK * 2) : (size_t)HALF * KB;
    const size_t tstep = (size_t)BM * KB;
    const unsigned ldsw = (unsigned)wid * 1024u;
    const int aoff = lds_byte(wr * 64 + fr, fq * 8), boff = lds_byte(wc * 32 + fr, fq * 8);
#define PG8_SA(b, h) (((b) * 2 + (h)) * HTB)
#define PG8_SB(b, h) ((4 + (b) * 2 + (h)) * HTB)
#define PG8_STAGE(bufoff, gbase, voff) do { _Pragma("unroll") for (int _i = 0; _i < 2; ++_i) \
        __builtin_amdgcn_global_load_lds((const unsigned*)((const char*)(gbase) + (voff)[_i]), (PG8_LAS unsigned*)(lds + (bufoff) + ldsw + _i * 8192), 16, 0, 0); } while (0)
#define PG8_LDA(dst, b, h) do { _Pragma("unroll") for (int m = 0; m < 4; ++m) _Pragma("unroll") for (int k = 0; k < 2; ++k) dst[m][k] = *(const PG8_LAS bf16x8*)(lds + PG8_SA(b, h) + aoff + m * 2048 + k * 1024); } while (0)
#define PG8_LDB(dst, b, h) do { _Pragma("unroll") for (int n = 0; n < 2; ++n) _Pragma("unroll") for (int k = 0; k < 2; ++k) dst[n][k] = *(const PG8_LAS bf16x8*)(lds + PG8_SB(b, h) + boff + n * 2048 + k * 1024); } while (0)
#define PG8_MMA(ai, bj, At, Bt) do { __builtin_amdgcn_s_setprio(1); _Pragma("unroll") for (int m = 0; m < 4; ++m) _Pragma("unroll") for (int n = 0; n < 2; ++n) _Pragma("unroll") for (int k = 0; k < 2; ++k) \
        acc[ai][bj][m][n] = mma16(Bt[n][k], At[m][k], acc[ai][bj][m][n]); __builtin_amdgcn_s_setprio(0); } while (0)
#define PG8_WAIT_V(n) asm volatile("s_waitcnt vmcnt(" #n ")" ::: "memory")
#define PG8_WAIT_L(n) asm volatile("s_waitcnt lgkmcnt(" #n ")" ::: "memory")
#define PG8_BAR __builtin_amdgcn_s_barrier()
#define PG8_SCHED __builtin_amdgcn_sched_barrier(0)
    Unit cur, nxt; int ui = 0;
    if (!S.next(0, cur)) return;
    typedef typename AccType<I8>::type accv;
    accv acc[2][2][4][2];
#pragma unroll
    for (int a = 0; a < 2; ++a)
#pragma unroll
        for (int b = 0; b < 2; ++b)
#pragma unroll
            for (int m = 0; m < 4; ++m)
#pragma unroll
                for (int n = 0; n < 2; ++n) acc[a][b][m][n] = (accv){0, 0, 0, 0};
    bf16x8 At[4][2], B0[2][2], B1[2][2];
    const char* cA = (const char*)g.A + (size_t)cur.pm * tstep; const char* cB = (const char*)g.Bt + (size_t)cur.pn * tstep;
    S.a_ready(cur);
    if constexpr (SP2) {
        PG8_STAGE(PG8_SB(0, 0), cB, voffB); PG8_STAGE(PG8_SB(0, 1), cB + hstepB, voffB); PG8_STAGE(PG8_SA(0, 0), cA, voffA); PG8_STAGE(PG8_SA(0, 1), cA + hstepA, voffA);
        if (wr == 1) PG8_BAR;
        PG8_WAIT_V(2); PG8_BAR;
        PG8_STAGE(PG8_SB(1, 0), cB + kstepB, voffB); PG8_STAGE(PG8_SA(1, 0), cA + kstepA, voffA); PG8_STAGE(PG8_SB(1, 1), cB + hstepB + kstepB, voffB);
        PG8_WAIT_V(6); PG8_BAR;
    } else {
        PG8_STAGE(PG8_SB(0, 0), cB, voffB); PG8_STAGE(PG8_SA(0, 0), cA, voffA); PG8_STAGE(PG8_SB(0, 1), cB + hstepB, voffB); PG8_STAGE(PG8_SA(0, 1), cA + hstepA, voffA);
        if (wr == 1) PG8_BAR;
        PG8_WAIT_V(4); PG8_BAR;
        PG8_STAGE(PG8_SB(1, 0), cB + kstepB, voffB); PG8_STAGE(PG8_SA(1, 0), cA + kstepA, voffA); PG8_STAGE(PG8_SB(1, 1), cB + hstepB + kstepB, voffB);
        PG8_WAIT_V(6); PG8_BAR;
    }
    for (;;) {
        const bool has_next = S.next(ui + 1, nxt);
        const char* nA = has_next ? (const char*)g.A + (size_t)nxt.pm * tstep : cA; const char* nB = has_next ? (const char*)g.Bt + (size_t)nxt.pn * tstep : cB;
        for (int t = 0; t < nt; t += 2) {
            const bool last = (t == nt - 2);
            const char* a1 = cA + (size_t)(t + 1) * kstepA;
            const char* a2 = last ? nA : cA + (size_t)(t + 2) * kstepA; const char* b2 = last ? nB : cB + (size_t)(t + 2) * kstepB;
            const char* a3 = a2 + kstepA; const char* b3 = b2 + kstepB;
            if (last && has_next) S.a_ready(nxt);
            if constexpr (SP2) {
            PG8_LDB(B0, 0, 0); PG8_LDB(B1, 0, 1); PG8_SCHED; PG8_LDA(At, 0, 0); PG8_STAGE(PG8_SA(1, 1), a1 + hstepA, voffA);
            PG8_WAIT_V(8); PG8_WAIT_L(0); PG8_BAR; PG8_MMA(0, 0, At, B0); PG8_MMA(0, 1, At, B1); PG8_BAR; PG8_SCHED;
            PG8_LDA(At, 0, 1); PG8_STAGE(PG8_SB(0, 0), b2, voffB); PG8_STAGE(PG8_SB(0, 1), b2 + hstepB, voffB); PG8_STAGE(PG8_SA(0, 0), a2, voffA);
            PG8_WAIT_V(8); PG8_WAIT_L(0); PG8_BAR; PG8_MMA(1, 0, At, B0); PG8_MMA(1, 1, At, B1); PG8_BAR; PG8_SCHED;
            PG8_LDB(B0, 1, 0); PG8_LDB(B1, 1, 1); PG8_SCHED; PG8_LDA(At, 1, 0); PG8_STAGE(PG8_SA(0, 1), a2 + hstepA, voffA);
            PG8_WAIT_V(8); PG8_WAIT_L(0); PG8_BAR; PG8_MMA(0, 0, At, B0); PG8_MMA(0, 1, At, B1); PG8_BAR; PG8_SCHED;
            PG8_LDA(At, 1, 1); PG8_STAGE(PG8_SB(1, 0), b3, voffB); PG8_STAGE(PG8_SB(1, 1), b3 + hstepB, voffB); PG8_STAGE(PG8_SA(1, 0), a3, voffA);
            PG8_WAIT_V(8); PG8_WAIT_L(0); PG8_BAR; PG8_MMA(1, 0, At, B0); PG8_MMA(1, 1, At, B1); PG8_BAR; PG8_SCHED;
            } else {
            PG8_LDB(B0, 0, 0); PG8_SCHED; PG8_LDA(At, 0, 0); PG8_STAGE(PG8_SA(1, 1), a1 + hstepA, voffA);
            PG8_WAIT_L(8); PG8_BAR; PG8_WAIT_L(0); PG8_MMA(0, 0, At, B0); PG8_BAR; PG8_SCHED;
            PG8_LDB(B1, 0, 1); PG8_STAGE(PG8_SB(0, 0), b2, voffB);
            PG8_BAR; PG8_WAIT_L(0); PG8_MMA(0, 1, At, B1); PG8_BAR;
            PG8_LDA(At, 0, 1); PG8_STAGE(PG8_SA(0, 0), a2, voffA);
            PG8_BAR; PG8_WAIT_L(0); PG8_MMA(1, 0, At, B0); PG8_BAR; PG8_SCHED;
            PG8_STAGE(PG8_SB(0, 1), b2 + hstepB, voffB);
            PG8_WAIT_V(6); PG8_BAR; PG8_MMA(1, 1, At, B1); PG8_BAR;
            PG8_LDB(B0, 1, 0); PG8_SCHED; PG8_LDA(At, 1, 0); PG8_STAGE(PG8_SA(0, 1), a2 + hstepA, voffA);
            PG8_WAIT_L(8); PG8_BAR; PG8_WAIT_L(0); PG8_MMA(0, 0, At, B0); PG8_BAR; PG8_SCHED;
            PG8_LDB(B1, 1, 1); PG8_STAGE(PG8_SB(1, 0), b3, voffB);
            PG8_BAR; PG8_WAIT_L(0); PG8_MMA(0, 1, At, B1); PG8_BAR;
            PG8_LDA(At, 1, 1); PG8_STAGE(PG8_SA(1, 0), a3, voffA);
            PG8_BAR; PG8_WAIT_L(0); PG8_MMA(1, 0, At, B0); PG8_BAR; PG8_SCHED;
            PG8_STAGE(PG8_SB(1, 1), b3 + hstepB, voffB);
            PG8_WAIT_V(6); PG8_BAR; PG8_MMA(1, 1, At, B1); PG8_BAR;
            }
        }
        if constexpr (ALIGN_EPI) { if (wr == 0) PG8_BAR; }
        if constexpr (!Epi::AFTER_DRAIN) { E(acc, cur, wr, wc, fr, fq); S.done(cur); }
        if (!has_next) break;
#pragma unroll
        for (int a = 0; a < 2; ++a)
#pragma unroll
            for (int b = 0; b < 2; ++b)
#pragma unroll
                for (int m = 0; m < 4; ++m)
#pragma unroll
                    for (int n = 0; n < 2; ++n) acc[a][b][m][n] = (accv){0, 0, 0, 0};
        cur = nxt; cA = nA; cB = nB; ++ui;
        if constexpr (ALIGN_EPI) { if (wr == 1) PG8_BAR; }
    }
    PG8_WAIT_V(0);
    if constexpr (!ALIGN_EPI) { if (wr == 0) PG8_BAR; }
    PG8_BAR;
    if constexpr (Epi::AFTER_DRAIN) { E.fused(acc, cur, wr, wc, fr, fq, lds, wid, lane); S.done(cur); }
#undef PG8_SA
#undef PG8_SB
#undef PG8_STAGE
#undef PG8_LDA
#undef PG8_LDB
#undef PG8_MMA
#undef PG8_WAIT_V
#undef PG8_WAIT_L
#undef PG8_BAR
#undef PG8_SCHED
}
}
constexpr int NWAVES = 8;
#ifndef MK_SPLIT
#define MK_SPLIT 0
#endif
#ifndef PG8_SP2
#define PG8_SP2 true
#endif
#ifndef PG8_ALIGN
#define PG8_ALIGN true
#endif
#ifndef XN_TILED
#define XN_TILED false
#endif
constexpr int N_PHASES = 31;

constexpr int SEQ = 16384, DM = 4096, DFF = 11008, M = SEQ;
constexpr int A_H = 32, A_D = 128, A_KVW = 1024, NQKV = 6144;
constexpr int B_H = 64, B_D = 64, B_KVW = 512;
constexpr int NBLK = 64;
constexpr float RMS_EPS = 1e-6f;
constexpr float LOG2E = 1.4426950408889634f;

constexpr size_t MiB = 1u << 20;
constexpr size_t WS_CTL = 0, CTL_ZERO_BYTES = 1 * MiB;
constexpr size_t SZ_WIN = 172 * MiB, SZ_WOUT = 86 * MiB;
constexpr size_t WS_WIN = 1 * MiB;
constexpr size_t WS_WOUT = WS_WIN + 4 * SZ_WIN;
constexpr size_t WS_WQKV = WS_WOUT + 4 * SZ_WOUT;
constexpr size_t WS_WAO = WS_WQKV + 48 * MiB;
constexpr size_t WS_WKV = WS_WAO + 32 * MiB;
constexpr size_t WS_WBQ = WS_WKV + 8 * MiB;
constexpr size_t WS_WBO = WS_WBQ + 32 * MiB;
constexpr size_t WS_XN = WS_WBO + 32 * MiB;
constexpr size_t WS_ACT = WS_XN + 128 * MiB;
constexpr size_t WS_Q = WS_ACT + 344 * MiB;
constexpr size_t WS_K = WS_Q + 128 * MiB;
constexpr size_t WS_V = WS_K + 32 * MiB;
constexpr size_t WS_O = WS_V + 32 * MiB;
constexpr size_t WS_KSH = WS_O + 128 * MiB;
constexpr size_t WS_VSH = WS_KSH + 16 * MiB;
constexpr size_t WS_ROPEA = WS_VSH + 16 * MiB;
constexpr size_t WS_ROPEB = WS_ROPEA + 8 * MiB;
constexpr size_t WS_KMEAN = WS_ROPEB + 4 * MiB;
constexpr size_t WS_LIST = WS_KMEAN + 1 * MiB;
constexpr size_t WS_PARTO = WS_LIST + 63 * MiB;
constexpr size_t WS_PARTML = WS_PARTO + 512 * MiB;
constexpr size_t WS_XN8 = WS_PARTML + 16 * MiB;
constexpr size_t WS_SA = WS_XN8 + 64 * MiB;
constexpr size_t WS_ACT8 = WS_SA + 1 * MiB;
constexpr size_t WS_SACT = WS_ACT8 + 172 * MiB;
constexpr size_t WS_END = WS_SACT + 1 * MiB;
static_assert(SZ_WIN == (size_t)22016 * 4096 * 2 && SZ_WOUT == (size_t)4096 * 11008 * 2, "weight sizes");
constexpr int CW_TMO = 0, CW_CODE = 1;
constexpr int CW_BAR = 4096;
constexpr int CW_CLAIM = 12288;
constexpr int CW_COLMAX = 32768;
constexpr int CW_CNT = 8192;

constexpr int RING_OFF = 0, RING_BYTES = 131072;
constexpr int LDSCTL_OFF = 146944, MISC_OFF = LDSCTL_OFF + 256;
constexpr int LDS_BYTES = 147456;
static_assert(MISC_OFF + 128 <= 147456 && RING_BYTES <= LDSCTL_OFF, "LDS map");

#define GAS __attribute__((address_space(1)))
#define LAS __attribute__((address_space(3)))
#define DI __device__ __forceinline__
typedef unsigned short bf16;
typedef unsigned v4u __attribute__((ext_vector_type(4)));
typedef unsigned v2u __attribute__((ext_vector_type(2)));
typedef float f32x4 __attribute__((ext_vector_type(4)));
typedef float f32x16 __attribute__((ext_vector_type(16)));
typedef short bf16x8 __attribute__((ext_vector_type(8)));
typedef short s16x4 __attribute__((ext_vector_type(4)));
typedef GAS unsigned gu32;
#define RLX_AGENT __ATOMIC_RELAXED, __HIP_MEMORY_SCOPE_AGENT
#define LDS_WAIT() asm volatile("s_waitcnt lgkmcnt(0)" ::: "memory")
#define VM_WAIT() asm volatile("s_waitcnt vmcnt(0)" ::: "memory")
DI unsigned f2bf(float f) { unsigned u = __builtin_bit_cast(unsigned, f); return (u + 0x7fffu + ((u >> 16) & 1u)) >> 16; }
DI unsigned pk2(float lo, float hi) { return f2bf(lo) | (f2bf(hi) << 16); }
DI float bf2f(unsigned b) { return __builtin_bit_cast(float, b << 16); }
#define XB_TMO      128
#define XB_XCNT(j)  (256  + 64 * (j))
#define XB_XSUB(j)  (1280 + 64 * (j))
#define XB_XGEN(j)  (2304 + 64 * (j))
#define XB_TOP      3328
#define XB_TOPGEN   3392
#define XCD_BAR_WORDS 3456
#define XB_SPIN_CAP (1u << 18)

__device__ __forceinline__ unsigned xb_ld(unsigned* p)              { return __hip_atomic_load(p, __ATOMIC_RELAXED, __HIP_MEMORY_SCOPE_AGENT); }
__device__ __forceinline__ unsigned xb_add(unsigned* p, unsigned v) { return __hip_atomic_fetch_add(p, v, __ATOMIC_RELAXED, __HIP_MEMORY_SCOPE_AGENT); }
__device__ __forceinline__ unsigned xb_xcc_id() { return (unsigned)__builtin_amdgcn_s_getreg((3 << 11) | 20) & 0xFu; }
#define XB_SPIN(cond, bar) do { unsigned _sp = 0; while (cond) { __builtin_amdgcn_s_sleep(1); \
    if ((++_sp & 255u) == 0u) { if (xb_ld(&(bar)[XB_TMO])) break; if (_sp > XB_SPIN_CAP) { atomicAdd(&(bar)[XB_TMO], 1u); break; } } } } while (0)

struct XcdBarrier {
    unsigned* bar; unsigned x;
    volatile LAS unsigned* st;
};

__device__ __forceinline__ XcdBarrier xcd_barrier_post(unsigned* bar, volatile LAS unsigned* st) {
    XcdBarrier b; b.bar = bar; b.x = xb_xcc_id(); b.st = st;
    if (threadIdx.x == 0) (void)xb_add(&bar[XB_XCNT(b.x)], 1u);
    return b;
}
__device__ __forceinline__ void xcd_barrier_complete(unsigned* bar, unsigned x, unsigned& nloc, unsigned& nx) {
    const unsigned G = gridDim.x * gridDim.y * gridDim.z;
    unsigned sum, cnt, mine, sp = 0u;
    for (;;) {
        sum = 0u; cnt = 0u; mine = 0u;
#pragma unroll
        for (unsigned j = 0; j < 16; ++j) { const unsigned c = xb_ld(&bar[XB_XCNT(j)]); sum += c; cnt += (c > 0u) ? 1u : 0u; mine = (j == x) ? c : mine; }
        if (sum == G) break;
        __builtin_amdgcn_s_sleep(1);
        if ((++sp & 255u) == 0u) { if (xb_ld(&bar[XB_TMO])) break; if (sp > XB_SPIN_CAP) { atomicAdd(&bar[XB_TMO], 1u); break; } }
    }
    nloc = mine > 0u ? mine : 1u; nx = cnt > 0u ? cnt : 1u;
}

__device__ __forceinline__ void xcd_barrier(const XcdBarrier& b) {
    asm volatile("s_waitcnt vmcnt(0)" ::: "memory");
    __syncthreads();
    if (threadIdx.x == 0) {
        unsigned* bar = b.bar;
        __builtin_amdgcn_s_waitcnt(0);
        unsigned nloc = b.st[0], nx = b.st[1];
        if (nloc == 0u) { xcd_barrier_complete(bar, b.x, nloc, nx); b.st[0] = nloc; b.st[1] = nx; }
        const unsigned old = xb_add(&bar[XB_XSUB(b.x)], 1u);
        const unsigned gen = old / nloc;
        if (old + 1u == (gen + 1u) * nloc) {
            __builtin_amdgcn_fence(__ATOMIC_RELEASE, "agent");
            asm volatile("s_waitcnt vmcnt(0)" ::: "memory");
            const unsigned og = xb_add(&bar[XB_TOP], 1u);
            const unsigned tg = og / nx;
            if (og + 1u == (tg + 1u) * nx) xb_add(&bar[XB_TOPGEN], 1u);
            else XB_SPIN(xb_ld(&bar[XB_TOPGEN]) == tg, bar);
            __builtin_amdgcn_fence(__ATOMIC_ACQUIRE, "agent");
            xb_add(&bar[XB_XGEN(b.x)], 1u);
            asm volatile("s_waitcnt vmcnt(0)" ::: "memory");
        } else {
            XB_SPIN(xb_ld(&bar[XB_XGEN(b.x)]) == gen, bar);
            __builtin_amdgcn_fence(__ATOMIC_ACQUIRE, "agent");
            asm volatile("s_waitcnt vmcnt(0)" ::: "memory");
        }
    }
    __syncthreads();
}
struct Frame {
    LAS unsigned char* lds;
    volatile LAS unsigned* MISC;
    gu32* ctl;
    int tid, lane, wave;
    int vcu, G;
    unsigned char* ws;
    const float* x; const float* ffn_norm; const float* ffn_w_in; const float* ffn_w_out; const float* attn_norm; const float* a_w_qkv; const float* a_w_o;
    const float* kv_norm; const float* w_kv; const float* b_w_q; const float* b_sinks; const float* b_w_o; const float* final_norm;
    float* out;
};
DI float wave_sum(float v) {
#pragma unroll
    for (int o = 1; o < 64; o <<= 1) v += __shfl_xor(v, o);
    return v;
}
__device__ const float ROPE_INV[64] = {
1.000000000e+00f, 8.659643531e-01f, 7.498942018e-01f, 6.493816376e-01f, 5.623413324e-01f, 4.869675338e-01f, 4.216965139e-01f, 3.651741147e-01f, 3.162277639e-01f, 2.738419771e-01f, 2.371373922e-01f, 2.053525001e-01f, 1.778279394e-01f, 1.539926529e-01f, 1.333521456e-01f, 1.154782027e-01f,
1.000000015e-01f, 8.659642935e-02f, 7.498941571e-02f, 6.493816525e-02f, 5.623412877e-02f, 4.869675264e-02f, 4.216964915e-02f, 3.651741147e-02f, 3.162277862e-02f, 2.738419734e-02f, 2.371373586e-02f, 2.053524926e-02f, 1.778279431e-02f, 1.539926510e-02f, 1.333521493e-02f, 1.154781971e-02f,
9.999999776e-03f, 8.659643121e-03f, 7.498942316e-03f, 6.493816618e-03f, 5.623413250e-03f, 4.869675264e-03f, 4.216964822e-03f, 3.651741426e-03f, 3.162277862e-03f, 2.738419687e-03f, 2.371373819e-03f, 2.053525066e-03f, 1.778279431e-03f, 1.539926627e-03f, 1.333521446e-03f, 1.154781901e-03f,
1.000000047e-03f, 8.659643354e-04f, 7.498941850e-04f, 6.493816618e-04f, 5.623413017e-04f, 4.869675031e-04f, 4.216965463e-04f, 3.651741135e-04f, 3.162277862e-04f, 2.738419571e-04f, 2.371373848e-04f, 2.053525241e-04f, 1.778279402e-04f, 1.539926452e-04f, 1.333521504e-04f, 1.154782076e-04f };

template <int DROP> DI unsigned f2bf_drop(float f) { unsigned u = __builtin_bit_cast(unsigned, f); constexpr int sh = 16 + DROP; u += ((1u << (sh - 1)) - 1u) + ((u >> sh) & 1u); return ((u >> sh) << DROP) & 0xffffu; }

DI int map_col(int mode, int lim, int c) {
    const int pn = c >> 8, bj = (c >> 7) & 1, t = c & 127;
    if (mode == 1) return bj * DFF + 128 * pn + t;
    if (mode == 2 && c < lim) return (2 * pn + (t >> 6)) * 128 + 64 * bj + (t & 63);
    if (mode == 3 && c < lim) return (4 * pn + (t >> 5)) * 64 + 32 * bj + (t & 31);
    return c;
}
template <bool TILED, int DROP = 0> DI void tr_item(const float* __restrict__ src, const float* __restrict__ gain, bf16* __restrict__ dst, int K, int N, int ld, int mode, int lim, LAS float* scr, int item, int lane) {
    const int nblk = N >> 5, kb = item / nblk, nb = item - kb * nblk, k0 = kb << 6, n0 = nb << 5, s0 = map_col(mode, lim, n0);
    const int kr = lane >> 3, c4 = lane & 7;
    f32x4 v[8]; float g[8];
#pragma unroll
    for (int it = 0; it < 8; ++it) { v[it] = *(const GAS f32x4*)(src + (size_t)(k0 + 8 * it + kr) * ld + s0 + 4 * c4); g[it] = gain ? gain[k0 + 8 * it + kr] : 1.0f; }
#pragma unroll
    for (int it = 0; it < 8; ++it) { LAS float* p = scr + (8 * it + kr) * 33 + 4 * c4; p[0] = v[it].x * g[it]; p[1] = v[it].y * g[it]; p[2] = v[it].z * g[it]; p[3] = v[it].w * g[it]; }
    LDS_WAIT(); asm volatile("" ::: "memory");
#pragma unroll
    for (int j = 0; j < 4; ++j) { const int n = kr + 8 * j; const LAS float* s = scr + (8 * c4) * 33 + n;
#define PKW(a_, b_) (DROP > 0 ? (f2bf_drop<DROP>(a_) | (f2bf_drop<DROP>(b_) << 16)) : pk2(a_, b_))
        v4u o; o.x = PKW(s[0 * 33], s[1 * 33]); o.y = PKW(s[2 * 33], s[3 * 33]); o.z = PKW(s[4 * 33], s[5 * 33]); o.w = PKW(s[6 * 33], s[7 * 33]);
#undef PKW
        *(GAS v4u*)(dst + (TILED ? pg8::tiled_off(n0 + n, k0 + 8 * c4, K) : (size_t)(n0 + n) * K + k0 + 8 * c4)) = o; }
    LDS_WAIT(); asm volatile("" ::: "memory");
}
DI void sincos_acc(float angf, float& s, float& c) {
    const double x = (double)angf, q = __builtin_rint(x * 0.63661977236758134308);
    double r = __builtin_fma(-q, 1.57079632679489655800e+00, x); r = __builtin_fma(-q, 6.12323399573676603587e-17, r);
    const int qi = (int)q & 3; const double r2 = r * r;
    const double sp = r + r * r2 * (-1.0 / 6 + r2 * (1.0 / 120 + r2 * (-1.0 / 5040 + r2 * (1.0 / 362880 + r2 * (-1.0 / 39916800 + r2 * (1.0 / 6227020800.0))))));
    const double cp = 1.0 + r2 * (-0.5 + r2 * (1.0 / 24 + r2 * (-1.0 / 720 + r2 * (1.0 / 40320 + r2 * (-1.0 / 3628800 + r2 * (1.0 / 479001600 + r2 * (-1.0 / 87178291200.0)))))));
    const double ss = (qi & 1) ? cp : sp, cc = (qi & 1) ? sp : cp;
    s = (float)((qi & 2) ? -ss : ss); c = (float)(((qi + 1) & 2) ? -cc : cc);
}
DI void rope_tables(Frame& F) {
    const int gt = (F.vcu * NWAVES + F.wave) * 64 + F.lane, NT = F.G * NWAVES * 64;
    float* ca = (float*)(F.ws + WS_ROPEA); float* sa = ca + (size_t)M * 64; float* cb = (float*)(F.ws + WS_ROPEB); float* sb = cb + (size_t)M * 32;
    for (int e = gt; e < M * 64; e += NT) { const int pos = e >> 6, i = e & 63; float s, c; sincos_acc((float)pos * ROPE_INV[i], s, c); ca[e] = c; sa[e] = s; }
    for (int e = gt; e < M * 32; e += NT) { const int pos = e >> 5, i = e & 31; float s, c; sincos_acc((float)pos * ROPE_INV[2 * i], s, c); cb[e] = c; sb[e] = s; }
}
template <int DROP = 0> DI void norm_rows(Frame& F, const float* x, bf16* xn) {
    const int gw = F.vcu * NWAVES + F.wave, NGW = F.G * NWAVES;
    for (int m = gw; m < M; m += NGW) {
        const GAS f32x4* xr = (const GAS f32x4*)(x + (size_t)m * DM) + F.lane;
        f32x4 v[16]; float s = 0.f;
#pragma unroll
        for (int j = 0; j < 16; ++j) { v[j] = xr[64 * j]; s += (v[j].x * v[j].x + v[j].y * v[j].y) + (v[j].z * v[j].z + v[j].w * v[j].w); }
        const float r = 1.0f / sqrtf(wave_sum(s) * (1.0f / DM) + RMS_EPS);
#pragma unroll
        for (int j = 0; j < 16; ++j) { v2u w; if (DROP > 0) { w.x = f2bf_drop<DROP>(v[j].x * r) | (f2bf_drop<DROP>(v[j].y * r) << 16); w.y = f2bf_drop<DROP>(v[j].z * r) | (f2bf_drop<DROP>(v[j].w * r) << 16); }
            else { w.x = pk2(v[j].x * r, v[j].y * r); w.y = pk2(v[j].z * r, v[j].w * r); } const int col = 256 * j + 4 * F.lane;
            *(GAS v2u*)(xn + (XN_TILED ? pg8::tiled_off(m, col, DM) : (size_t)m * DM + col)) = w; }
    }
}
DI void colmax_item(const float* __restrict__ src, const float* __restrict__ gain, unsigned* cm, int N, int item, int lane) {
    const int ncg = N >> 8, rb = item / ncg, cg = item - rb * ncg; const int c0 = cg * 256 + 4 * lane;
    f32x4 mx = {0.f, 0.f, 0.f, 0.f};
#pragma unroll 8
    for (int r = 0; r < 256; ++r) { const int k = rb * 256 + r; const f32x4 v = *(const GAS f32x4*)(src + (size_t)k * N + c0) * (gain ? gain[k] : 1.0f);
        mx.x = __builtin_fmaxf(mx.x, __builtin_fabsf(v.x)); mx.y = __builtin_fmaxf(mx.y, __builtin_fabsf(v.y)); mx.z = __builtin_fmaxf(mx.z, __builtin_fabsf(v.z)); mx.w = __builtin_fmaxf(mx.w, __builtin_fabsf(v.w)); }
    __hip_atomic_fetch_max(cm + c0 + 0, __builtin_bit_cast(unsigned, mx.x), RLX_AGENT); __hip_atomic_fetch_max(cm + c0 + 1, __builtin_bit_cast(unsigned, mx.y), RLX_AGENT);
    __hip_atomic_fetch_max(cm + c0 + 2, __builtin_bit_cast(unsigned, mx.z), RLX_AGENT); __hip_atomic_fetch_max(cm + c0 + 3, __builtin_bit_cast(unsigned, mx.w), RLX_AGENT);
}
DI unsigned q8x4(float a, float b, float c, float d, float inv) { unsigned w = 0u;
    w = __builtin_amdgcn_cvt_pk_u8_f32(__builtin_rintf(__builtin_fmaf(a, inv, 128.f)), 0, w); w = __builtin_amdgcn_cvt_pk_u8_f32(__builtin_rintf(__builtin_fmaf(b, inv, 128.f)), 1, w);
    w = __builtin_amdgcn_cvt_pk_u8_f32(__builtin_rintf(__builtin_fmaf(c, inv, 128.f)), 2, w); w = __builtin_amdgcn_cvt_pk_u8_f32(__builtin_rintf(__builtin_fmaf(d, inv, 128.f)), 3, w); return w ^ 0x80808080u; }
DI unsigned q8(float v) { const float r = __builtin_rintf(v); const int i = (int)__builtin_fminf(__builtin_fmaxf(r, -127.f), 127.f); return (unsigned)i & 0xffu; }
DI void tr_item8(const float* __restrict__ src, const float* __restrict__ gain, const float* __restrict__ cm, unsigned char* __restrict__ dst, int K, int N, int mode, int lim, int item, LAS float* scr, int lane) {
    const int nblk = N >> 5, kb = item / nblk, nb = item - kb * nblk, k0 = kb << 6, n0 = nb << 5, s0 = map_col(mode, lim, n0);
    const int kr = lane >> 3, c4 = lane & 7;
    f32x4 v[8]; float g[8];
#pragma unroll
    for (int it = 0; it < 8; ++it) { v[it] = *(const GAS f32x4*)(src + (size_t)(k0 + 8 * it + kr) * N + s0 + 4 * c4); g[it] = gain ? gain[k0 + 8 * it + kr] : 1.0f; }
#pragma unroll
    for (int it = 0; it < 8; ++it) { LAS float* p = scr + (8 * it + kr) * 33 + 4 * c4; p[0] = v[it].x * g[it]; p[1] = v[it].y * g[it]; p[2] = v[it].z * g[it]; p[3] = v[it].w * g[it]; }
    LDS_WAIT(); asm volatile("" ::: "memory");
#pragma unroll
    for (int j = 0; j < 4; ++j) { const int n = kr + 8 * j; const LAS float* s = scr + (8 * c4) * 33 + n;
        const float cmx = cm[s0 + n], inv = cmx > 0.f ? 127.0f / cmx : 0.f;
        v2u o; o.x = q8x4(s[0 * 33], s[1 * 33], s[2 * 33], s[3 * 33], inv);
        o.y = q8x4(s[4 * 33], s[5 * 33], s[6 * 33], s[7 * 33], inv);
        const int nn = n0 + n, kk = k0 + 8 * c4;
        *(GAS v2u*)(dst + (size_t)(nn >> 8) * ((size_t)256 * K) + (size_t)(kk >> 7) * (256 * 128) + (size_t)(nn & 255) * 128 + (kk & 127)) = o; }
    LDS_WAIT(); asm volatile("" ::: "memory");
}
DI void strip_quant8(Frame& F, const float* __restrict__ src, const float* __restrict__ gain, float* __restrict__ cm, unsigned char* __restrict__ dst, int K, int N, int mode, int lim, int strip, LAS float* scr, LAS unsigned* cml) {
    const int n0 = strip << 5, s0 = map_col(mode, lim, n0), lane = F.lane, kr = lane >> 3, c4 = lane & 7, nkb = K >> 6;
    if (F.tid < 32) cml[F.tid] = 0u;
    __syncthreads();
    f32x4 mx = {0.f, 0.f, 0.f, 0.f};
#pragma unroll 1
    for (int kb = F.wave; kb < nkb; kb += NWAVES) {
#pragma unroll
        for (int it = 0; it < 8; ++it) { const int k = (kb << 6) + 8 * it + kr; const f32x4 v = *(const GAS f32x4*)(src + (size_t)k * N + s0 + 4 * c4) * (gain ? gain[k] : 1.0f);
            mx.x = __builtin_fmaxf(mx.x, __builtin_fabsf(v.x)); mx.y = __builtin_fmaxf(mx.y, __builtin_fabsf(v.y)); mx.z = __builtin_fmaxf(mx.z, __builtin_fabsf(v.z)); mx.w = __builtin_fmaxf(mx.w, __builtin_fabsf(v.w)); } }
#pragma unroll
    for (int o = 8; o < 64; o <<= 1) { mx.x = __builtin_fmaxf(mx.x, __shfl_xor(mx.x, o)); mx.y = __builtin_fmaxf(mx.y, __shfl_xor(mx.y, o)); mx.z = __builtin_fmaxf(mx.z, __shfl_xor(mx.z, o)); mx.w = __builtin_fmaxf(mx.w, __shfl_xor(mx.w, o)); }
    if (lane < 8) { __hip_atomic_fetch_max(cml + 4 * lane + 0, __builtin_bit_cast(unsigned, mx.x), __ATOMIC_RELAXED, __HIP_MEMORY_SCOPE_WORKGROUP); __hip_atomic_fetch_max(cml + 4 * lane + 1, __builtin_bit_cast(unsigned, mx.y), __ATOMIC_RELAXED, __HIP_MEMORY_SCOPE_WORKGROUP);
                    __hip_atomic_fetch_max(cml + 4 * lane + 2, __builtin_bit_cast(unsigned, mx.z), __ATOMIC_RELAXED, __HIP_MEMORY_SCOPE_WORKGROUP); __hip_atomic_fetch_max(cml + 4 * lane + 3, __builtin_bit_cast(unsigned, mx.w), __ATOMIC_RELAXED, __HIP_MEMORY_SCOPE_WORKGROUP); }
    __syncthreads();
#pragma unroll 1
    for (int kb = F.wave; kb < nkb; kb += NWAVES) { const int k0 = kb << 6;
        f32x4 v[8]; float g[8];
#pragma unroll
        for (int it = 0; it < 8; ++it) { v[it] = *(const GAS f32x4*)(src + (size_t)(k0 + 8 * it + kr) * N + s0 + 4 * c4); g[it] = gain ? gain[k0 + 8 * it + kr] : 1.0f; }
#pragma unroll
        for (int it = 0; it < 8; ++it) { LAS float* p = scr + (8 * it + kr) * 33 + 4 * c4; p[0] = v[it].x * g[it]; p[1] = v[it].y * g[it]; p[2] = v[it].z * g[it]; p[3] = v[it].w * g[it]; }
        LDS_WAIT(); asm volatile("" ::: "memory");
#pragma unroll
        for (int j = 0; j < 4; ++j) { const int n = kr + 8 * j; const LAS float* s = scr + (8 * c4) * 33 + n;
            const float cmx = __builtin_bit_cast(float, cml[n]), inv = cmx > 0.f ? 127.0f / cmx : 0.f;
            v2u o; o.x = q8x4(s[0 * 33], s[1 * 33], s[2 * 33], s[3 * 33], inv);
            o.y = q8x4(s[4 * 33], s[5 * 33], s[6 * 33], s[7 * 33], inv);
            const int nn = n0 + n, kk = k0 + 8 * c4;
            *(GAS v2u*)(dst + (size_t)(nn >> 8) * ((size_t)256 * K) + (size_t)(kk >> 7) * (256 * 128) + (size_t)(nn & 255) * 128 + (kk & 127)) = o; }
        LDS_WAIT(); asm volatile("" ::: "memory"); }
    if (F.tid < 32) cm[s0 + F.tid] = __builtin_bit_cast(float, cml[F.tid]);
    __syncthreads();
}
#ifndef HAD_ON
#define HAD_ON 1
#endif
#ifndef ACT8_TILED
#define ACT8_TILED 0
#endif
DI void fwht_inlane8(float (&v)[8]) {
#pragma unroll
    for (int b = 1; b < 8; b <<= 1)
#pragma unroll
        for (int i = 0; i < 8; ++i) if (!(i & b)) { const float lo = v[i], hi = v[i | b]; v[i] = lo + hi; v[i | b] = lo - hi; }
}
template <int CTRL> DI float dpp_f(float v) { return __builtin_bit_cast(float, __builtin_amdgcn_update_dpp(0, __builtin_bit_cast(int, v), CTRL, 0xf, 0xf, false)); }
DI float swz_xor4(float v) { return __builtin_bit_cast(float, __builtin_amdgcn_ds_swizzle(__builtin_bit_cast(int, v), 0x101f)); }
constexpr int AQ_NIT = 11;
DI void aq_load(const bf16* act, int m, int sub, int lane, v4u (&t)[AQ_NIT]) {
    const bf16* row = act + (size_t)m * DFF + sub * (AQ_NIT * 512) + lane * 8;
#pragma unroll
    for (int it = 0; it < AQ_NIT; ++it) { t[it] = v4u{0u, 0u, 0u, 0u}; if (sub * (AQ_NIT * 512) + it * 512 + lane * 8 < DFF) t[it] = *(const GAS v4u*)(row + it * 512); }
}
DI void act_quant_phase(Frame& F, const bf16* act, unsigned char* aq, float* sact) {
    const int lane = F.lane, pair = F.wave >> 1, sub = F.wave & 1, step = F.G * (NWAVES / 2);
    LAS float* const smx = (LAS float*)(F.lds + RING_BYTES);
    const float s1 = (lane & 1) ? -1.f : 1.f, s2 = (lane & 2) ? -1.f : 1.f, s4 = (lane & 4) ? -1.f : 1.f;
    int par = 0;
    v4u t[AQ_NIT];
    { const int m = F.vcu * (NWAVES / 2) + pair; aq_load(act, m < M ? m : 0, sub, lane, t); }
#pragma unroll 1
    for (int m0 = F.vcu * (NWAVES / 2); m0 < M; m0 += step, par ^= 8) {
        const int m = m0 + pair; const bool rowok = m < M;
        float r[AQ_NIT][8]; float mx = 0.f;
#pragma unroll
        for (int it = 0; it < AQ_NIT; ++it) {
            float v[8] = {bf2f(t[it].x & 0xffffu), __builtin_bit_cast(float, t[it].x & 0xffff0000u), bf2f(t[it].y & 0xffffu), __builtin_bit_cast(float, t[it].y & 0xffff0000u),
                          bf2f(t[it].z & 0xffffu), __builtin_bit_cast(float, t[it].z & 0xffff0000u), bf2f(t[it].w & 0xffffu), __builtin_bit_cast(float, t[it].w & 0xffff0000u)};
            if (HAD_ON) { fwht_inlane8(v);
#pragma unroll
                for (int i = 0; i < 8; ++i) v[i] = __builtin_fmaf(v[i], s1, dpp_f<0xB1>(v[i]));
#pragma unroll
                for (int i = 0; i < 8; ++i) v[i] = __builtin_fmaf(v[i], s2, dpp_f<0x4E>(v[i]));
#pragma unroll
                for (int i = 0; i < 8; ++i) v[i] = __builtin_fmaf(v[i], s4, swz_xor4(v[i])); }
#pragma unroll
            for (int i = 0; i < 8; ++i) { mx = __builtin_fmaxf(mx, __builtin_fabsf(v[i])); r[it][i] = v[i]; } }
        { const int mn = m + step; aq_load(act, mn < M ? mn : 0, sub, lane, t); }
#pragma unroll
        for (int s = 1; s < 64; s <<= 1) mx = __builtin_fmaxf(mx, __shfl_xor(mx, s));
        if (lane == 0) smx[par + F.wave] = mx;
        __syncthreads();
        mx = __builtin_fmaxf(smx[par + 2 * pair], smx[par + 2 * pair + 1]);
        const float inv = mx > 0.f ? 127.0f / mx : 0.f;
#pragma unroll
        for (int it = 0; it < AQ_NIT; ++it) { const int e0 = sub * (AQ_NIT * 512) + it * 512 + lane * 8;
            v2u w = {0u, 0u};
#pragma unroll
            for (int i = 0; i < 4; ++i) { w.x = __builtin_amdgcn_cvt_pk_u8_f32(__builtin_rintf(__builtin_fmaf(r[it][i], inv, 128.f)), i, w.x);
                                          w.y = __builtin_amdgcn_cvt_pk_u8_f32(__builtin_rintf(__builtin_fmaf(r[it][4 + i], inv, 128.f)), i, w.y); }
            w.x ^= 0x80808080u; w.y ^= 0x80808080u;
            if (rowok && e0 < DFF) *(GAS v2u*)(aq + (ACT8_TILED ? (size_t)(m >> 8) * ((size_t)256 * DFF) + (size_t)(e0 >> 7) * (256 * 128) + (size_t)(m & 255) * 128 + (e0 & 127) : (size_t)m * DFF + e0)) = w; }
        if (rowok && sub == 0 && lane == 0) sact[m] = mx * (HAD_ON ? 0.125f / 127.0f : 1.0f / 127.0f);
    }
    __syncthreads();
}
DI void rot_tile_col(const LAS float* scr, int lane, float (&v)[32]) {
    const int n = lane & 31, half = lane >> 5;
#pragma unroll
    for (int i = 0; i < 32; ++i) v[i] = scr[(32 * half + i) * 33 + n];
    if (HAD_ON) {
#pragma unroll
        for (int b = 1; b < 32; b <<= 1)
#pragma unroll
            for (int i = 0; i < 32; ++i) if (!(i & b)) { const float lo = v[i], hi = v[i | b]; v[i] = lo + hi; v[i | b] = lo - hi; }
#pragma unroll
        for (int i = 0; i < 32; ++i) { const float p = __shfl_xor(v[i], 32); v[i] = (half ? p - v[i] : v[i] + p) * 0.125f; } }
}
DI void strip_quant8_rot(Frame& F, const float* __restrict__ src, float* __restrict__ cm, unsigned char* __restrict__ dst, int K, int N, int strip, LAS float* scr, LAS unsigned* cml) {
    const int n0 = strip << 5, lane = F.lane, kr = lane >> 3, c4 = lane & 7, nkb = K >> 6, n = lane & 31, half = lane >> 5;
    if (F.tid < 32) cml[F.tid] = 0u;
    __syncthreads();
    float mxc = 0.f;
#pragma unroll 1
    for (int pass = 0; pass < 2; ++pass) {
        float inv = 0.f; if (pass) { const float cmx = __builtin_bit_cast(float, cml[n]); inv = cmx > 0.f ? 127.0f / cmx : 0.f; }
#pragma unroll 1
        for (int kb = F.wave; kb < nkb; kb += NWAVES) { const int k0 = kb << 6;
            f32x4 t[8];
#pragma unroll
            for (int it = 0; it < 8; ++it) t[it] = *(const GAS f32x4*)(src + (size_t)(k0 + 8 * it + kr) * N + n0 + 4 * c4);
#pragma unroll
            for (int it = 0; it < 8; ++it) { LAS float* p = scr + (8 * it + kr) * 33 + 4 * c4; p[0] = t[it].x; p[1] = t[it].y; p[2] = t[it].z; p[3] = t[it].w; }
            LDS_WAIT(); asm volatile("" ::: "memory");
            float v[32]; rot_tile_col(scr, lane, v);
            if (!pass) {
#pragma unroll
                for (int i = 0; i < 32; ++i) mxc = __builtin_fmaxf(mxc, __builtin_fabsf(v[i])); }
            else { v4u o[2];
#pragma unroll
                for (int h = 0; h < 2; ++h)
#pragma unroll
                    for (int c = 0; c < 4; ++c) { const int i = 16 * h + 4 * c; o[h][c] = q8x4(v[i], v[i + 1], v[i + 2], v[i + 3], inv); }
                const int nn = n0 + n, kk = k0 + 32 * half;
                unsigned char* p = dst + (size_t)(nn >> 8) * ((size_t)256 * K) + (size_t)(kk >> 7) * (256 * 128) + (size_t)(nn & 255) * 128 + (kk & 127);
                *(GAS v4u*)p = o[0]; *(GAS v4u*)(p + 16) = o[1]; }
            LDS_WAIT(); asm volatile("" ::: "memory"); }
        if (!pass) { mxc = __builtin_fmaxf(mxc, __shfl_xor(mxc, 32)); if (half == 0) __hip_atomic_fetch_max(cml + n, __builtin_bit_cast(unsigned, mxc), __ATOMIC_RELAXED, __HIP_MEMORY_SCOPE_WORKGROUP); __syncthreads(); }
    }
    if (F.tid < 32) cm[n0 + F.tid] = __builtin_bit_cast(float, cml[F.tid]);
    __syncthreads();
}
template <int DROP> DI void norm_rows8(Frame& F, const float* x, unsigned char* xq, float* sA, bf16* xb) {
    const int gw = F.vcu * NWAVES + F.wave, NGW = F.G * NWAVES;
    for (int m = gw; m < M; m += NGW) {
        const GAS f32x4* xr = (const GAS f32x4*)(x + (size_t)m * DM) + 4 * F.lane;
        f32x4 v[16]; float s = 0.f, mx = 0.f;
#pragma unroll
        for (int j = 0; j < 4; ++j)
#pragma unroll
            for (int i = 0; i < 4; ++i) { const f32x4 t = xr[256 * j + i]; v[4 * j + i] = t; s += (t.x * t.x + t.y * t.y) + (t.z * t.z + t.w * t.w);
                mx = __builtin_fmaxf(mx, __builtin_fmaxf(__builtin_fmaxf(__builtin_fabsf(t.x), __builtin_fabsf(t.y)), __builtin_fmaxf(__builtin_fabsf(t.z), __builtin_fabsf(t.w)))); }
        const float r = 1.0f / sqrtf(wave_sum(s) * (1.0f / DM) + RMS_EPS);
#pragma unroll
        for (int o = 1; o < 64; o <<= 1) mx = __builtin_fmaxf(mx, __shfl_xor(mx, o));
        const float inv = mx > 0.f ? 127.0f / mx : 0.f;
#pragma unroll
        for (int j = 0; j < 4; ++j) { v4u w;
#pragma unroll
            for (int i = 0; i < 4; ++i) { const f32x4 t = v[4 * j + i]; w[i] = q8x4(t.x, t.y, t.z, t.w, inv); }
            *(GAS v4u*)(xq + (size_t)m * DM + 1024 * j + 16 * F.lane) = w;
            if (xb) {
#pragma unroll
                for (int h = 0; h < 2; ++h) { const f32x4 a = v[4 * j + 2 * h] * r, b = v[4 * j + 2 * h + 1] * r; v4u y;
                    if (DROP > 0) { y.x = f2bf_drop<DROP>(a.x) | (f2bf_drop<DROP>(a.y) << 16); y.y = f2bf_drop<DROP>(a.z) | (f2bf_drop<DROP>(a.w) << 16); y.z = f2bf_drop<DROP>(b.x) | (f2bf_drop<DROP>(b.y) << 16); y.w = f2bf_drop<DROP>(b.z) | (f2bf_drop<DROP>(b.w) << 16); }
                    else { y.x = pk2(a.x, a.y); y.y = pk2(a.z, a.w); y.z = pk2(b.x, b.y); y.w = pk2(b.z, b.w); }
                    *(GAS v4u*)(xb + (size_t)m * DM + 1024 * j + 16 * F.lane + 8 * h) = y; } } }
        if (F.lane == 0) sA[m] = mx * r * (1.0f / 127.0f);
    }
}
DI void quant_rows_bf16(Frame& F, const bf16* o, unsigned char* oq, float* sO) {
    const int gw = F.vcu * NWAVES + F.wave, NGW = F.G * NWAVES;
    for (int m = gw; m < M; m += NGW) {
        const GAS v4u* orow = (const GAS v4u*)(o + (size_t)m * DM) + 2 * F.lane;
        v4u v[8]; float mx = 0.f;
#pragma unroll
        for (int j = 0; j < 4; ++j)
#pragma unroll
            for (int h = 0; h < 2; ++h) { const v4u t = orow[128 * j + h]; v[2 * j + h] = t;
#pragma unroll
                for (int c = 0; c < 4; ++c) mx = __builtin_fmaxf(mx, __builtin_fmaxf(__builtin_fabsf(bf2f(t[c] & 0xffffu)), __builtin_fabsf(bf2f(t[c] >> 16)))); }
#pragma unroll
        for (int s = 1; s < 64; s <<= 1) mx = __builtin_fmaxf(mx, __shfl_xor(mx, s));
        const float inv = mx > 0.f ? 127.0f / mx : 0.f;
#pragma unroll
        for (int j = 0; j < 4; ++j) { v4u w;
#pragma unroll
            for (int h = 0; h < 2; ++h) { const v4u t = v[2 * j + h];
                w[2 * h] = q8x4(bf2f(t[0] & 0xffffu), bf2f(t[0] >> 16), bf2f(t[1] & 0xffffu), bf2f(t[1] >> 16), inv);
                w[2 * h + 1] = q8x4(bf2f(t[2] & 0xffffu), bf2f(t[2] >> 16), bf2f(t[3] & 0xffffu), bf2f(t[3] >> 16), inv); }
            *(GAS v4u*)(oq + (size_t)m * DM + 1024 * j + 16 * F.lane) = w; }
        if (F.lane == 0) sO[m] = mx * (1.0f / 127.0f);
    }
}
DI void norm_rows8_b(Frame& F, const bf16* x, unsigned char* xq, float* sA) {
    const int gw = F.vcu * NWAVES + F.wave, NGW = F.G * NWAVES;
    for (int m = gw; m < M; m += NGW) {
        const GAS v4u* xr = (const GAS v4u*)(x + (size_t)m * DM) + 2 * F.lane;
        v4u t[8]; float s = 0.f, mx = 0.f;
#pragma unroll
        for (int j = 0; j < 4; ++j) { t[2 * j] = xr[128 * j]; t[2 * j + 1] = xr[128 * j + 1]; }
#pragma unroll
        for (int j = 0; j < 8; ++j)
#pragma unroll
            for (int i = 0; i < 4; ++i) { const float a = __builtin_bit_cast(float, t[j][i] << 16), b = __builtin_bit_cast(float, t[j][i] & 0xffff0000u); s += a * a + b * b; mx = __builtin_fmaxf(mx, __builtin_fmaxf(__builtin_fabsf(a), __builtin_fabsf(b))); }
        const float r = 1.0f / sqrtf(wave_sum(s) * (1.0f / DM) + RMS_EPS);
#pragma unroll
        for (int o = 1; o < 64; o <<= 1) mx = __builtin_fmaxf(mx, __shfl_xor(mx, o));
        const float inv = mx > 0.f ? 127.0f / mx : 0.f;
#pragma unroll
        for (int j = 0; j < 4; ++j) { v4u w;
#pragma unroll
            for (int i = 0; i < 4; ++i) { const unsigned w0 = t[2 * j + (i >> 1)][2 * (i & 1)], w1 = t[2 * j + (i >> 1)][2 * (i & 1) + 1];
                w[i] = q8x4(__builtin_bit_cast(float, w0 << 16), __builtin_bit_cast(float, w0 & 0xffff0000u), __builtin_bit_cast(float, w1 << 16), __builtin_bit_cast(float, w1 & 0xffff0000u), inv); }
            *(GAS v4u*)(xq + (size_t)m * DM + 1024 * j + 16 * F.lane) = w; }
        if (F.lane == 0) sA[m] = mx * r * (1.0f / 127.0f);
    }
}
DI void final_norm_rows_b(Frame& F, const bf16* x, float* out, const float* gain, bool poison) {
    const int gw = F.vcu * NWAVES + F.wave, NGW = F.G * NWAVES;
    for (int m = gw; m < M; m += NGW) {
        const GAS v4u* xr = (const GAS v4u*)(x + (size_t)m * DM) + F.lane; GAS f32x4* orow = (GAS f32x4*)(out + (size_t)m * DM) + 2 * F.lane; const GAS f32x4* gr = (const GAS f32x4*)gain + 2 * F.lane;
        v4u t[8]; float s = 0.f;
#pragma unroll
        for (int j = 0; j < 8; ++j) t[j] = xr[64 * j];
#pragma unroll
        for (int j = 0; j < 8; ++j)
#pragma unroll
            for (int i = 0; i < 4; ++i) { const float a = __builtin_bit_cast(float, t[j][i] << 16), b = __builtin_bit_cast(float, t[j][i] & 0xffff0000u); s += a * a + b * b; }
        float r = 1.0f / sqrtf(wave_sum(s) * (1.0f / DM) + RMS_EPS); if (poison) r = __builtin_nanf("");
#pragma unroll
        for (int j = 0; j < 8; ++j) { f32x4 a, b;
            a.x = __builtin_bit_cast(float, t[j].x << 16); a.y = __builtin_bit_cast(float, t[j].x & 0xffff0000u); a.z = __builtin_bit_cast(float, t[j].y << 16); a.w = __builtin_bit_cast(float, t[j].y & 0xffff0000u);
            b.x = __builtin_bit_cast(float, t[j].z << 16); b.y = __builtin_bit_cast(float, t[j].z & 0xffff0000u); b.z = __builtin_bit_cast(float, t[j].w << 16); b.w = __builtin_bit_cast(float, t[j].w & 0xffff0000u);
            orow[128 * j] = a * r * gr[128 * j]; orow[128 * j + 1] = b * r * gr[128 * j + 1]; }
    }
}
DI void final_norm_rows(Frame& F, float* x, const float* gain, bool poison) {
    const int gw = F.vcu * NWAVES + F.wave, NGW = F.G * NWAVES;
    for (int m = gw; m < M; m += NGW) {
        GAS f32x4* xr = (GAS f32x4*)(x + (size_t)m * DM) + F.lane; const GAS f32x4* gr = (const GAS f32x4*)gain + F.lane;
        f32x4 v[16]; float s = 0.f;
#pragma unroll
        for (int j = 0; j < 16; ++j) { v[j] = xr[64 * j]; s += (v[j].x * v[j].x + v[j].y * v[j].y) + (v[j].z * v[j].z + v[j].w * v[j].w); }
        float r = 1.0f / sqrtf(wave_sum(s) * (1.0f / DM) + RMS_EPS); if (poison) r = __builtin_nanf("");
#pragma unroll
        for (int j = 0; j < 16; ++j) xr[64 * j] = v[j] * r * gr[64 * j];
    }
}
DI void kmean_phase(Frame& F) {
    const bf16* Kb = (const bf16*)(F.ws + WS_K); bf16* kh = (bf16*)(F.ws + WS_KMEAN); bf16* kl = kh + 8 * 64 * 128;
    LAS float* red = (LAS float*)(F.lds + RING_OFF);
    const int c = F.tid & 15, rg = F.tid >> 4;
    for (int it = F.vcu; it < 8 * NBLK; it += F.G) {
        const int kvh = it >> 6, n = it & 63; float a[8];
#pragma unroll
        for (int e = 0; e < 8; ++e) a[e] = 0.f;
#pragma unroll
        for (int r = 0; r < 8; ++r) { const v4u w = *(const GAS v4u*)(Kb + (size_t)(n * 256 + rg + 32 * r) * A_KVW + kvh * 128 + c * 8);
            a[0] += bf2f(w.x & 0xffffu); a[1] += bf2f(w.x >> 16); a[2] += bf2f(w.y & 0xffffu); a[3] += bf2f(w.y >> 16); a[4] += bf2f(w.z & 0xffffu); a[5] += bf2f(w.z >> 16); a[6] += bf2f(w.w & 0xffffu); a[7] += bf2f(w.w >> 16); }
#pragma unroll
        for (int e = 0; e < 8; ++e) red[rg * 128 + c * 8 + e] = a[e];
        __syncthreads();
        if (F.tid < 128) { float s = 0.f;
#pragma unroll 8
            for (int g = 0; g < 32; ++g) s += red[g * 128 + F.tid];
            s *= (1.0f / 256.0f); const unsigned h = f2bf(s); const float l = s - bf2f(h);
            kh[(size_t)it * 128 + F.tid] = (bf16)h; kl[(size_t)it * 128 + F.tid] = (bf16)f2bf(l); }
        __syncthreads();
    }
}
namespace att {
template <int D> struct TL { static constexpr int PITCH = D * 2 + 16, BYTES = 64 * PITCH, NCH = D / 8, NLD = (64 * NCH) / 512; };
DI int crow(int reg, int h) { return (reg & 3) + 8 * (reg >> 2) + 4 * h; }
typedef float f32x2_t __attribute__((ext_vector_type(2))); typedef __bf16 bf16x2_t __attribute__((ext_vector_type(2)));
DI unsigned cvtpk(float lo, float hi) { f32x2_t v = {lo, hi}; bf16x2_t b = __builtin_convertvector(v, bf16x2_t); return __builtin_bit_cast(unsigned, b); }
typedef short v4i16_t __attribute__((ext_vector_type(4)));
DI s16x4 vtr(const LAS unsigned char* p) { return __builtin_bit_cast(s16x4, __builtin_amdgcn_ds_read_tr16_b64_v4i16((LAS v4i16_t*)p)); }
#define MFMA32(a, b, c) __builtin_amdgcn_mfma_f32_32x32x16_bf16((a), (b), (c), 0, 0, 0)

template <int D, int NL = TL<D>::NLD> DI void tile_load(v4u (&r)[NL], const bf16* g, int pitch, int tid) {
#pragma unroll
    for (int i = 0; i < NL; ++i) { const int c = tid + 512 * i, row = c / TL<D>::NCH, ch = c % TL<D>::NCH; r[i] = *(const GAS v4u*)(g + (size_t)row * pitch + ch * 8); }
}
template <int D, int NL = TL<D>::NLD> DI void tile_store(LAS unsigned char* t, const v4u (&r)[NL], int tid) {
#pragma unroll
    for (int i = 0; i < NL; ++i) { const int c = tid + 512 * i, row = c / TL<D>::NCH, ch = c % TL<D>::NCH; *(LAS v4u*)(t + row * TL<D>::PITCH + ch * 16) = r[i]; }
}
template <int D, bool INIT = true> DI void qk(f32x16& p0, f32x16& p1, const LAS unsigned char* kt, const bf16x8 (&qf)[D / 16], int r32, int hi) {
    const LAS unsigned char* a = kt + r32 * TL<D>::PITCH + hi * 16;
    if (INIT) {
#pragma unroll
        for (int i = 0; i < 16; ++i) { p0[i] = 0.f; p1[i] = 0.f; } }
#pragma unroll
    for (int s = 0; s < D / 16; ++s) { const bf16x8 a0 = *(const LAS bf16x8*)(a + s * 32), a1 = *(const LAS bf16x8*)(a + 32 * TL<D>::PITCH + s * 32);
        p0 = MFMA32(a0, qf[s], p0); p1 = MFMA32(a1, qf[s], p1); if ((s & 3) == 3) __builtin_amdgcn_sched_barrier(0); }
}
DI bf16x8 pack8(const f32x16& x, int s) {
    v4u p; p.x = cvtpk(x[8 * s], x[8 * s + 1]); p.y = cvtpk(x[8 * s + 2], x[8 * s + 3]); p.z = cvtpk(x[8 * s + 4], x[8 * s + 5]); p.w = cvtpk(x[8 * s + 6], x[8 * s + 7]);
    return __builtin_bit_cast(bf16x8, p);
}
template <int D> DI void pv(f32x16 (&o)[D / 32], const LAS unsigned char* vt, const f32x16& p0, const f32x16& p1, int lane, int hi) {
    bf16x8 pf[4]; pf[0] = pack8(p0, 0); pf[1] = pack8(p0, 1); pf[2] = pack8(p1, 0); pf[3] = pack8(p1, 1);
    const LAS unsigned char* vb = vt + (4 * hi + ((lane & 15) >> 2)) * TL<D>::PITCH + ((lane >> 4) & 1) * 32 + (lane & 3) * 8;
#pragma unroll
    for (int db = 0; db < D / 32; ++db)
#pragma unroll
        for (int ks = 0; ks < 4; ++ks) { const s16x4 lo = vtr(vb + (16 * ks) * TL<D>::PITCH + db * 64), hh = vtr(vb + (16 * ks + 8) * TL<D>::PITCH + db * 64);
            const bf16x8 va = (bf16x8){lo[0], lo[1], lo[2], lo[3], hh[0], hh[1], hh[2], hh[3]};
            o[db] = MFMA32(va, pf[ks], o[db]); if (ks == 3) __builtin_amdgcn_sched_barrier(0); }
}
template <int D> DI void softmax_update(f32x16& p0, f32x16& p1, float& m, float& l, f32x16 (&o)[D / 32]) {
    float mx = __builtin_fmaxf(p0[0], p1[0]);
#pragma unroll
    for (int i = 1; i < 16; ++i) mx = __builtin_fmaxf(mx, __builtin_fmaxf(p0[i], p1[i]));
    mx = __builtin_fmaxf(mx, __shfl_xor(mx, 32));
    const float mn = __builtin_fmaxf(m, mx), al = __builtin_amdgcn_exp2f(m - mn);
    float s = 0.f;
#pragma unroll
    for (int i = 0; i < 16; ++i) { p0[i] = __builtin_amdgcn_exp2f(p0[i] - mn); p1[i] = __builtin_amdgcn_exp2f(p1[i] - mn); s += p0[i] + p1[i]; }
    l = l * al + s; m = mn;
#pragma unroll
    for (int db = 0; db < D / 32; ++db)
#pragma unroll
        for (int i = 0; i < 16; ++i) o[db][i] *= al;
}
template <int D> DI void store_rows16(bf16* orow, const f32x16 (&o)[D / 32], float inv, int hi, bool valid) {
#pragma unroll
    for (int db = 0; db < D / 32; ++db)
#pragma unroll
        for (int gp = 0; gp < 2; ++gp) { const int ge = 8 * gp, go = 8 * gp + 4;
            const unsigned ex = cvtpk(o[db][ge] * inv, o[db][ge + 1] * inv), ey = cvtpk(o[db][ge + 2] * inv, o[db][ge + 3] * inv);
            const unsigned ox = cvtpk(o[db][go] * inv, o[db][go + 1] * inv), oy = cvtpk(o[db][go + 2] * inv, o[db][go + 3] * inv);
            const auto sx = __builtin_amdgcn_permlane32_swap(ex, ox, false, false), sy = __builtin_amdgcn_permlane32_swap(ey, oy, false, false);
            v4u w; w.x = sx[0]; w.y = sy[0]; w.z = sx[1]; w.w = sy[1];
            if (valid) *(GAS v4u*)(orow + db * 32 + 16 * gp + 8 * hi) = w; }
}
template <int D> DI void store_o(bf16* orow  , const f32x16 (&o)[D / 32], float l, int hi) {
    const float L = l + __shfl_xor(l, 32), inv = 1.0f / L;
    store_rows16<D>(orow, o, inv, hi, true);
}

constexpr int MOBA_HIST_OFF = 36864, MOBA_SCAN_OFF = 40960;
DI size_t moba_list_off(int kvh, int n) { return (size_t)kvh * 2064384 + (size_t)1024 * (63 * n - (n * (n - 1)) / 2); }
template <int D> DI void store_part(bf16* po  , float* pml, const f32x16 (&o)[D / 32], float m, float l, int hi, bool valid) {
    const float L = l + __shfl_xor(l, 32), inv = 1.0f / L;
    store_rows16<D>(po, o, inv, hi, valid);
    if (valid && hi == 0) { pml[0] = m; pml[1] = L; }
}
DI void moba_own_item(Frame& F, int b, int h) {
    constexpr int D = 128; typedef TL<D> T;
    LAS unsigned char* kt = F.lds + RING_OFF; LAS unsigned char* vt = kt + T::BYTES;
    LAS unsigned* hist = (LAS unsigned*)(F.lds + RING_OFF + MOBA_HIST_OFF); LAS unsigned* bases = hist + 64;
    const int lane = F.lane, r32 = lane & 31, hi = lane >> 5, w = F.wave, kvh = h >> 2, tid = F.tid;
    const bf16* Kb = (const bf16*)(F.ws + WS_K) + kvh * 128; const bf16* Vb = (const bf16*)(F.ws + WS_V) + kvh * 128;
    const bf16* kmh = (const bf16*)(F.ws + WS_KMEAN) + (size_t)kvh * 64 * 128; const bf16* kml = kmh + 8 * 64 * 128;
    const int tok = b * 256 + w * 32 + r32, pair = tok * 32 + h;
    const bf16* qrow = (const bf16*)(F.ws + WS_Q) + (size_t)tok * DM + h * 128;
    bf16x8 qf[8];
#pragma unroll
    for (int s = 0; s < 8; ++s) qf[s] = *(const GAS bf16x8*)(qrow + 16 * s + 8 * hi);
    v4u rk[T::NLD], rv[T::NLD];
    const float NEG = -__builtin_inff();
    if (b > 0) {
        tile_load<D>(rk, kmh, 128, tid); tile_load<D>(rv, kml, 128, tid);
        if (tid < 64) hist[tid] = 0u;
        __syncthreads(); tile_store<D>(kt, rk, tid); tile_store<D>(vt, rv, tid); __syncthreads();
        int nsel[3]; unsigned rnk[3];
        { f32x16 g0, g1; qk<D>(g0, g1, vt, qf, r32, hi); __builtin_amdgcn_sched_barrier(0); qk<D, false>(g0, g1, kt, qf, r32, hi);
#pragma unroll
          for (int i = 0; i < 16; ++i) { const int n0 = crow(i, hi); g0[i] = (n0 < b) ? g0[i] : NEG; g1[i] = (n0 + 32 < b) ? g1[i] : NEG; }
#pragma unroll
          for (int j = 0; j < 3; ++j) { float bv = NEG; int bi = 64;
#pragma unroll
              for (int i = 0; i < 16; ++i) { const int n0 = crow(i, hi); if (g0[i] > bv) { bv = g0[i]; bi = n0; } }
#pragma unroll
              for (int i = 0; i < 16; ++i) { const int n1 = 32 + crow(i, hi); if (g1[i] > bv) { bv = g1[i]; bi = n1; } }
              const float ov = __shfl_xor(bv, 32); const int oi = __shfl_xor(bi, 32);
              if (ov > bv || (ov == bv && oi < bi)) { bv = ov; bi = oi; }
              nsel[j] = (bv > NEG) ? bi : -1;
#pragma unroll
              for (int i = 0; i < 16; ++i) { const int n0 = crow(i, hi); g0[i] = (n0 == bi) ? NEG : g0[i]; g1[i] = (n0 + 32 == bi) ? NEG : g1[i]; } } }
#pragma unroll
        for (int j = 0; j < 3; ++j) { rnk[j] = 0u; if (hi == 0 && nsel[j] >= 0) rnk[j] = __hip_atomic_fetch_add(hist + nsel[j], 1u, __ATOMIC_RELAXED, __HIP_MEMORY_SCOPE_WORKGROUP); }
        __syncthreads();
        if (tid < 64) { const unsigned hc = hist[tid]; unsigned bs = 0u; if (hc) bs = __hip_atomic_fetch_add((unsigned*)(F.ctl + CW_CNT) + kvh * 64 + tid, hc, RLX_AGENT); bases[tid] = bs; }
        __syncthreads();
        unsigned* lst = (unsigned*)(F.ws + WS_LIST);
#pragma unroll
        for (int j = 0; j < 3; ++j) if (hi == 0 && nsel[j] >= 0) lst[moba_list_off(kvh, nsel[j]) + bases[nsel[j]] + rnk[j]] = ((unsigned)pair << 2) | (unsigned)j;
    }
    float m = -1e30f, l = 0.f; f32x16 o[4];
#pragma unroll
    for (int db = 0; db < 4; ++db)
#pragma unroll
        for (int i = 0; i < 16; ++i) o[db][i] = 0.f;
    tile_load<D>(rk, Kb + (size_t)(b * 256) * A_KVW, A_KVW, tid); tile_load<D>(rv, Vb + (size_t)(b * 256) * A_KVW, A_KVW, tid);
    for (int tt = 0; tt < 4; ++tt) {
        __syncthreads();
        tile_store<D>(kt, rk, tid); tile_store<D>(vt, rv, tid);
        __syncthreads();
        if (tt + 1 < 4) { const size_t r0 = (size_t)b * 256 + (tt + 1) * 64; tile_load<D>(rk, Kb + r0 * A_KVW, A_KVW, tid); tile_load<D>(rv, Vb + r0 * A_KVW, A_KVW, tid); }
        if (tt * 64 <= w * 32 + 31) {
            f32x16 p0, p1; qk<D>(p0, p1, kt, qf, r32, hi);
            const int qrel = w * 32 + r32, kb = tt * 64 + 4 * hi;
#pragma unroll
            for (int i = 0; i < 16; ++i) { const int kv = kb + (i & 3) + 8 * (i >> 2); p0[i] = (kv > qrel) ? NEG : p0[i]; p1[i] = (kv + 32 > qrel) ? NEG : p1[i]; }
            softmax_update<D>(p0, p1, m, l, o);
            pv<D>(o, vt, p0, p1, lane, hi);
        }
    }
    store_part<D>((bf16*)(F.ws + WS_PARTO) + ((size_t)pair * 4 + 3) * 128, (float*)(F.ws + WS_PARTML) + ((size_t)pair * 4 + 3) * 2, o, m, l, hi, true);
    __syncthreads();
}
DI void moba_own_phase(Frame& F) {
#pragma unroll 1
    for (int p2 = 2 * F.vcu; p2 < 2 * 32 * A_H; p2 += (p2 & 1) ? 2 * F.G - 1 : 1) { const int p = p2 >> 1, h = p >> 5, bp = p & 31; moba_own_item(F, (p2 & 1) ? bp : 63 - bp, h); }
}
DI void moba_past_phase(Frame& F) {
    constexpr int D = 128; typedef TL<D> T; constexpr int IMG = 256 * T::PITCH;
    LAS unsigned char* kt = F.lds + RING_OFF; LAS unsigned char* vt = kt + IMG;
    LAS int* sc = (LAS int*)(F.lds + RING_OFF + 2 * IMG); LAS int* pc = sc + 512;
    static_assert(2 * IMG + 4096 <= LDSCTL_OFF, "MoBA past phase LDS map");
    const int lane = F.lane, r32 = lane & 31, hi = lane >> 5, w = F.wave, tid = F.tid;
    { int cv = 0; if (tid < 504) cv = (int)__hip_atomic_load((unsigned*)(F.ctl + CW_CNT) + (tid / 63) * 64 + (tid % 63), RLX_AGENT);
      pc[tid] = cv; sc[tid] = (cv + 255) >> 8; __syncthreads();
      for (int off = 1; off < 512; off <<= 1) { const int x = sc[tid] + (tid >= off ? sc[tid - off] : 0); __syncthreads(); sc[tid] = x; __syncthreads(); } }
    const int total = sc[511];
    const unsigned* lst = (const unsigned*)(F.ws + WS_LIST); const bf16* Qg = (const bf16*)(F.ws + WS_Q);
    const int i_lo = (int)(((long)total * F.vcu) / F.G), i_hi = (int)(((long)total * (F.vcu + 1)) / F.G);
#define MOBA_QLOAD(QF, E) do { const int pr_ = (int)((E) >> 2); const bf16* qrow_ = Qg + (size_t)(pr_ >> 5) * DM + (pr_ & 31) * 128; \
        _Pragma("unroll") for (int s_ = 0; s_ < 8; ++s_) QF[s_] = *(const GAS bf16x8*)(qrow_ + 16 * s_ + 8 * hi); } while (0)
    int t = 0;
    if (i_lo < i_hi) { int lo_ = 0, hi_ = 511; while (lo_ < hi_) { const int mid_ = (lo_ + hi_) >> 1; if (sc[mid_] > i_lo) hi_ = mid_; else lo_ = mid_ + 1; } t = __builtin_amdgcn_readfirstlane(lo_); }
    int t_img = -1; bf16x8 qf[8]; unsigned e = 0u; bool valid = false;
#pragma unroll 1
    for (int idx = i_lo; idx < i_hi; ++idx) {
        while (sc[t] <= idx) ++t;
        t = __builtin_amdgcn_readfirstlane(t);
        const int cnt = pc[t], c = idx - (sc[t] - ((cnt + 255) >> 8)), kvh = t / 63, n = t % 63;
        const size_t lbase = moba_list_off(kvh, n);
        if (t != t_img) {
            const bf16* Kb = (const bf16*)(F.ws + WS_K) + kvh * 128 + (size_t)(n * 256) * A_KVW; const bf16* Vb = (const bf16*)(F.ws + WS_V) + kvh * 128 + (size_t)(n * 256) * A_KVW;
            __syncthreads();
            { v4u r8[8]; tile_load<D, 8>(r8, Kb, A_KVW, tid); tile_store<D, 8>(kt, r8, tid); }
            { v4u r8[8]; tile_load<D, 8>(r8, Vb, A_KVW, tid); tile_store<D, 8>(vt, r8, tid); }
            __syncthreads();
            t_img = t;
            const int ir0 = c * 256 + w * 32 + r32; valid = ir0 < cnt; e = lst[lbase + (valid ? ir0 : 0)]; MOBA_QLOAD(qf, e);
        }
        const bool nxt_same = (idx + 1 < i_hi) && (sc[t] > idx + 1);
        unsigned e2 = 0u; bool valid2 = false;
        if (nxt_same) { const int ir2 = (c + 1) * 256 + w * 32 + r32; valid2 = ir2 < cnt; e2 = lst[lbase + (valid2 ? ir2 : 0)]; }
        const bool wact = __any(valid ? 1 : 0) != 0;
        float m = -1e30f, l = 0.f; f32x16 o[4];
#pragma unroll
        for (int db = 0; db < 4; ++db)
#pragma unroll
            for (int i = 0; i < 16; ++i) o[db][i] = 0.f;
        const int pair = (int)(e >> 2), j = (int)(e & 3u);
#pragma unroll 1
        for (int ss = 0; ss < 4; ++ss) {
            f32x16 p0, p1;
            if (wact) qk<D>(p0, p1, kt + ss * 64 * T::PITCH, qf, r32, hi);
            if (ss == 3 && nxt_same) { __builtin_amdgcn_sched_barrier(0); MOBA_QLOAD(qf, e2); }
            if (wact) { softmax_update<D>(p0, p1, m, l, o); pv<D>(o, vt + ss * 64 * T::PITCH, p0, p1, lane, hi); }
        }
        store_part<D>((bf16*)(F.ws + WS_PARTO) + ((size_t)pair * 4 + j) * 128, (float*)(F.ws + WS_PARTML) + ((size_t)pair * 4 + j) * 2, o, m, l, hi, valid);
        e = e2; valid = valid2;
    }
    __syncthreads();
#undef MOBA_QLOAD
}
DI void moba_combine_phase(Frame& F) {
    const int gw = F.vcu * NWAVES + F.wave, NGW = F.G * NWAVES, sub = F.lane >> 4, ch = F.lane & 15;
    const bf16* po = (const bf16*)(F.ws + WS_PARTO); const float* pml = (const float*)(F.ws + WS_PARTML); bf16* ob = (bf16*)(F.ws + WS_O);
#pragma unroll 1
    for (int it = gw; it < (M * A_H) / 4; it += NGW) {
        const int pair = it * 4 + sub, tok = pair >> 5, h = pair & 31, b = tok >> 8, nv = b < 3 ? b : 3;
        const f32x4 ml01 = *(const GAS f32x4*)(pml + (size_t)pair * 8), ml23 = *(const GAS f32x4*)(pml + (size_t)pair * 8 + 4);
        float mm[4] = {ml01.x, ml01.z, ml23.x, ml23.z}, ll[4] = {ml01.y, ml01.w, ml23.y, ml23.w};
        float mx = mm[3];
#pragma unroll
        for (int s = 0; s < 3; ++s) if (s < nv) mx = __builtin_fmaxf(mx, mm[s]);
        float wgt[4], wsum = 0.f;
#pragma unroll
        for (int s = 0; s < 4; ++s) { const bool ok = (s == 3) || (s < nv); wgt[s] = ok ? __builtin_amdgcn_exp2f(mm[s] - mx) * ll[s] : 0.f; wsum += wgt[s]; }
        const float inv = 1.0f / wsum; float acc[8];
#pragma unroll
        for (int e = 0; e < 8; ++e) acc[e] = 0.f;
#pragma unroll
        for (int s = 0; s < 4; ++s) { const bool ok = (s == 3) || (s < nv);
            if (ok) { const v4u v = *(const GAS v4u*)(po + ((size_t)pair * 4 + s) * 128 + ch * 8); const float ws_ = wgt[s] * inv;
                acc[0] += ws_ * bf2f(v.x & 0xffffu); acc[1] += ws_ * bf2f(v.x >> 16); acc[2] += ws_ * bf2f(v.y & 0xffffu); acc[3] += ws_ * bf2f(v.y >> 16);
                acc[4] += ws_ * bf2f(v.z & 0xffffu); acc[5] += ws_ * bf2f(v.z >> 16); acc[6] += ws_ * bf2f(v.w & 0xffffu); acc[7] += ws_ * bf2f(v.w >> 16); } }
        v4u o; o.x = cvtpk(acc[0], acc[1]); o.y = cvtpk(acc[2], acc[3]); o.z = cvtpk(acc[4], acc[5]); o.w = cvtpk(acc[6], acc[7]);
        *(GAS v4u*)(ob + (size_t)tok * DM + h * 128 + ch * 8) = o;
    }
}

DI void moba_combine_quant_phase(Frame& F, unsigned char* oq, float* sO) {
    const int gw = F.vcu * NWAVES + F.wave, NGW = F.G * NWAVES, sub = F.lane >> 4, ch = F.lane & 15;
    const bf16* po = (const bf16*)(F.ws + WS_PARTO); const float* pml = (const float*)(F.ws + WS_PARTML);
#pragma unroll 1
    for (int tok = gw; tok < M; tok += NGW) {
        const int b = tok >> 8, nv = b < 3 ? b : 3; float acc[8][8]; float amx = 0.f;
#pragma unroll
        for (int j = 0; j < 8; ++j) {
            const int pair = tok * 32 + 4 * j + sub;
            const f32x4 ml01 = *(const GAS f32x4*)(pml + (size_t)pair * 8), ml23 = *(const GAS f32x4*)(pml + (size_t)pair * 8 + 4);
            float mm[4] = {ml01.x, ml01.z, ml23.x, ml23.z}, ll[4] = {ml01.y, ml01.w, ml23.y, ml23.w};
            float mx = mm[3];
#pragma unroll
            for (int s = 0; s < 3; ++s) if (s < nv) mx = __builtin_fmaxf(mx, mm[s]);
            float wgt[4], wsum = 0.f;
#pragma unroll
            for (int s = 0; s < 4; ++s) { const bool ok = (s == 3) || (s < nv); wgt[s] = ok ? __builtin_amdgcn_exp2f(mm[s] - mx) * ll[s] : 0.f; wsum += wgt[s]; }
            const float inv = 1.0f / wsum;
#pragma unroll
            for (int e = 0; e < 8; ++e) acc[j][e] = 0.f;
#pragma unroll
            for (int s = 0; s < 4; ++s) { const bool ok = (s == 3) || (s < nv);
                if (ok) { const v4u v = *(const GAS v4u*)(po + ((size_t)pair * 4 + s) * 128 + ch * 8); const float ws_ = wgt[s] * inv;
                    acc[j][0] += ws_ * bf2f(v.x & 0xffffu); acc[j][1] += ws_ * bf2f(v.x >> 16); acc[j][2] += ws_ * bf2f(v.y & 0xffffu); acc[j][3] += ws_ * bf2f(v.y >> 16);
                    acc[j][4] += ws_ * bf2f(v.z & 0xffffu); acc[j][5] += ws_ * bf2f(v.z >> 16); acc[j][6] += ws_ * bf2f(v.w & 0xffffu); acc[j][7] += ws_ * bf2f(v.w >> 16); } }
#pragma unroll
            for (int e = 0; e < 8; ++e) amx = __builtin_fmaxf(amx, __builtin_fabsf(acc[j][e]));
        }
#pragma unroll
        for (int s = 1; s < 64; s <<= 1) amx = __builtin_fmaxf(amx, __shfl_xor(amx, s));
        const float qi = amx > 0.f ? 127.0f / amx : 0.f;
#pragma unroll
        for (int j = 0; j < 8; ++j) { v2u w; w.x = q8x4(acc[j][0], acc[j][1], acc[j][2], acc[j][3], qi); w.y = q8x4(acc[j][4], acc[j][5], acc[j][6], acc[j][7], qi);
            *(GAS v2u*)(oq + (size_t)tok * DM + (4 * j + sub) * 128 + ch * 8) = w; }
        if (F.lane == 0) sO[tok] = amx * (1.0f / 127.0f);
    }
}

DI void swa_item(Frame& F, int qb, int kvh) {
    constexpr int D = 64; typedef TL<D> T; constexpr int IMG = 384 * T::PITCH;
    LAS unsigned char* kt = F.lds + RING_OFF; LAS unsigned char* vt = kt + IMG;
    const int lane = F.lane, r32 = lane & 31, hi = lane >> 5, w = F.wave, tid = F.tid;
    const long base = (long)qb * 256 - 128; const int tb = (qb == 0) ? 2 : 0;
    const bf16* Kb = (const bf16*)(F.ws + WS_KSH) + kvh * 64 + base * B_KVW; const bf16* Vb = (const bf16*)(F.ws + WS_VSH) + kvh * 64 + base * B_KVW;
    const int tok = qb * 256 + w * 32 + r32;
    const bf16* qrow = (const bf16*)(F.ws + WS_Q) + (size_t)tok * DM + kvh * 8 * 64;
    bf16x8 qf[4];
#pragma unroll
    for (int s = 0; s < 4; ++s) qf[s] = *(const GAS bf16x8*)(qrow + 16 * s + 8 * hi);
    { v4u rk[6], rv[6];
#pragma unroll
      for (int i = 0; i < 6; ++i) { const int c = tid + 512 * i, row = c >> 3, ch = c & 7; if (row >= 64 * tb) { rk[i] = *(const GAS v4u*)(Kb + (size_t)row * B_KVW + ch * 8); rv[i] = *(const GAS v4u*)(Vb + (size_t)row * B_KVW + ch * 8); } }
      __syncthreads();
#pragma unroll
      for (int i = 0; i < 6; ++i) { const int c = tid + 512 * i, row = c >> 3, ch = c & 7; if (row >= 64 * tb) { *(LAS v4u*)(kt + row * T::PITCH + ch * 16) = rk[i]; *(LAS v4u*)(vt + row * T::PITCH + ch * 16) = rv[i]; } }
      __syncthreads(); }
    const float NEG = -__builtin_inff(); const int qs = 32 * w, qrel = qs + r32;
#pragma unroll 1
    for (int g = 0; g < 8; ++g) {
        const int h = kvh * 8 + g;
        bf16x8 qn[4];
        if (g < 7) {
#pragma unroll
            for (int s = 0; s < 4; ++s) qn[s] = *(const GAS bf16x8*)(qrow + (g + 1) * 64 + 16 * s + 8 * hi); }
        float m = F.b_sinks[h] * LOG2E, l = (hi == 0) ? 1.0f : 0.f; f32x16 o[2];
#pragma unroll
        for (int db = 0; db < 2; ++db)
#pragma unroll
            for (int i = 0; i < 16; ++i) o[db][i] = 0.f;
#pragma unroll 1
        for (int tt = tb; tt < 6; ++tt) {
            const int kbr = -128 + 64 * tt;
            if ((kbr <= qs + 31) && (kbr + 63 >= qs - 127)) {
                f32x16 p0, p1; qk<D>(p0, p1, kt + tt * 64 * T::PITCH, qf, r32, hi);
                const int kb = kbr + 4 * hi;
#pragma unroll
                for (int i = 0; i < 16; ++i) { const int kv = kb + (i & 3) + 8 * (i >> 2);
                    p0[i] = (kv <= qrel && qrel - kv < 128) ? p0[i] : NEG; p1[i] = (kv + 32 <= qrel && qrel - kv - 32 < 128) ? p1[i] : NEG; }
                softmax_update<D>(p0, p1, m, l, o);
                pv<D>(o, vt + tt * 64 * T::PITCH, p0, p1, lane, hi);
            }
        }
        store_o<D>((bf16*)(F.ws + WS_O) + (size_t)tok * DM + h * 64, o, l, hi);
        if (g < 7) {
#pragma unroll
            for (int s = 0; s < 4; ++s) qf[s] = qn[s]; }
    }
}
DI void swa_phase(Frame& F) {
#pragma unroll 1
    for (int p = F.vcu; p < 64 * 8; p += F.G) swa_item(F, p & 63, p >> 6);
    __syncthreads();
}
#undef MFMA32
}
struct Args { const float* in[13]; float* out; unsigned char* ws; int ph_lo, ph_hi; };
__global__ void __launch_bounds__(NWAVES * 64, 2) yoco_fwd(Args args) {
    extern __shared__ __attribute__((aligned(16))) unsigned char lds[];
    Frame F;
    F.lds = (LAS unsigned char*)lds;
    F.MISC = (volatile LAS unsigned*)(F.lds + MISC_OFF);
    F.tid = threadIdx.x; F.lane = F.tid & 63; F.wave = __builtin_amdgcn_readfirstlane(F.tid >> 6);
    F.G = gridDim.x; { const int bx = blockIdx.x; F.vcu = (F.G % 8 == 0) ? (bx % 8) * (F.G / 8) + bx / 8 : bx; }
    F.ws = args.ws; F.ctl = (gu32*)(args.ws + WS_CTL);
    F.x = args.in[0]; F.ffn_norm = args.in[1]; F.ffn_w_in = args.in[2]; F.ffn_w_out = args.in[3]; F.attn_norm = args.in[4]; F.a_w_qkv = args.in[5]; F.a_w_o = args.in[6];
    F.kv_norm = args.in[7]; F.w_kv = args.in[8]; F.b_w_q = args.in[9]; F.b_sinks = args.in[10]; F.b_w_o = args.in[11]; F.final_norm = args.in[12]; F.out = args.out;
    for (int u = F.tid; u < (LDS_BYTES - LDSCTL_OFF) / 4; u += NWAVES * 64) ((LAS unsigned*)(F.lds + LDSCTL_OFF))[u] = 0u;
    __syncthreads();
    XcdBarrier bar; bar.bar = (unsigned*)(F.ctl + CW_BAR); bar.x = 0; bar.st = nullptr;
    if (!MK_SPLIT) bar = xcd_barrier_post((unsigned*)(F.ctl + CW_BAR), F.MISC + 8);
#define GRID_BAR(seam) do { if (MK_SPLIT) { if (F.tid == 0) __hip_atomic_store(F.ctl + CW_TMO, 0xBADBA0u | (unsigned)(seam), RLX_AGENT); } else { xcd_barrier(bar); } } while (0)
    const int lo = args.ph_lo, hi = args.ph_hi;
#ifndef PH_MASK
#define PH_MASK 0xffffffffu
#endif
#define IN(k) ((((PH_MASK) >> (k)) & 1u) && lo <= (k) && (k) < hi)
#define SEAM(k) do { if (IN(k) && IN((k) + 1)) GRID_BAR(k); } while (0)
    bf16* const W_IN = (bf16*)(F.ws + WS_WIN); bf16* const W_OUT = (bf16*)(F.ws + WS_WOUT);
    bf16* const W_QKV = (bf16*)(F.ws + WS_WQKV); bf16* const W_AO = (bf16*)(F.ws + WS_WAO); bf16* const W_KV = (bf16*)(F.ws + WS_WKV); bf16* const W_BQ = (bf16*)(F.ws + WS_WBQ); bf16* const W_BO = (bf16*)(F.ws + WS_WBO);
    bf16* const XN = (bf16*)(F.ws + WS_XN); bf16* const ACT = (bf16*)(F.ws + WS_ACT); bf16* const QB = (bf16*)(F.ws + WS_Q); bf16* const KB = (bf16*)(F.ws + WS_K); bf16* const VB = (bf16*)(F.ws + WS_V);
    bf16* const OB = (bf16*)(F.ws + WS_O); bf16* const KSH = (bf16*)(F.ws + WS_KSH); bf16* const VSH = (bf16*)(F.ws + WS_VSH);
    const float* const COSA = (const float*)(F.ws + WS_ROPEA); const float* const SINA = COSA + (size_t)M * 64; const float* const COSB = (const float*)(F.ws + WS_ROPEB); const float* const SINB = COSB + (size_t)M * 32;
    unsigned char* const W8 = (unsigned char*)(F.ws + WS_WIN); unsigned char* const XN8 = (unsigned char*)(F.ws + WS_XN8); float* const SA = (float*)(F.ws + WS_SA);
    float* const COLMAX = (float*)(F.ctl + CW_COLMAX); constexpr int CM_BQ = 4 * 2 * DFF, CM_KV = CM_BQ + DM, CM_AO = CM_KV + 2 * B_KVW, CM_BO = CM_AO + DM, CM_OUT = CM_BO + DM, CM_QKV = CM_OUT + 4 * DM;
    bf16* const XRES = (bf16*)(F.ws + WS_XN);
    unsigned char* const ACT8 = (unsigned char*)(F.ws + WS_ACT8); float* const SACT = (float*)(F.ws + WS_SACT); unsigned char* const W8O = (unsigned char*)(F.ws + WS_WOUT);
    constexpr size_t E_WIN = (size_t)2 * DFF * DM, E_WOUT = (size_t)DFF * DM;

#define GEMM_PHASE_T(EPI_T, EPI_OBJ, A_, B_, N_, K_, TA_, TB_, WGM_) do { pg8::Gemm g_{(A_), (B_), M, (N_), (K_)}; pg8::StaticOrder S_; S_.init(M, (N_), F.G, (int)blockIdx.x, (WGM_)); \
        pg8::gemm_phase<EPI_T, pg8::StaticOrder, PG8_ALIGN, PG8_SP2, TA_, TB_>(F.lds + RING_OFF, g_, S_, (EPI_OBJ)); } while (0)
#ifndef XN_TILED
#define XN_TILED false
#endif
#define GEMM_PHASE_8(EPI_T, EPI_OBJ, A_, B_, N_, K_) do { pg8::Gemm g_{(const bf16*)(A_), (const bf16*)(B_), M, (N_), (K_)}; pg8::StaticOrder S_; S_.init(M, (N_), F.G, (int)blockIdx.x, 8); \
        pg8::gemm_phase<EPI_T, pg8::StaticOrder, PG8_ALIGN, PG8_SP2, false, true, true>(F.lds + RING_OFF, g_, S_, (EPI_OBJ)); } while (0)
#define GEMM_PHASE(EPI_T, EPI_OBJ, A_, B_, N_, K_) GEMM_PHASE_T(EPI_T, EPI_OBJ, A_, B_, N_, K_, false, true, 8)
#define GEMM_PHASE_X(EPI_T, EPI_OBJ, A_, B_, N_, K_) GEMM_PHASE_T(EPI_T, EPI_OBJ, A_, B_, N_, K_, XN_TILED, true, 8)
#ifndef DOWN_WGM
#define DOWN_WGM 2
#endif
#define FFN_UP(f)   do { pg8::EpiSwiGLU8 E_{ACT, DFF, SA, COLMAX + (size_t)(f) * 2 * DFF}; pg8::Gemm g_{(const bf16*)XN8, (const bf16*)(W8 + (size_t)(f) * E_WIN), M, 2 * DFF, DM}; \
        pg8::ClaimOrder S_; S_.init(M, 2 * DFF, F.G, (int)blockIdx.x, 8); S_.setup((unsigned*)(F.ctl + CW_CLAIM + 64 * (f)), F.MISC + 16); \
        pg8::gemm_phase<pg8::EpiSwiGLU8, pg8::ClaimOrder, PG8_ALIGN, PG8_SP2, false, true, true>(F.lds + RING_OFF, g_, S_, E_); } while (0)
#define FFN_DOWN(f, BASE_) do { pg8::EpiResid8 E_{(BASE_), (pg8::bf16_t*)XRES, DM, 0.5f, SACT, COLMAX + CM_OUT + (size_t)(f) * DM}; pg8::Gemm g_{(const bf16*)ACT8, (const bf16*)(W8O + (size_t)(f) * E_WOUT), M, DM, DFF}; \
        pg8::StaticOrder S_; S_.init(M, DM, F.G, (int)blockIdx.x, DOWN_WGM); pg8::gemm_phase<pg8::EpiResid8, pg8::StaticOrder, PG8_ALIGN, PG8_SP2, (ACT8_TILED != 0), true, true>(F.lds + RING_OFF, g_, S_, E_); } while (0)

    LAS float* const scr_ = (LAS float*)(F.lds + RING_OFF + F.wave * 16384);
#ifndef XN_FFN_DROP
#define XN_FFN_DROP 2
#endif
#ifndef FFN_W_DROP
#define FFN_W_DROP 2
#endif
#define TR_WXD(SRC, GAIN, DST, K_, N_, MODE_, LIM_, TL_, GW_, NGW_, DROP_) for (int it_ = (GW_); it_ < ((K_) / 64) * ((N_) / 32); it_ += (NGW_)) tr_item<TL_, DROP_>((SRC), (GAIN), (DST), (K_), (N_), (N_), (MODE_), (LIM_), scr_, it_, F.lane)
#define TR_WX(SRC, GAIN, DST, K_, N_, MODE_, LIM_, TL_, GW_, NGW_) for (int it_ = (GW_); it_ < ((K_) / 64) * ((N_) / 32); it_ += (NGW_)) tr_item<TL_>((SRC), (GAIN), (DST), (K_), (N_), (N_), (MODE_), (LIM_), scr_, it_, F.lane)
    const bool tailconv = false, tailwg = false;
    const int tw_ = ((int)blockIdx.x - 128) * NWAVES + F.wave, NTW_ = 128 * NWAVES;
    if (IN(0)) {
        {
        const int gw = F.vcu * NWAVES + F.wave, NGW = F.G * NWAVES;
#define TR_W(SRC, GAIN, DST, K_, N_, MODE_, LIM_, TL_) TR_WX(SRC, GAIN, DST, K_, N_, MODE_, LIM_, TL_, gw, NGW)
#define TR_WF(SRC, GAIN, DST, K_, N_, MODE_, LIM_, TL_) TR_WXD(SRC, GAIN, DST, K_, N_, MODE_, LIM_, TL_, gw, NGW, FFN_W_DROP)
        if (!tailconv) {
        }
#undef TR_W
#undef TR_WF
        { LAS unsigned* const cml_ = (LAS unsigned*)(F.lds + RING_BYTES); constexpr int S_IN = (2 * DFF) / 32, S_D = DM / 32, S_KV = (2 * B_KVW) / 32, S_QKV = NQKV / 32, S_TOT = 4 * S_IN + 3 * S_D + S_KV + S_QKV;
#pragma unroll 1
          for (int st_ = F.vcu; st_ < S_TOT; st_ += F.G) {
              const float* src_; const float* gn_; float* cm_; unsigned char* dst_; int n_, mode_, lim_, sl_;
              if (st_ < 4 * S_IN) { const int fw_ = st_ / S_IN; sl_ = st_ - fw_ * S_IN; src_ = F.ffn_w_in + (size_t)fw_ * E_WIN; gn_ = F.ffn_norm + (size_t)fw_ * DM; cm_ = COLMAX + (size_t)fw_ * 2 * DFF; dst_ = W8 + (size_t)fw_ * E_WIN; n_ = 2 * DFF; mode_ = 1; lim_ = 0; }
              else if (st_ < 4 * S_IN + S_D) { sl_ = st_ - 4 * S_IN; src_ = F.b_w_q; gn_ = F.attn_norm + DM; cm_ = COLMAX + CM_BQ; dst_ = (unsigned char*)W_BQ; n_ = DM; mode_ = 3; lim_ = 4096; }
              else if (st_ < 4 * S_IN + 2 * S_D) { sl_ = st_ - 4 * S_IN - S_D; src_ = F.a_w_o; gn_ = nullptr; cm_ = COLMAX + CM_AO; dst_ = (unsigned char*)W_AO; n_ = DM; mode_ = 0; lim_ = 0; }
              else if (st_ < 4 * S_IN + 3 * S_D) { sl_ = st_ - 4 * S_IN - 2 * S_D; src_ = F.b_w_o; gn_ = nullptr; cm_ = COLMAX + CM_BO; dst_ = (unsigned char*)W_BO; n_ = DM; mode_ = 0; lim_ = 0; }
              else if (st_ >= 4 * S_IN + 3 * S_D + S_KV) { sl_ = st_ - 4 * S_IN - 3 * S_D - S_KV; src_ = F.a_w_qkv; gn_ = F.attn_norm; cm_ = COLMAX + CM_QKV; dst_ = (unsigned char*)W_QKV; n_ = NQKV; mode_ = 2; lim_ = 5120; }
              else { sl_ = st_ - 4 * S_IN - 3 * S_D; src_ = F.w_kv; gn_ = F.kv_norm; cm_ = COLMAX + CM_KV; dst_ = (unsigned char*)W_KV; n_ = 2 * B_KVW; mode_ = 3; lim_ = 512; }
              strip_quant8(F, src_, gn_, cm_, dst_, DM, n_, mode_, lim_, sl_, scr_, cml_); } }
        { LAS unsigned* const cml_ = (LAS unsigned*)(F.lds + RING_BYTES);
#pragma unroll 1
          for (int st_ = F.vcu; st_ < 4 * (DM / 32); st_ += F.G) { const int fw_ = st_ / (DM / 32), sl_ = st_ - fw_ * (DM / 32);
              strip_quant8_rot(F, F.ffn_w_out + (size_t)fw_ * E_WOUT, COLMAX + CM_OUT + (size_t)fw_ * DM, W8O + (size_t)fw_ * E_WOUT, DFF, DM, sl_, scr_, cml_); } }
        rope_tables(F);
        norm_rows8<0>(F, F.x, XN8, SA, (bf16*)nullptr);
        }
    }
    if (IN(0) && IN(1)) GRID_BAR(0);
    if (IN(1)) { FFN_UP(0);
        if (tailwg) { TR_WX(F.a_w_qkv, F.attn_norm, W_QKV, DM, NQKV, 2, 5120, true, tw_, NTW_); } }
    if (IN(1) && IN(27)) GRID_BAR(1);
    if (IN(27)) act_quant_phase(F, ACT, ACT8, SACT);
    if (IN(27) && IN(2)) GRID_BAR(27);
    if (IN(2)) FFN_DOWN(0, F.x);
    SEAM(2);
    if (IN(3)) norm_rows8_b(F, XRES, XN8, SA);
    SEAM(3);
    if (IN(4)) { pg8::EpiRope8<128> E_{QB, KB, VB, DM, A_KVW, A_KVW, 16, 4, 0.08838834764831845f * LOG2E, COSA, SINA, SA, COLMAX + CM_QKV}; GEMM_PHASE_8(pg8::EpiRope8<128>, E_, XN8, W_QKV, NQKV, DM);
    }
    SEAM(4);
    if (IN(5)) kmean_phase(F);
    SEAM(5);
    if (IN(6)) att::moba_own_phase(F);
    SEAM(6);
    if (IN(22)) att::moba_past_phase(F);
    if (IN(22) && IN(23)) GRID_BAR(22);
    if (IN(23)) att::moba_combine_quant_phase(F, XN8, SA);
    if (IN(23) && IN(7)) GRID_BAR(23);
    if (IN(7)) { pg8::EpiResid8 E_{nullptr, (pg8::bf16_t*)XRES, DM, 1.0f, SA, COLMAX + CM_AO}; GEMM_PHASE_8(pg8::EpiResid8, E_, XN8, W_AO, DM, DM); }
    SEAM(7);
    if (IN(8)) norm_rows8_b(F, XRES, XN8, SA);
    SEAM(8);
    if (IN(9)) { FFN_UP(1);
        if (tailwg) { } }
    if (IN(9) && IN(28)) GRID_BAR(9);
    if (IN(28)) act_quant_phase(F, ACT, ACT8, SACT);
    if (IN(28) && IN(10)) GRID_BAR(28);
    if (IN(10)) FFN_DOWN(1, (const float*)nullptr);
    SEAM(10);
    if (IN(11)) norm_rows8_b(F, XRES, XN8, SA);
    SEAM(11);
    if (IN(12)) { { pg8::EpiRope8<64> E_{KSH, KSH, VSH, B_KVW, B_KVW, B_KVW, 0, 2, 1.0f, COSB, SINB, SA, COLMAX + CM_KV}; GEMM_PHASE_8(pg8::EpiRope8<64>, E_, XN8, W_KV, 2 * B_KVW, DM); }
                  FFN_UP(2);
                  }
    if (IN(12) && IN(29)) GRID_BAR(12);
    if (IN(29)) act_quant_phase(F, ACT, ACT8, SACT);
    if (IN(29) && IN(13)) GRID_BAR(29);
    if (IN(13)) FFN_DOWN(2, (const float*)nullptr);
    SEAM(13);
    if (IN(14)) norm_rows8_b(F, XRES, XN8, SA);
    SEAM(14);
    if (IN(15)) { pg8::EpiRope8<64> E_{QB, QB, QB, DM, DM, DM, 16, 0, 0.125f * LOG2E, COSB, SINB, SA, COLMAX + CM_BQ}; GEMM_PHASE_8(pg8::EpiRope8<64>, E_, XN8, W_BQ, DM, DM); }
    SEAM(15);
    if (IN(16)) att::swa_phase(F);
    if (IN(16) && IN(26)) GRID_BAR(16);
    if (IN(26)) quant_rows_bf16(F, OB, XN8, SA);
    if (IN(26) && IN(17)) GRID_BAR(26);
    if (IN(17)) { pg8::EpiResid8 E_{nullptr, (pg8::bf16_t*)XRES, DM, 1.0f, SA, COLMAX + CM_BO}; GEMM_PHASE_8(pg8::EpiResid8, E_, XN8, W_BO, DM, DM); }
    SEAM(17);
    if (IN(18)) norm_rows8_b(F, XRES, XN8, SA);
    SEAM(18);
    if (IN(19)) FFN_UP(3);
    if (IN(19) && IN(30)) GRID_BAR(19);
    if (IN(30)) act_quant_phase(F, ACT, ACT8, SACT);
    if (IN(30) && IN(20)) GRID_BAR(30);
    if (IN(20)) FFN_DOWN(3, (const float*)nullptr);
    SEAM(20);
    if (IN(21)) { bool poison = false; if (!MK_SPLIT) poison = __hip_atomic_load((gu32*)((unsigned*)(F.ctl + CW_BAR) + XB_TMO), RLX_AGENT) != 0u;
                  final_norm_rows_b(F, XRES, F.out, F.final_norm, poison); }
#undef IN
#undef SEAM
#undef GRID_BAR
}

extern "C" void kernel_launch(void* const* d_in, const int* in_sizes, int n_in, void* d_out, int out_size, void* d_ws, size_t ws_size, hipStream_t stream) {
    static int grid = 0;
    if (grid == 0) {
        if (n_in != 13 || in_sizes[0] != M * DM || out_size != M * DM || ws_size < WS_END) { fprintf(stderr, "kernel_launch: unexpected shapes: n_in %d, in0 %d, out %d, ws %zu (need %zu); nothing launched\n", n_in, n_in > 0 ? in_sizes[0] : -1, out_size, ws_size, (size_t)WS_END); grid = -1; return; }
        int dev = 0, cus = 0, per_cu = 0;
        if (hipGetDevice(&dev) != hipSuccess || hipDeviceGetAttribute(&cus, hipDeviceAttributeMultiprocessorCount, dev) != hipSuccess) { fprintf(stderr, "kernel_launch: device query failed\n"); grid = -1; return; }
        if (hipFuncSetAttribute((const void*)yoco_fwd, hipFuncAttributeMaxDynamicSharedMemorySize, LDS_BYTES) != hipSuccess) { fprintf(stderr, "kernel_launch: hipFuncSetAttribute failed\n"); grid = -1; return; }
        if (hipOccupancyMaxActiveBlocksPerMultiprocessor(&per_cu, (const void*)yoco_fwd, NWAVES * 64, LDS_BYTES) != hipSuccess || per_cu < 1)
            fprintf(stderr, "kernel_launch: note: occupancy query reports %d workgroups per CU\n", per_cu);
        (void)hipGetLastError();
        grid = cus;
    }
    if (grid < 0) return;
    if (hipMemsetAsync((char*)d_ws + WS_CTL, 0, CTL_ZERO_BYTES, stream) != hipSuccess) { fprintf(stderr, "kernel_launch: hipMemsetAsync failed\n"); return; }
    Args a{};
    for (int i = 0; i < 13; ++i) a.in[i] = (const float*)d_in[i];
    a.out = (float*)d_out; a.ws = (unsigned char*)d_ws;
#if MK_SPLIT
    static const int order[N_PHASES] = {0, 24, 25, 1, 27, 2, 3, 4, 5, 6, 22, 23, 7, 8, 9, 28, 10, 11, 12, 29, 13, 14, 15, 16, 26, 17, 18, 19, 30, 20, 21};
    for (int k = 0; k < N_PHASES; ++k) { a.ph_lo = order[k]; a.ph_hi = order[k] + 1; hipLaunchKernelGGL(yoco_fwd, dim3(grid), dim3(NWAVES * 64), LDS_BYTES, stream, a); }
#else
    a.ph_lo = 0; a.ph_hi = N_PHASES;
    hipLaunchKernelGGL(yoco_fwd, dim3(grid), dim3(NWAVES * 64), LDS_BYTES, stream, a);
#endif
    const hipError_t le = hipPeekAtLastError();
    if (le != hipSuccess) fprintf(stderr, "kernel_launch: launch failed: %s\n", hipGetErrorName(le));
}
```

```cpp
#include <hip/hip_runtime.h>
#include <cstdio>
#include <cstdint>
#include <cmath>
namespace pg8 {
#define PG8_LAS __attribute__((address_space(3)))
typedef unsigned short bf16_t;
typedef short bf16x8 __attribute__((ext_vector_type(8)));
typedef float f32x4 __attribute__((ext_vector_type(4)));
typedef unsigned u32x4 __attribute__((ext_vector_type(4)));
typedef unsigned u32x2 __attribute__((ext_vector_type(2)));
constexpr int BM = 256, BK = 64, HALF = 128, HTB = HALF * BK * 2  , STAGE_BYTES = 8 * HTB, NXCD = 8, WGM = 8;

__host__ __device__ __forceinline__ int lds_byte(int r, int c) { const int st = (r >> 4) * 2 + (c >> 5), rr = r & 15, cc = c & 31, ob = rr * 64 + cc * 2; return st * 1024 + (ob ^ (((ob >> 9) & 1) << 5)); }
__host__ __device__ __forceinline__ void stage_rc(int b, int& R, int& C) { const int st = b / 1024, sb = b % 1024, swz = sb ^ (((sb >> 9) & 1) << 5); R = (st >> 1) * 16 + swz / 64; C = (st & 1) * 32 + (swz % 64) / 2; }
__host__ __device__ __forceinline__ int perm32(int rho) { const int n = rho >> 4, i = rho & 15; return 8 * (i >> 2) + 4 * n + (i & 3); }

__host__ __device__ __forceinline__ size_t tiled_off(int r, int k, int K) { return (size_t)(r >> 8) * ((size_t)BM * K) + (size_t)(k >> 6) * (BM * BK) + (size_t)(r & 255) * BK + (k & 63); }
typedef int i32x4 __attribute__((ext_vector_type(4)));
template <bool I8> struct AccType { typedef f32x4 type; };
template <> struct AccType<true> { typedef i32x4 type; };
__device__ __forceinline__ f32x4 mma16(bf16x8 a, bf16x8 b, f32x4 c) { return __builtin_amdgcn_mfma_f32_16x16x32_bf16(a, b, c, 0, 0, 0); }
__device__ __forceinline__ i32x4 mma16(bf16x8 a, bf16x8 b, i32x4 c) { return __builtin_amdgcn_mfma_i32_16x16x64_i8(__builtin_bit_cast(i32x4, a), __builtin_bit_cast(i32x4, b), c, 0, 0, 0); }
struct Unit { int pm, pn; };
struct Gemm { const bf16_t* A; const bf16_t* Bt; int M, N, K; };

struct StaticOrder {
    int nM, nN, nwg, G, c, wgm, i0, i1;
    __host__ __device__ void init(int M, int N, int G_, int c_, int wgm_ = WGM, int i0_ = 0, int i1_ = 1 << 20) { nM = M / BM; nN = N / BM; nwg = nM * nN; G = G_; c = c_; wgm = wgm_; i0 = i0_; i1 = i1_; }
    __host__ __device__ void decode(long L, Unit& u) const {
        int wgid = (int)L; { const int q = nwg / NXCD, r = nwg % NXCD, xcd = wgid % NXCD, off = wgid / NXCD; wgid = (xcd < r ? xcd * (q + 1) : r * (q + 1) + (xcd - r) * q) + off; }
        const int nig = wgm * nN, gid = wgid / nig, fm = gid * wgm, gsz = (nM - fm) < wgm ? (nM - fm) : wgm;
        u.pm = fm + ((wgid % nig) % gsz); u.pn = (wgid % nig) / gsz;
    }
    __host__ __device__ bool next(int i, Unit& u) const {
        if (i + i0 >= i1) return false;
        const long L = (long)(i + i0) * G + c; if (L >= nwg) return false;
        decode(L, u); return true;
    }
    __device__ __forceinline__ void a_ready(const Unit&) const {}
    __device__ __forceinline__ void done(const Unit&) const {}
};
struct ClaimOrder : StaticOrder {
    int nfull, nleft; unsigned* ctr; volatile PG8_LAS unsigned* slot;
    __device__ void setup(unsigned* ctr_, volatile PG8_LAS unsigned* slot_) { nfull = nwg / G; nleft = nwg - nfull * G; ctr = ctr_; slot = slot_; }
    __device__ __forceinline__ bool next(int i, Unit& u) const {
        if (i < nfull) { decode((long)i * G + c, u); return true; }
        if (i > nfull || nleft == 0) return false;
        if (threadIdx.x == 0) { const unsigned id = __hip_atomic_fetch_add(ctr, 1u, __ATOMIC_RELAXED, __HIP_MEMORY_SCOPE_AGENT); *slot = id; }
        asm volatile("s_waitcnt lgkmcnt(0)" ::: "memory"); __builtin_amdgcn_s_barrier(); asm volatile("" ::: "memory");
        const unsigned id = *slot;
        if (id >= (unsigned)nleft) return false;
        decode((long)nfull * G + id, u); return true;
    }
};
__device__ __forceinline__ unsigned cvt_pk_bf16(float lo, float hi) { unsigned r; asm volatile("v_cvt_pk_bf16_f32 %0, %1, %2" : "=v"(r) : "v"(lo), "v"(hi)); return r; }
__device__ __forceinline__ float silu_mul(float g, float u) { return g * u * __builtin_amdgcn_rcpf(1.0f + __builtin_amdgcn_exp2f(g * -1.4426950408889634f)); }
#ifndef ACT_DROP
#define ACT_DROP 0
#endif
struct EpiSwiGLU {
    static constexpr bool PERM = true, AFTER_DRAIN = false;
    bf16_t* O; int ldc;
    __device__ __forceinline__ void operator()(const f32x4 (&acc)[2][2][4][2], const Unit& u, int wr, int wc, int fr, int fq) const {
        const int row0 = u.pm * BM + wr * 64 + fr, col0 = u.pn * HALF + wc * 32 + 8 * fq;
#pragma unroll
        for (int ai = 0; ai < 2; ++ai)
#pragma unroll
            for (int m = 0; m < 4; ++m) { bf16_t* p = O + tiled_off(row0 + ai * HALF + m * 16, col0, ldc);
                const f32x4 g0 = acc[ai][0][m][0], g1 = acc[ai][0][m][1], u0 = acc[ai][1][m][0], u1 = acc[ai][1][m][1];
                u32x4 w; w.x = cvt_pk_bf16(silu_mul(g0[0], u0[0]), silu_mul(g0[1], u0[1])); w.y = cvt_pk_bf16(silu_mul(g0[2], u0[2]), silu_mul(g0[3], u0[3]));
                w.z = cvt_pk_bf16(silu_mul(g1[0], u1[0]), silu_mul(g1[1], u1[1])); w.w = cvt_pk_bf16(silu_mul(g1[2], u1[2]), silu_mul(g1[3], u1[3]));
                if (ACT_DROP > 0) { constexpr unsigned add_ = ((1u << ACT_DROP) >> 1) * 0x00010001u, msk_ = ~(((1u << ACT_DROP) - 1u) * 0x00010001u);
                    w.x = (w.x + add_) & msk_; w.y = (w.y + add_) & msk_; w.z = (w.z + add_) & msk_; w.w = (w.w + add_) & msk_; }
                *(u32x4*)p = w; }
    }
};
struct EpiSwiGLU8 {
    static constexpr bool PERM = true, AFTER_DRAIN = false;
    bf16_t* O; int ldc; const float* sA; const float* colmax;
    __device__ __forceinline__ void operator()(const i32x4 (&acc)[2][2][4][2], const Unit& u, int wr, int wc, int fr, int fq) const {
        const int row0 = u.pm * BM + wr * 64 + fr, col0 = u.pn * HALF + wc * 32 + 8 * fq;
        const f32x4 sg0 = *(const f32x4*)(colmax + col0) * (1.0f / 127.0f), sg1 = *(const f32x4*)(colmax + col0 + 4) * (1.0f / 127.0f);
        const f32x4 su0 = *(const f32x4*)(colmax + ldc + col0) * (1.0f / 127.0f), su1 = *(const f32x4*)(colmax + ldc + col0 + 4) * (1.0f / 127.0f);
        float rs[2][4];
#pragma unroll
        for (int ai = 0; ai < 2; ++ai)
#pragma unroll
            for (int m = 0; m < 4; ++m) rs[ai][m] = sA[row0 + ai * HALF + m * 16];
#pragma unroll
        for (int ai = 0; ai < 2; ++ai)
#pragma unroll
            for (int m = 0; m < 4; ++m) { bf16_t* p = O + (size_t)(row0 + ai * HALF + m * 16) * ldc + col0; const float r = rs[ai][m];
                const f32x4 g0 = __builtin_convertvector(acc[ai][0][m][0], f32x4) * sg0 * r, g1 = __builtin_convertvector(acc[ai][0][m][1], f32x4) * sg1 * r;
                const f32x4 u0 = __builtin_convertvector(acc[ai][1][m][0], f32x4) * su0 * r, u1 = __builtin_convertvector(acc[ai][1][m][1], f32x4) * su1 * r;
                u32x4 w; w.x = cvt_pk_bf16(silu_mul(g0[0], u0[0]), silu_mul(g0[1], u0[1])); w.y = cvt_pk_bf16(silu_mul(g0[2], u0[2]), silu_mul(g0[3], u0[3]));
                w.z = cvt_pk_bf16(silu_mul(g1[0], u1[0]), silu_mul(g1[1], u1[1])); w.w = cvt_pk_bf16(silu_mul(g1[2], u1[2]), silu_mul(g1[3], u1[3]));
                *(u32x4*)p = w; }
    }
};
struct EpiResid {
    static constexpr bool PERM = false, AFTER_DRAIN = false;
    const float* base; float* out; int ldc; float alpha;
    __device__ __forceinline__ void operator()(const f32x4 (&acc)[2][2][4][2], const Unit& u, int wr, int wc, int fr, int fq) const {
        const int row0 = u.pm * BM + wr * 64 + fr, col0 = u.pn * BM + wc * 32 + 4 * fq;
#pragma unroll
        for (int ai = 0; ai < 2; ++ai)
#pragma unroll
            for (int m = 0; m < 4; ++m) { const size_t off = (size_t)(row0 + ai * HALF + m * 16) * ldc + col0;
#pragma unroll
                for (int bj = 0; bj < 2; ++bj)
#pragma unroll
                    for (int n = 0; n < 2; ++n) { const f32x4 b = *(const f32x4*)(base + off + bj * HALF + n * 16); *(f32x4*)(out + off + bj * HALF + n * 16) = b + acc[ai][bj][m][n] * alpha; }
                asm volatile("" ::: "memory"); }
    }
};
template <int DH> struct EpiRope {
    static constexpr bool PERM = true, AFTER_DRAIN = false;
    bf16_t *dq, *dk, *dv; int ldq, ldk, ldv, nq, nk; float qscale; const float *cosT, *sinT;
    __device__ __forceinline__ void operator()(const f32x4 (&acc)[2][2][4][2], const Unit& u, int wr, int wc, int fr, int fq) const {
        const int row0 = u.pm * BM + wr * 64 + fr;
        if (u.pn >= nq + nk) {
            const int col0 = (u.pn - nq - nk) * BM + wc * 32 + 8 * fq;
#pragma unroll
            for (int ai = 0; ai < 2; ++ai)
#pragma unroll
                for (int m = 0; m < 4; ++m) { bf16_t* p = dv + (size_t)(row0 + ai * HALF + m * 16) * ldv + col0;
#pragma unroll
                    for (int bj = 0; bj < 2; ++bj) { const f32x4 v0 = acc[ai][bj][m][0], v1 = acc[ai][bj][m][1];
                        u32x4 w; w.x = cvt_pk_bf16(v0[0], v0[1]); w.y = cvt_pk_bf16(v0[2], v0[3]); w.z = cvt_pk_bf16(v1[0], v1[1]); w.w = cvt_pk_bf16(v1[2], v1[3]);
                        *(u32x4*)(p + bj * HALF) = w; } }
            return;
        }
        const bool isq = u.pn < nq; bf16_t* dst = isq ? dq : dk; const int ld = isq ? ldq : ldk, pt = isq ? u.pn : u.pn - nq; const float sc = isq ? qscale : 1.0f;
        constexpr int HD2 = DH / 2, HPT = BM / DH;
        const int t = wc * 32 + 8 * fq, hl = t / HD2, i0 = t % HD2, col1 = (HPT * pt + hl) * DH + i0;
#pragma unroll
        for (int ai = 0; ai < 2; ++ai)
#pragma unroll
            for (int m = 0; m < 4; ++m) { const int row = row0 + ai * HALF + m * 16;
                const f32x4 c0 = *(const f32x4*)(cosT + (size_t)row * HD2 + i0), c1 = *(const f32x4*)(cosT + (size_t)row * HD2 + i0 + 4);
                const f32x4 s0 = *(const f32x4*)(sinT + (size_t)row * HD2 + i0), s1 = *(const f32x4*)(sinT + (size_t)row * HD2 + i0 + 4);
                const f32x4 xa0 = acc[ai][0][m][0], xa1 = acc[ai][0][m][1], xb0 = acc[ai][1][m][0], xb1 = acc[ai][1][m][1];
                const f32x4 o10 = (xa0 * c0 - xb0 * s0) * sc, o11 = (xa1 * c1 - xb1 * s1) * sc, o20 = (xb0 * c0 + xa0 * s0) * sc, o21 = (xb1 * c1 + xa1 * s1) * sc;
                bf16_t* p = dst + (size_t)row * ld + col1;
                u32x4 w; w.x = cvt_pk_bf16(o10[0], o10[1]); w.y = cvt_pk_bf16(o10[2], o10[3]); w.z = cvt_pk_bf16(o11[0], o11[1]); w.w = cvt_pk_bf16(o11[2], o11[3]);
                *(u32x4*)p = w;
                w.x = cvt_pk_bf16(o20[0], o20[1]); w.y = cvt_pk_bf16(o20[2], o20[3]); w.z = cvt_pk_bf16(o21[0], o21[1]); w.w = cvt_pk_bf16(o21[2], o21[3]);
                *(u32x4*)(p + HD2) = w;
                asm volatile("" ::: "memory"); }
    }
};
template <int DH> struct EpiRope8 {
    static constexpr bool PERM = true, AFTER_DRAIN = false;
    bf16_t *dq, *dk, *dv; int ldq, ldk, ldv, nq, nk; float qscale; const float *cosT, *sinT; const float* sA; const float* colmax;
    __device__ __forceinline__ void operator()(const i32x4 (&acc)[2][2][4][2], const Unit& u, int wr, int wc, int fr, int fq) const {
        const int row0 = u.pm * BM + wr * 64 + fr;
        float rs[2][4];
#pragma unroll
        for (int ai = 0; ai < 2; ++ai)
#pragma unroll
            for (int m = 0; m < 4; ++m) rs[ai][m] = sA[row0 + ai * HALF + m * 16];
        if (u.pn >= nq + nk) {
            const int col0 = (u.pn - nq - nk) * BM + wc * 32 + 8 * fq, src0 = u.pn * BM + wc * 32 + 8 * fq;
            f32x4 sc[2][2];
#pragma unroll
            for (int bj = 0; bj < 2; ++bj) { sc[bj][0] = *(const f32x4*)(colmax + src0 + bj * HALF) * (1.0f / 127.0f); sc[bj][1] = *(const f32x4*)(colmax + src0 + bj * HALF + 4) * (1.0f / 127.0f); }
#pragma unroll
            for (int ai = 0; ai < 2; ++ai)
#pragma unroll
                for (int m = 0; m < 4; ++m) { bf16_t* p = dv + (size_t)(row0 + ai * HALF + m * 16) * ldv + col0; const float r = rs[ai][m];
#pragma unroll
                    for (int bj = 0; bj < 2; ++bj) { const f32x4 v0 = __builtin_convertvector(acc[ai][bj][m][0], f32x4) * sc[bj][0] * r, v1 = __builtin_convertvector(acc[ai][bj][m][1], f32x4) * sc[bj][1] * r;
                        u32x4 w; w.x = cvt_pk_bf16(v0[0], v0[1]); w.y = cvt_pk_bf16(v0[2], v0[3]); w.z = cvt_pk_bf16(v1[0], v1[1]); w.w = cvt_pk_bf16(v1[2], v1[3]);
                        *(u32x4*)(p + bj * HALF) = w; } }
            return;
        }
        const bool isq = u.pn < nq; bf16_t* dst = isq ? dq : dk; const int ld = isq ? ldq : ldk, pt = isq ? u.pn : u.pn - nq; const float scq = isq ? qscale : 1.0f;
        constexpr int HD2 = DH / 2, HPT = BM / DH;
        const int t = wc * 32 + 8 * fq, hl = t / HD2, i0 = t % HD2, col1 = (HPT * pt + hl) * DH + i0, src1 = (HPT * u.pn + hl) * DH + i0;
        const f32x4 sa0 = *(const f32x4*)(colmax + src1) * (1.0f / 127.0f), sa1 = *(const f32x4*)(colmax + src1 + 4) * (1.0f / 127.0f);
        const f32x4 sb0 = *(const f32x4*)(colmax + src1 + HD2) * (1.0f / 127.0f), sb1 = *(const f32x4*)(colmax + src1 + HD2 + 4) * (1.0f / 127.0f);
#pragma unroll
        for (int ai = 0; ai < 2; ++ai)
#pragma unroll
            for (int m = 0; m < 4; ++m) { const int row = row0 + ai * HALF + m * 16; const float r = rs[ai][m];
                const f32x4 c0 = *(const f32x4*)(cosT + (size_t)row * HD2 + i0), c1 = *(const f32x4*)(cosT + (size_t)row * HD2 + i0 + 4);
                const f32x4 s0 = *(const f32x4*)(sinT + (size_t)row * HD2 + i0), s1 = *(const f32x4*)(sinT + (size_t)row * HD2 + i0 + 4);
                const f32x4 xa0 = __builtin_convertvector(acc[ai][0][m][0], f32x4) * sa0 * r, xa1 = __builtin_convertvector(acc[ai][0][m][1], f32x4) * sa1 * r;
                const f32x4 xb0 = __builtin_convertvector(acc[ai][1][m][0], f32x4) * sb0 * r, xb1 = __builtin_convertvector(acc[ai][1][m][1], f32x4) * sb1 * r;
                const f32x4 o10 = (xa0 * c0 - xb0 * s0) * scq, o11 = (xa1 * c1 - xb1 * s1) * scq, o20 = (xb0 * c0 + xa0 * s0) * scq, o21 = (xb1 * c1 + xa1 * s1) * scq;
                bf16_t* p = dst + (size_t)row * ld + col1;
                u32x4 w; w.x = cvt_pk_bf16(o10[0], o10[1]); w.y = cvt_pk_bf16(o10[2], o10[3]); w.z = cvt_pk_bf16(o11[0], o11[1]); w.w = cvt_pk_bf16(o11[2], o11[3]);
                *(u32x4*)p = w;
                w.x = cvt_pk_bf16(o20[0], o20[1]); w.y = cvt_pk_bf16(o20[2], o20[3]); w.z = cvt_pk_bf16(o21[0], o21[1]); w.w = cvt_pk_bf16(o21[2], o21[3]);
                *(u32x4*)(p + HD2) = w;
                asm volatile("" ::: "memory"); }
    }
};
struct EpiResid8 {
    static constexpr bool PERM = false, AFTER_DRAIN = false;
    const float* base; bf16_t* xr; int ldc; float alpha; const float* sA; const float* colmax;
    __device__ __forceinline__ void operator()(const i32x4 (&acc)[2][2][4][2], const Unit& u, int wr, int wc, int fr, int fq) const {
        const int row0 = u.pm * BM + wr * 64 + fr, col0 = u.pn * BM + wc * 32 + 4 * fq;
        f32x4 sc[2][2];
#pragma unroll
        for (int bj = 0; bj < 2; ++bj)
#pragma unroll
            for (int n = 0; n < 2; ++n) sc[bj][n] = *(const f32x4*)(colmax + col0 + bj * HALF + n * 16) * (alpha * (1.0f / 127.0f));
        float rs[2][4];
#pragma unroll
        for (int ai = 0; ai < 2; ++ai)
#pragma unroll
            for (int m = 0; m < 4; ++m) rs[ai][m] = sA[row0 + ai * HALF + m * 16];
#pragma unroll
        for (int ai = 0; ai < 2; ++ai)
#pragma unroll
            for (int m = 0; m < 4; ++m) { const size_t off = (size_t)(row0 + ai * HALF + m * 16) * ldc + col0; const float r = rs[ai][m];
#pragma unroll
                for (int bj = 0; bj < 2; ++bj)
#pragma unroll
                    for (int n = 0; n < 2; ++n) { f32x4 b;
                        if (base) b = *(const f32x4*)(base + off + bj * HALF + n * 16);
                        else { const u32x2 w = *(const u32x2*)(xr + off + bj * HALF + n * 16); b[0] = __builtin_bit_cast(float, w.x << 16); b[1] = __builtin_bit_cast(float, w.x & 0xffff0000u); b[2] = __builtin_bit_cast(float, w.y << 16); b[3] = __builtin_bit_cast(float, w.y & 0xffff0000u); }
                        const f32x4 o = b + __builtin_convertvector(acc[ai][bj][m][n], f32x4) * sc[bj][n] * r;
                        u32x2 y; y.x = cvt_pk_bf16(o[0], o[1]); y.y = cvt_pk_bf16(o[2], o[3]); *(u32x2*)(xr + off + bj * HALF + n * 16) = y; }
                asm volatile("" ::: "memory"); }
    }
};
template <class Epi, class Sched, bool ALIGN_EPI = false, bool SP2 = false, bool TA = false, bool TB = false, bool I8 = false>
__device__ __forceinline__ void gemm_phase(PG8_LAS unsigned char* lds, const Gemm g, const Sched& S, const Epi& E) {
    const int tid = threadIdx.x, wid = __builtin_amdgcn_readfirstlane(tid >> 6), lane = tid & 63, wr = wid >> 2, wc = wid & 3, fr = lane & 15, fq = lane >> 4;
    const int KB = I8 ? g.K : 2 * g.K, nt = KB / (BK * 2);
    unsigned voffA[2], voffB[2];
#pragma unroll
    for (int i = 0; i < 2; ++i) { int R, C; stage_rc(tid * 16 + i * 8192, R, C); const int Rb = Epi::PERM ? ((R & ~31) + perm32(R & 31)) : R;
        voffA[i] = (unsigned)(R * (TA ? BK * 2 : KB) + C * 2); voffB[i] = (unsigned)(Rb * (TB ? BK * 2 : KB) + C * 2); }
    const size_t kstepA = TA ? (size_t)(BM * BK * 2) : (size_t)(BK * 2), kstepB = TB ? (size_t)(BM * BK * 2) : (size_t)(BK * 2);
    const size_t hstepA = TA ? (size_t)(HALF * BK * 2) : (size_t)HALF * KB, hstepB = TB ? (size_t)(HALF * BK * 2) : (size_t)HALF * KB;
    const size_t tstep = (size_t)BM * KB;
    const unsigned ldsw = (unsigned)wid * 1024u;
    const int aoff = lds_byte(wr * 64 + fr, fq * 8), boff = lds_byte(wc * 32 + fr, fq * 8);
#define PG8_SA(b, h) (((b) * 2 + (h)) * HTB)
#define PG8_SB(b, h) ((4 + (b) * 2 + (h)) * HTB)
#define PG8_STAGE(bufoff, gbase, voff) do { _Pragma("unroll") for (int _i = 0; _i < 2; ++_i) \
        __builtin_amdgcn_global_load_lds((const unsigned*)((const char*)(gbase) + (voff)[_i]), (PG8_LAS unsigned*)(lds + (bufoff) + ldsw + _i * 8192), 16, 0, 0); } while (0)
#define PG8_LDA(dst, b, h) do { _Pragma("unroll") for (int m = 0; m < 4; ++m) _Pragma("unroll") for (int k = 0; k < 2; ++k) dst[m][k] = *(const PG8_LAS bf16x8*)(lds + PG8_SA(b, h) + aoff + m * 2048 + k * 1024); } while (0)
#define PG8_LDB(dst, b, h) do { _Pragma("unroll") for (int n = 0; n < 2; ++n) _Pragma("unroll") for (int k = 0; k < 2; ++k) dst[n][k] = *(const PG8_LAS bf16x8*)(lds + PG8_SB(b, h) + boff + n * 2048 + k * 1024); } while (0)
#define PG8_MMA(ai, bj, At, Bt) do { __builtin_amdgcn_s_setprio(1); _Pragma("unroll") for (int m = 0; m < 4; ++m) _Pragma("unroll") for (int n = 0; n < 2; ++n) _Pragma("unroll") for (int k = 0; k < 2; ++k) \
        acc[ai][bj][m][n] = mma16(Bt[n][k], At[m][k], acc[ai][bj][m][n]); __builtin_amdgcn_s_setprio(0); } while (0)
#define PG8_WAIT_V(n) asm volatile("s_waitcnt vmcnt(" #n ")" ::: "memory")
#define PG8_WAIT_L(n) asm volatile("s_waitcnt lgkmcnt(" #n ")" ::: "memory")
#define PG8_BAR __builtin_amdgcn_s_barrier()
#define PG8_SCHED __builtin_amdgcn_sched_barrier(0)
    Unit cur, nxt; int ui = 0;
    if (!S.next(0, cur)) return;
    typedef typename AccType<I8>::type accv;
    accv acc[2][2][4][2];
#pragma unroll
    for (int a = 0; a < 2; ++a)
#pragma unroll
        for (int b = 0; b < 2; ++b)
#pragma unroll
            for (int m = 0; m < 4; ++m)
#pragma unroll
                for (int n = 0; n < 2; ++n) acc[a][b][m][n] = (accv){0, 0, 0, 0};
    bf16x8 At[4][2], B0[2][2], B1[2][2];
    const char* cA = (const char*)g.A + (size_t)cur.pm * tstep; const char* cB = (const char*)g.Bt + (size_t)cur.pn * tstep;
    S.a_ready(cur);
    if constexpr (SP2) {
        PG8_STAGE(PG8_SB(0, 0), cB, voffB); PG8_STAGE(PG8_SB(0, 1), cB + hstepB, voffB); PG8_STAGE(PG8_SA(0, 0), cA, voffA); PG8_STAGE(PG8_SA(0, 1), cA + hstepA, voffA);
        if (wr == 1) PG8_BAR;
        PG8_WAIT_V(2); PG8_BAR;
        PG8_STAGE(PG8_SB(1, 0), cB + kstepB, voffB); PG8_STAGE(PG8_SA(1, 0), cA + kstepA, voffA); PG8_STAGE(PG8_SB(1, 1), cB + hstepB + kstepB, voffB);
        PG8_WAIT_V(6); PG8_BAR;
    } else {
        PG8_STAGE(PG8_SB(0, 0), cB, voffB); PG8_STAGE(PG8_SA(0, 0), cA, voffA); PG8_STAGE(PG8_SB(0, 1), cB + hstepB, voffB); PG8_STAGE(PG8_SA(0, 1), cA + hstepA, voffA);
        if (wr == 1) PG8_BAR;
        PG8_WAIT_V(4); PG8_BAR;
        PG8_STAGE(PG8_SB(1, 0), cB + kstepB, voffB); PG8_STAGE(PG8_SA(1, 0), cA + kstepA, voffA); PG8_STAGE(PG8_SB(1, 1), cB + hstepB + kstepB, voffB);
        PG8_WAIT_V(6); PG8_BAR;
    }
    for (;;) {
        const bool has_next = S.next(ui + 1, nxt);
        const char* nA = has_next ? (const char*)g.A + (size_t)nxt.pm * tstep : cA; const char* nB = has_next ? (const char*)g.Bt + (size_t)nxt.pn * tstep : cB;
        for (int t = 0; t < nt; t += 2) {
            const bool last = (t == nt - 2);
            const char* a1 = cA + (size_t)(t + 1) * kstepA;
            const char* a2 = last ? nA : cA + (size_t)(t + 2) * kstepA; const char* b2 = last ? nB : cB + (size_t)(t + 2) * kstepB;
            const char* a3 = a2 + kstepA; const char* b3 = b2 + kstepB;
            if (last && has_next) S.a_ready(nxt);
            if constexpr (SP2) {
            PG8_LDB(B0, 0, 0); PG8_LDB(B1, 0, 1); PG8_SCHED; PG8_LDA(At, 0, 0); PG8_STAGE(PG8_SA(1, 1), a1 + hstepA, voffA);
            PG8_WAIT_V(8); PG8_WAIT_L(0); PG8_BAR; PG8_MMA(0, 0, At, B0); PG8_MMA(0, 1, At, B1); PG8_BAR; PG8_SCHED;
            PG8_LDA(At, 0, 1); PG8_STAGE(PG8_SB(0, 0), b2, voffB); PG8_STAGE(PG8_SB(0, 1), b2 + hstepB, voffB); PG8_STAGE(PG8_SA(0, 0), a2, voffA);
            PG8_WAIT_V(8); PG8_WAIT_L(0); PG8_BAR; PG8_MMA(1, 0, At, B0); PG8_MMA(1, 1, At, B1); PG8_BAR; PG8_SCHED;
            PG8_LDB(B0, 1, 0); PG8_LDB(B1, 1, 1); PG8_SCHED; PG8_LDA(At, 1, 0); PG8_STAGE(PG8_SA(0, 1), a2 + hstepA, voffA);
            PG8_WAIT_V(8); PG8_WAIT_L(0); PG8_BAR; PG8_MMA(0, 0, At, B0); PG8_MMA(0, 1, At, B1); PG8_BAR; PG8_SCHED;
            PG8_LDA(At, 1, 1); PG8_STAGE(PG8_SB(1, 0), b3, voffB); PG8_STAGE(PG8_SB(1, 1), b3 + hstepB, voffB); PG8_STAGE(PG8_SA(1, 0), a3, voffA);
            PG8_WAIT_V(8); PG8_WAIT_L(0); PG8_BAR; PG8_MMA(1, 0, At, B0); PG8_MMA(1, 1, At, B1); PG8_BAR; PG8_SCHED;
            } else {
            PG8_LDB(B0, 0, 0); PG8_SCHED; PG8_LDA(At, 0, 0); PG8_STAGE(PG8_SA(1, 1), a1 + hstepA, voffA);
            PG8_WAIT_L(8); PG8_BAR; PG8_WAIT_L(0); PG8_MMA(0, 0, At, B0); PG8_BAR; PG8_SCHED;
            PG8_LDB(B1, 0, 1); PG8_STAGE(PG8_SB(0, 0), b2, voffB);
            PG8_BAR; PG8_WAIT_L(0); PG8_MMA(0, 1, At, B1); PG8_BAR;
            PG8_LDA(At, 0, 1); PG8_STAGE(PG8_SA(0, 0), a2, voffA);
            PG8_BAR; PG8_WAIT_L(0); PG8_MMA(1, 0, At, B0); PG8_BAR; PG8_SCHED;
            PG8_STAGE(PG8_SB(0, 1), b2 + hstepB, voffB);
            PG8_WAIT_V(6); PG8_BAR; PG8_MMA(1, 1, At, B1); PG8_BAR;
            PG8_LDB(B0, 1, 0); PG8_SCHED; PG8_LDA(At, 1, 0); PG8_STAGE(PG8_SA(0, 1), a2 + hstepA, voffA);
            PG8_WAIT_L(8); PG8_BAR; PG8_WAIT_L(0); PG8_MMA(0, 0, At, B0); PG8_BAR; PG8_SCHED;
            PG8_LDB(B1, 1, 1); PG8_STAGE(PG8_SB(1, 0), b3, voffB);
            PG8_BAR; PG8_WAIT_L(0); PG8_MMA(0, 1, At, B1); PG8_BAR;
            PG8_LDA(At, 1, 1); PG8_STAGE(PG8_SA(1, 0), a3, voffA);
            PG8_BAR; PG8_WAIT_L(0); PG8_MMA(1, 0, At, B0); PG8_BAR; PG8_SCHED;
            PG8_STAGE(PG8_SB(1, 1), b3 + hstepB, voffB);
            PG8_WAIT_V(6); PG8_BAR; PG8_MMA(1, 1, At, B1); PG8_BAR;
            }
        }
        if constexpr (ALIGN_EPI) { if (wr == 0) PG8_BAR; }
        if constexpr (!Epi::AFTER_DRAIN) { E(acc, cur, wr, wc, fr, fq); S.done(cur); }
        if (!has_next) break;
#pragma unroll
        for (int a = 0; a < 2; ++a)
#pragma unroll
            for (int b = 0; b < 2; ++b)
#pragma unroll
                for (int m = 0; m < 4; ++m)
#pragma unroll
                    for (int n = 0; n < 2; ++n) acc[a][b][m][n] = (accv){0, 0, 0, 0};
        cur = nxt; cA = nA; cB = nB; ++ui;
        if constexpr (ALIGN_EPI) { if (wr == 1) PG8_BAR; }
    }
    PG8_WAIT_V(0);
    if constexpr (!ALIGN_EPI) { if (wr == 0) PG8_BAR; }
    PG8_BAR;
    if constexpr (Epi::AFTER_DRAIN) { E.fused(acc, cur, wr, wc, fr, fq, lds, wid, lane); S.done(cur); }
#undef PG8_SA
#undef PG8_SB
#undef PG8_STAGE
#undef PG8_LDA
#undef PG8_LDB
#undef PG8_MMA
#undef PG8_WAIT_V
#undef PG8_WAIT_L
#undef PG8_BAR
#undef PG8_SCHED
}
}
constexpr int NWAVES = 8;
#ifndef MK_SPLIT
#define MK_SPLIT 0
#endif
#ifndef PG8_SP2
#define PG8_SP2 true
#endif
#ifndef PG8_ALIGN
#define PG8_ALIGN true
#endif
#ifndef XN_TILED
#define XN_TILED false
#endif
constexpr int N_PHASES = 31;

constexpr int SEQ = 16384, DM = 4096, DFF = 11008, M = SEQ;
constexpr int A_H = 32, A_D = 128, A_KVW = 1024, NQKV = 6144;
constexpr int B_H = 64, B_D = 64, B_KVW = 512;
constexpr int NBLK = 64;
constexpr float RMS_EPS = 1e-6f;
constexpr float LOG2E = 1.4426950408889634f;

constexpr size_t MiB = 1u << 20;
constexpr size_t WS_CTL = 0, CTL_ZERO_BYTES = 1 * MiB;
constexpr size_t SZ_WIN = 172 * MiB, SZ_WOUT = 86 * MiB;
constexpr size_t WS_WIN = 1 * MiB;
constexpr size_t WS_WOUT = WS_WIN + 4 * SZ_WIN;
constexpr size_t WS_WQKV = WS_WOUT + 4 * SZ_WOUT;
constexpr size_t WS_WAO = WS_WQKV + 48 * MiB;
constexpr size_t WS_WKV = WS_WAO + 32 * MiB;
constexpr size_t WS_WBQ = WS_WKV + 8 * MiB;
constexpr size_t WS_WBO = WS_WBQ + 32 * MiB;
constexpr size_t WS_XN = WS_WBO + 32 * MiB;
constexpr size_t WS_ACT = WS_XN + 128 * MiB;
constexpr size_t WS_Q = WS_ACT + 344 * MiB;
constexpr size_t WS_K = WS_Q + 128 * MiB;
constexpr size_t WS_V = WS_K + 32 * MiB;
constexpr size_t WS_O = WS_V + 32 * MiB;
constexpr size_t WS_KSH = WS_O + 128 * MiB;
constexpr size_t WS_VSH = WS_KSH + 16 * MiB;
constexpr size_t WS_ROPEA = WS_VSH + 16 * MiB;
constexpr size_t WS_ROPEB = WS_ROPEA + 8 * MiB;
constexpr size_t WS_KMEAN = WS_ROPEB + 4 * MiB;
constexpr size_t WS_LIST = WS_KMEAN + 1 * MiB;
constexpr size_t WS_PARTO = WS_LIST + 63 * MiB;
constexpr size_t WS_PARTML = WS_PARTO + 512 * MiB;
constexpr size_t WS_XN8 = WS_PARTML + 16 * MiB;
constexpr size_t WS_SA = WS_XN8 + 64 * MiB;
constexpr size_t WS_ACT8 = WS_SA + 1 * MiB;
constexpr size_t WS_SACT = WS_ACT8 + 172 * MiB;
constexpr size_t WS_END = WS_SACT + 1 * MiB;
static_assert(SZ_WIN == (size_t)22016 * 4096 * 2 && SZ_WOUT == (size_t)4096 * 11008 * 2, "weight sizes");
constexpr int CW_TMO = 0, CW_CODE = 1;
constexpr int CW_BAR = 4096;
constexpr int CW_CLAIM = 12288;
constexpr int CW_COLMAX = 32768;
constexpr int CW_CNT = 8192;

constexpr int RING_OFF = 0, RING_BYTES = 131072;
constexpr int LDSCTL_OFF = 146944, MISC_OFF = LDSCTL_OFF + 256;
constexpr int LDS_BYTES = 147456;
static_assert(MISC_OFF + 128 <= 147456 && RING_BYTES <= LDSCTL_OFF, "LDS map");

#define GAS __attribute__((address_space(1)))
#define LAS __attribute__((address_space(3)))
#define DI __device__ __forceinline__
typedef unsigned short bf16;
typedef unsigned v4u __attribute__((ext_vector_type(4)));
typedef unsigned v2u __attribute__((ext_vector_type(2)));
typedef float f32x4 __attribute__((ext_vector_type(4)));
typedef float f32x16 __attribute__((ext_vector_type(16)));
typedef short bf16x8 __attribute__((ext_vector_type(8)));
typedef short s16x4 __attribute__((ext_vector_type(4)));
typedef GAS unsigned gu32;
#define RLX_AGENT __ATOMIC_RELAXED, __HIP_MEMORY_SCOPE_AGENT
#define LDS_WAIT() asm volatile("s_waitcnt lgkmcnt(0)" ::: "memory")
#define VM_WAIT() asm volatile("s_waitcnt vmcnt(0)" ::: "memory")
DI unsigned f2bf(float f) { unsigned u = __builtin_bit_cast(unsigned, f); return (u + 0x7fffu + ((u >> 16) & 1u)) >> 16; }
DI unsigned pk2(float lo, float hi) { return f2bf(lo) | (f2bf(hi) << 16); }
DI float bf2f(unsigned b) { return __builtin_bit_cast(float, b << 16); }
#define XB_TMO      128
#define XB_XCNT(j)  (256  + 64 * (j))
#define XB_XSUB(j)  (1280 + 64 * (j))
#define XB_XGEN(j)  (2304 + 64 * (j))
#define XB_TOP      3328
#define XB_TOPGEN   3392
#define XCD_BAR_WORDS 3456
#define XB_SPIN_CAP (1u << 18)

__device__ __forceinline__ unsigned xb_ld(unsigned* p)              { return __hip_atomic_load(p, __ATOMIC_RELAXED, __HIP_MEMORY_SCOPE_AGENT); }
__device__ __forceinline__ unsigned xb_add(unsigned* p, unsigned v) { return __hip_atomic_fetch_add(p, v, __ATOMIC_RELAXED, __HIP_MEMORY_SCOPE_AGENT); }
__device__ __forceinline__ unsigned xb_xcc_id() { return (unsigned)__builtin_amdgcn_s_getreg((3 << 11) | 20) & 0xFu; }
#define XB_SPIN(cond, bar) do { unsigned _sp = 0; while (cond) { __builtin_amdgcn_s_sleep(1); \
    if ((++_sp & 255u) == 0u) { if (xb_ld(&(bar)[XB_TMO])) break; if (_sp > XB_SPIN_CAP) { atomicAdd(&(bar)[XB_TMO], 1u); break; } } } } while (0)

struct XcdBarrier {
    unsigned* bar; unsigned x;
    volatile LAS unsigned* st;
};

__device__ __forceinline__ XcdBarrier xcd_barrier_post(unsigned* bar, volatile LAS unsigned* st) {
    XcdBarrier b; b.bar = bar; b.x = xb_xcc_id(); b.st = st;
    if (threadIdx.x == 0) (void)xb_add(&bar[XB_XCNT(b.x)], 1u);
    return b;
}
__device__ __forceinline__ void xcd_barrier_complete(unsigned* bar, unsigned x, unsigned& nloc, unsigned& nx) {
    const unsigned G = gridDim.x * gridDim.y * gridDim.z;
    unsigned sum, cnt, mine, sp = 0u;
    for (;;) {
        sum = 0u; cnt = 0u; mine = 0u;
#pragma unroll
        for (unsigned j = 0; j < 16; ++j) { const unsigned c = xb_ld(&bar[XB_XCNT(j)]); sum += c; cnt += (c > 0u) ? 1u : 0u; mine = (j == x) ? c : mine; }
        if (sum == G) break;
        __builtin_amdgcn_s_sleep(1);
        if ((++sp & 255u) == 0u) { if (xb_ld(&bar[XB_TMO])) break; if (sp > XB_SPIN_CAP) { atomicAdd(&bar[XB_TMO], 1u); break; } }
    }
    nloc = mine > 0u ? mine : 1u; nx = cnt > 0u ? cnt : 1u;
}

__device__ __forceinline__ void xcd_barrier(const XcdBarrier& b) {
    asm volatile("s_waitcnt vmcnt(0)" ::: "memory");
    __syncthreads();
    if (threadIdx.x == 0) {
        unsigned* bar = b.bar;
        __builtin_amdgcn_s_waitcnt(0);
        unsigned nloc = b.st[0], nx = b.st[1];
        if (nloc == 0u) { xcd_barrier_complete(bar, b.x, nloc, nx); b.st[0] = nloc; b.st[1] = nx; }
        const unsigned old = xb_add(&bar[XB_XSUB(b.x)], 1u);
        const unsigned gen = old / nloc;
        if (old + 1u == (gen + 1u) * nloc) {
            __builtin_amdgcn_fence(__ATOMIC_RELEASE, "agent");
            asm volatile("s_waitcnt vmcnt(0)" ::: "memory");
            const unsigned og = xb_add(&bar[XB_TOP], 1u);
            const unsigned tg = og / nx;
            if (og + 1u == (tg + 1u) * nx) xb_add(&bar[XB_TOPGEN], 1u);
            else XB_SPIN(xb_ld(&bar[XB_TOPGEN]) == tg, bar);
            __builtin_amdgcn_fence(__ATOMIC_ACQUIRE, "agent");
            xb_add(&bar[XB_XGEN(b.x)], 1u);
            asm volatile("s_waitcnt vmcnt(0)" ::: "memory");
        } else {
            XB_SPIN(xb_ld(&bar[XB_XGEN(b.x)]) == gen, bar);
            __builtin_amdgcn_fence(__ATOMIC_ACQUIRE, "agent");
            asm volatile("s_waitcnt vmcnt(0)" ::: "memory");
        }
    }
    __syncthreads();
}
struct Frame {
    LAS unsigned char* lds;
    volatile LAS unsigned* MISC;
    gu32* ctl;
    int tid, lane, wave;
    int vcu, G;
    unsigned char* ws;
    const float* x; const float* ffn_norm; const float* ffn_w_in; const float* ffn_w_out; const float* attn_norm; const float* a_w_qkv; const float* a_w_o;
    const float* kv_norm; const float* w_kv; const float* b_w_q; const float* b_sinks; const float* b_w_o; const float* final_norm;
    float* out;
};
DI float wave_sum(float v) {
#pragma unroll
    for (int o = 1; o < 64; o <<= 1) v += __shfl_xor(v, o);
    return v;
}
__device__ const float ROPE_INV[64] = {
1.000000000e+00f, 8.659643531e-01f, 7.498942018e-01f, 6.493816376e-01f, 5.623413324e-01f, 4.869675338e-01f, 4.216965139e-01f, 3.651741147e-01f, 3.162277639e-01f, 2.738419771e-01f, 2.371373922e-01f, 2.053525001e-01f, 1.778279394e-01f, 1.539926529e-01f, 1.333521456e-01f, 1.154782027e-01f,
1.000000015e-01f, 8.659642935e-02f, 7.498941571e-02f, 6.493816525e-02f, 5.623412877e-02f, 4.869675264e-02f, 4.216964915e-02f, 3.651741147e-02f, 3.162277862e-02f, 2.738419734e-02f, 2.371373586e-02f, 2.053524926e-02f, 1.778279431e-02f, 1.539926510e-02f, 1.333521493e-02f, 1.154781971e-02f,
9.999999776e-03f, 8.659643121e-03f, 7.498942316e-03f, 6.493816618e-03f, 5.623413250e-03f, 4.869675264e-03f, 4.216964822e-03f, 3.651741426e-03f, 3.162277862e-03f, 2.738419687e-03f, 2.371373819e-03f, 2.053525066e-03f, 1.778279431e-03f, 1.539926627e-03f, 1.333521446e-03f, 1.154781901e-03f,
1.000000047e-03f, 8.659643354e-04f, 7.498941850e-04f, 6.493816618e-04f, 5.623413017e-04f, 4.869675031e-04f, 4.216965463e-04f, 3.651741135e-04f, 3.162277862e-04f, 2.738419571e-04f, 2.371373848e-04f, 2.053525241e-04f, 1.778279402e-04f, 1.539926452e-04f, 1.333521504e-04f, 1.154782076e-04f };

template <int DROP> DI unsigned f2bf_drop(float f) { unsigned u = __builtin_bit_cast(unsigned, f); constexpr int sh = 16 + DROP; u += ((1u << (sh - 1)) - 1u) + ((u >> sh) & 1u); return ((u >> sh) << DROP) & 0xffffu; }

DI int map_col(int mode, int lim, int c) {
    const int pn = c >> 8, bj = (c >> 7) & 1, t = c & 127;
    if (mode == 1) return bj * DFF + 128 * pn + t;
    if (mode == 2 && c < lim) return (2 * pn + (t >> 6)) * 128 + 64 * bj + (t & 63);
    if (mode == 3 && c < lim) return (4 * pn + (t >> 5)) * 64 + 32 * bj + (t & 31);
    return c;
}
template <bool TILED, int DROP = 0> DI void tr_item(const float* __restrict__ src, const float* __restrict__ gain, bf16* __restrict__ dst, int K, int N, int ld, int mode, int lim, LAS float* scr, int item, int lane) {
    const int nblk = N >> 5, kb = item / nblk, nb = item - kb * nblk, k0 = kb << 6, n0 = nb << 5, s0 = map_col(mode, lim, n0);
    const int kr = lane >> 3, c4 = lane & 7;
    f32x4 v[8]; float g[8];
#pragma unroll
    for (int it = 0; it < 8; ++it) { v[it] = *(const GAS f32x4*)(src + (size_t)(k0 + 8 * it + kr) * ld + s0 + 4 * c4); g[it] = gain ? gain[k0 + 8 * it + kr] : 1.0f; }
#pragma unroll
    for (int it = 0; it < 8; ++it) { LAS float* p = scr + (8 * it + kr) * 33 + 4 * c4; p[0] = v[it].x * g[it]; p[1] = v[it].y * g[it]; p[2] = v[it].z * g[it]; p[3] = v[it].w * g[it]; }
    LDS_WAIT(); asm volatile("" ::: "memory");
#pragma unroll
    for (int j = 0; j < 4; ++j) { const int n = kr + 8 * j; const LAS float* s = scr + (8 * c4) * 33 + n;
#define PKW(a_, b_) (DROP > 0 ? (f2bf_drop<DROP>(a_) | (f2bf_drop<DROP>(b_) << 16)) : pk2(a_, b_))
        v4u o; o.x = PKW(s[0 * 33], s[1 * 33]); o.y = PKW(s[2 * 33], s[3 * 33]); o.z = PKW(s[4 * 33], s[5 * 33]); o.w = PKW(s[6 * 33], s[7 * 33]);
#undef PKW
        *(GAS v4u*)(dst + (TILED ? pg8::tiled_off(n0 + n, k0 + 8 * c4, K) : (size_t)(n0 + n) * K + k0 + 8 * c4)) = o; }
    LDS_WAIT(); asm volatile("" ::: "memory");
}
DI void sincos_acc(float angf, float& s, float& c) {
    const double x = (double)angf, q = __builtin_rint(x * 0.63661977236758134308);
    double r = __builtin_fma(-q, 1.57079632679489655800e+00, x); r = __builtin_fma(-q, 6.12323399573676603587e-17, r);
    const int qi = (int)q & 3; const double r2 = r * r;
    const double sp = r + r * r2 * (-1.0 / 6 + r2 * (1.0 / 120 + r2 * (-1.0 / 5040 + r2 * (1.0 / 362880 + r2 * (-1.0 / 39916800 + r2 * (1.0 / 6227020800.0))))));
    const double cp = 1.0 + r2 * (-0.5 + r2 * (1.0 / 24 + r2 * (-1.0 / 720 + r2 * (1.0 / 40320 + r2 * (-1.0 / 3628800 + r2 * (1.0 / 479001600 + r2 * (-1.0 / 87178291200.0)))))));
    const double ss = (qi & 1) ? cp : sp, cc = (qi & 1) ? sp : cp;
    s = (float)((qi & 2) ? -ss : ss); c = (float)(((qi + 1) & 2) ? -cc : cc);
}
DI void rope_tables(Frame& F) {
    const int gt = (F.vcu * NWAVES + F.wave) * 64 + F.lane, NT = F.G * NWAVES * 64;
    float* ca = (float*)(F.ws + WS_ROPEA); float* sa = ca + (size_t)M * 64; float* cb = (float*)(F.ws + WS_ROPEB); float* sb = cb + (size_t)M * 32;
    for (int e = gt; e < M * 64; e += NT) { const int pos = e >> 6, i = e & 63; float s, c; sincos_acc((float)pos * ROPE_INV[i], s, c); ca[e] = c; sa[e] = s; }
    for (int e = gt; e < M * 32; e += NT) { const int pos = e >> 5, i = e & 31; float s, c; sincos_acc((float)pos * ROPE_INV[2 * i], s, c); cb[e] = c; sb[e] = s; }
}
template <int DROP = 0> DI void norm_rows(Frame& F, const float* x, bf16* xn) {
    const int gw = F.vcu * NWAVES + F.wave, NGW = F.G * NWAVES;
    for (int m = gw; m < M; m += NGW) {
        const GAS f32x4* xr = (const GAS f32x4*)(x + (size_t)m * DM) + F.lane;
        f32x4 v[16]; float s = 0.f;
#pragma unroll
        for (int j = 0; j < 16; ++j) { v[j] = xr[64 * j]; s += (v[j].x * v[j].x + v[j].y * v[j].y) + (v[j].z * v[j].z + v[j].w * v[j].w); }
        const float r = 1.0f / sqrtf(wave_sum(s) * (1.0f / DM) + RMS_EPS);
#pragma unroll
        for (int j = 0; j < 16; ++j) { v2u w; if (DROP > 0) { w.x = f2bf_drop<DROP>(v[j].x * r) | (f2bf_drop<DROP>(v[j].y * r) << 16); w.y = f2bf_drop<DROP>(v[j].z * r) | (f2bf_drop<DROP>(v[j].w * r) << 16); }
            else { w.x = pk2(v[j].x * r, v[j].y * r); w.y = pk2(v[j].z * r, v[j].w * r); } const int col = 256 * j + 4 * F.lane;
            *(GAS v2u*)(xn + (XN_TILED ? pg8::tiled_off(m, col, DM) : (size_t)m * DM + col)) = w; }
    }
}
DI void colmax_item(const float* __restrict__ src, const float* __restrict__ gain, unsigned* cm, int N, int item, int lane) {
    const int ncg = N >> 8, rb = item / ncg, cg = item - rb * ncg; const int c0 = cg * 256 + 4 * lane;
    f32x4 mx = {0.f, 0.f, 0.f, 0.f};
#pragma unroll 8
    for (int r = 0; r < 256; ++r) { const int k = rb * 256 + r; const f32x4 v = *(const GAS f32x4*)(src + (size_t)k * N + c0) * (gain ? gain[k] : 1.0f);
        mx.x = __builtin_fmaxf(mx.x, __builtin_fabsf(v.x)); mx.y = __builtin_fmaxf(mx.y, __builtin_fabsf(v.y)); mx.z = __builtin_fmaxf(mx.z, __builtin_fabsf(v.z)); mx.w = __builtin_fmaxf(mx.w, __builtin_fabsf(v.w)); }
    __hip_atomic_fetch_max(cm + c0 + 0, __builtin_bit_cast(unsigned, mx.x), RLX_AGENT); __hip_atomic_fetch_max(cm + c0 + 1, __builtin_bit_cast(unsigned, mx.y), RLX_AGENT);
    __hip_atomic_fetch_max(cm + c0 + 2, __builtin_bit_cast(unsigned, mx.z), RLX_AGENT); __hip_atomic_fetch_max(cm + c0 + 3, __builtin_bit_cast(unsigned, mx.w), RLX_AGENT);
}
DI unsigned q8x4(float a, float b, float c, float d, float inv) { unsigned w = 0u;
    w = __builtin_amdgcn_cvt_pk_u8_f32(__builtin_rintf(__builtin_fmaf(a, inv, 128.f)), 0, w); w = __builtin_amdgcn_cvt_pk_u8_f32(__builtin_rintf(__builtin_fmaf(b, inv, 128.f)), 1, w);
    w = __builtin_amdgcn_cvt_pk_u8_f32(__builtin_rintf(__builtin_fmaf(c, inv, 128.f)), 2, w); w = __builtin_amdgcn_cvt_pk_u8_f32(__builtin_rintf(__builtin_fmaf(d, inv, 128.f)), 3, w); return w ^ 0x80808080u; }
DI unsigned q8(float v) { const float r = __builtin_rintf(v); const int i = (int)__builtin_fminf(__builtin_fmaxf(r, -127.f), 127.f); return (unsigned)i & 0xffu; }
DI void tr_item8(const float* __restrict__ src, const float* __restrict__ gain, const float* __restrict__ cm, unsigned char* __restrict__ dst, int K, int N, int mode, int lim, int item, LAS float* scr, int lane) {
    const int nblk = N >> 5, kb = item / nblk, nb = item - kb * nblk, k0 = kb << 6, n0 = nb << 5, s0 = map_col(mode, lim, n0);
    const int kr = lane >> 3, c4 = lane & 7;
    f32x4 v[8]; float g[8];
#pragma unroll
    for (int it = 0; it < 8; ++it) { v[it] = *(const GAS f32x4*)(src + (size_t)(k0 + 8 * it + kr) * N + s0 + 4 * c4); g[it] = gain ? gain[k0 + 8 * it + kr] : 1.0f; }
#pragma unroll
    for (int it = 0; it < 8; ++it) { LAS float* p = scr + (8 * it + kr) * 33 + 4 * c4; p[0] = v[it].x * g[it]; p[1] = v[it].y * g[it]; p[2] = v[it].z * g[it]; p[3] = v[it].w * g[it]; }
    LDS_WAIT(); asm volatile("" ::: "memory");
#pragma unroll
    for (int j = 0; j < 4; ++j) { const int n = kr + 8 * j; const LAS float* s = scr + (8 * c4) * 33 + n;
        const float cmx = cm[s0 + n], inv = cmx > 0.f ? 127.0f / cmx : 0.f;
        v2u o; o.x = q8x4(s[0 * 33], s[1 * 33], s[2 * 33], s[3 * 33], inv);
        o.y = q8x4(s[4 * 33], s[5 * 33], s[6 * 33], s[7 * 33], inv);
        const int nn = n0 + n, kk = k0 + 8 * c4;
        *(GAS v2u*)(dst + (size_t)(nn >> 8) * ((size_t)256 * K) + (size_t)(kk >> 7) * (256 * 128) + (size_t)(nn & 255) * 128 + (kk & 127)) = o; }
    LDS_WAIT(); asm volatile("" ::: "memory");
}
DI void strip_quant8(Frame& F, const float* __restrict__ src, const float* __restrict__ gain, float* __restrict__ cm, unsigned char* __restrict__ dst, int K, int N, int mode, int lim, int strip, LAS float* scr, LAS unsigned* cml) {
    const int n0 = strip << 5, s0 = map_col(mode, lim, n0), lane = F.lane, kr = lane >> 3, c4 = lane & 7, nkb = K >> 6;
    if (F.tid < 32) cml[F.tid] = 0u;
    __syncthreads();
    f32x4 mx = {0.f, 0.f, 0.f, 0.f};
#pragma unroll 1
    for (int kb = F.wave; kb < nkb; kb += NWAVES) {
#pragma unroll
        for (int it = 0; it < 8; ++it) { const int k = (kb << 6) + 8 * it + kr; const f32x4 v = *(const GAS f32x4*)(src + (size_t)k * N + s0 + 4 * c4) * (gain ? gain[k] : 1.0f);
            mx.x = __builtin_fmaxf(mx.x, __builtin_fabsf(v.x)); mx.y = __builtin_fmaxf(mx.y, __builtin_fabsf(v.y)); mx.z = __builtin_fmaxf(mx.z, __builtin_fabsf(v.z)); mx.w = __builtin_fmaxf(mx.w, __builtin_fabsf(v.w)); } }
#pragma unroll
    for (int o = 8; o < 64; o <<= 1) { mx.x = __builtin_fmaxf(mx.x, __shfl_xor(mx.x, o)); mx.y = __builtin_fmaxf(mx.y, __shfl_xor(mx.y, o)); mx.z = __builtin_fmaxf(mx.z, __shfl_xor(mx.z, o)); mx.w = __builtin_fmaxf(mx.w, __shfl_xor(mx.w, o)); }
    if (lane < 8) { __hip_atomic_fetch_max(cml + 4 * lane + 0, __builtin_bit_cast(unsigned, mx.x), __ATOMIC_RELAXED, __HIP_MEMORY_SCOPE_WORKGROUP); __hip_atomic_fetch_max(cml + 4 * lane + 1, __builtin_bit_cast(unsigned, mx.y), __ATOMIC_RELAXED, __HIP_MEMORY_SCOPE_WORKGROUP);
                    __hip_atomic_fetch_max(cml + 4 * lane + 2, __builtin_bit_cast(unsigned, mx.z), __ATOMIC_RELAXED, __HIP_MEMORY_SCOPE_WORKGROUP); __hip_atomic_fetch_max(cml + 4 * lane + 3, __builtin_bit_cast(unsigned, mx.w), __ATOMIC_RELAXED, __HIP_MEMORY_SCOPE_WORKGROUP); }
    __syncthreads();
#pragma unroll 1
    for (int kb = F.wave; kb < nkb; kb += NWAVES) { const int k0 = kb << 6;
        f32x4 v[8]; float g[8];
#pragma unroll
        for (int it = 0; it < 8; ++it) { v[it] = *(const GAS f32x4*)(src + (size_t)(k0 + 8 * it + kr) * N + s0 + 4 * c4); g[it] = gain ? gain[k0 + 8 * it + kr] : 1.0f; }
#pragma unroll
        for (int it = 0; it < 8; ++it) { LAS float* p = scr + (8 * it + kr) * 33 + 4 * c4; p[0] = v[it].x * g[it]; p[1] = v[it].y * g[it]; p[2] = v[it].z * g[it]; p[3] = v[it].w * g[it]; }
        LDS_WAIT(); asm volatile("" ::: "memory");
#pragma unroll
        for (int j = 0; j < 4; ++j) { const int n = kr + 8 * j; const LAS float* s = scr + (8 * c4) * 33 + n;
            const float cmx = __builtin_bit_cast(float, cml[n]), inv = cmx > 0.f ? 127.0f / cmx : 0.f;
            v2u o; o.x = q8x4(s[0 * 33], s[1 * 33], s[2 * 33], s[3 * 33], inv);
            o.y = q8x4(s[4 * 33], s[5 * 33], s[6 * 33], s[7 * 33], inv);
            const int nn = n0 + n, kk = k0 + 8 * c4;
            *(GAS v2u*)(dst + (size_t)(nn >> 8) * ((size_t)256 * K) + (size_t)(kk >> 7) * (256 * 128) + (size_t)(nn & 255) * 128 + (kk & 127)) = o; }
        LDS_WAIT(); asm volatile("" ::: "memory"); }
    if (F.tid < 32) cm[s0 + F.tid] = __builtin_bit_cast(float, cml[F.tid]);
    __syncthreads();
}
#ifndef HAD_ON
#define HAD_ON 1
#endif
#ifndef ACT8_TILED
#define ACT8_TILED 0
#endif
DI void fwht_inlane8(float (&v)[8]) {
#pragma unroll
    for (int b = 1; b < 8; b <<= 1)
#pragma unroll
        for (int i = 0; i < 8; ++i) if (!(i & b)) { const float lo = v[i], hi = v[i | b]; v[i] = lo + hi; v[i | b] = lo - hi; }
}
template <int CTRL> DI float dpp_f(float v) { return __builtin_bit_cast(float, __builtin_amdgcn_update_dpp(0, __builtin_bit_cast(int, v), CTRL, 0xf, 0xf, false)); }
DI float swz_xor4(float v) { return __builtin_bit_cast(float, __builtin_amdgcn_ds_swizzle(__builtin_bit_cast(int, v), 0x101f)); }
constexpr int AQ_NIT = 11;
DI void aq_load(const bf16* act, int m, int sub, int lane, v4u (&t)[AQ_NIT]) {
    const bf16* row = act + (size_t)m * DFF + sub * (AQ_NIT * 512) + lane * 8;
#pragma unroll
    for (int it = 0; it < AQ_NIT; ++it) { t[it] = v4u{0u, 0u, 0u, 0u}; if (sub * (AQ_NIT * 512) + it * 512 + lane * 8 < DFF) t[it] = *(const GAS v4u*)(row + it * 512); }
}
DI void act_quant_phase(Frame& F, const bf16* act, unsigned char* aq, float* sact) {
    const int lane = F.lane, pair = F.wave >> 1, sub = F.wave & 1, step = F.G * (NWAVES / 2);
    LAS float* const smx = (LAS float*)(F.lds + RING_BYTES);
    const float s1 = (lane & 1) ? -1.f : 1.f, s2 = (lane & 2) ? -1.f : 1.f, s4 = (lane & 4) ? -1.f : 1.f;
    int par = 0;
    v4u t[AQ_NIT];
    { const int m = F.vcu * (NWAVES / 2) + pair; aq_load(act, m < M ? m : 0, sub, lane, t); }
#pragma unroll 1
    for (int m0 = F.vcu * (NWAVES / 2); m0 < M; m0 += step, par ^= 8) {
        const int m = m0 + pair; const bool rowok = m < M;
        float r[AQ_NIT][8]; float mx = 0.f;
#pragma unroll
        for (int it = 0; it < AQ_NIT; ++it) {
            float v[8] = {bf2f(t[it].x & 0xffffu), __builtin_bit_cast(float, t[it].x & 0xffff0000u), bf2f(t[it].y & 0xffffu), __builtin_bit_cast(float, t[it].y & 0xffff0000u),
                          bf2f(t[it].z & 0xffffu), __builtin_bit_cast(float, t[it].z & 0xffff0000u), bf2f(t[it].w & 0xffffu), __builtin_bit_cast(float, t[it].w & 0xffff0000u)};
            if (HAD_ON) { fwht_inlane8(v);
#pragma unroll
                for (int i = 0; i < 8; ++i) v[i] = __builtin_fmaf(v[i], s1, dpp_f<0xB1>(v[i]));
#pragma unroll
                for (int i = 0; i < 8; ++i) v[i] = __builtin_fmaf(v[i], s2, dpp_f<0x4E>(v[i]));
#pragma unroll
                for (int i = 0; i < 8; ++i) v[i] = __builtin_fmaf(v[i], s4, swz_xor4(v[i])); }
#pragma unroll
            for (int i = 0; i < 8; ++i) { mx = __builtin_fmaxf(mx, __builtin_fabsf(v[i])); r[it][i] = v[i]; } }
        { const int mn = m + step; aq_load(act, mn < M ? mn : 0, sub, lane, t); }
#pragma unroll
        for (int s = 1; s < 64; s <<= 1) mx = __builtin_fmaxf(mx, __shfl_xor(mx, s));
        if (lane == 0) smx[par + F.wave] = mx;
        __syncthreads();
        mx = __builtin_fmaxf(smx[par + 2 * pair], smx[par + 2 * pair + 1]);
        const float inv = mx > 0.f ? 127.0f / mx : 0.f;
#pragma unroll
        for (int it = 0; it < AQ_NIT; ++it) { const int e0 = sub * (AQ_NIT * 512) + it * 512 + lane * 8;
            v2u w = {0u, 0u};
#pragma unroll
            for (int i = 0; i < 4; ++i) { w.x = __builtin_amdgcn_cvt_pk_u8_f32(__builtin_rintf(__builtin_fmaf(r[it][i], inv, 128.f)), i, w.x);
                                          w.y = __builtin_amdgcn_cvt_pk_u8_f32(__builtin_rintf(__builtin_fmaf(r[it][4 + i], inv, 128.f)), i, w.y); }
            w.x ^= 0x80808080u; w.y ^= 0x80808080u;
            if (rowok && e0 < DFF) *(GAS v2u*)(aq + (ACT8_TILED ? (size_t)(m >> 8) * ((size_t)256 * DFF) + (size_t)(e0 >> 7) * (256 * 128) + (size_t)(m & 255) * 128 + (e0 & 127) : (size_t)m * DFF + e0)) = w; }
        if (rowok && sub == 0 && lane == 0) sact[m] = mx * (HAD_ON ? 0.125f / 127.0f : 1.0f / 127.0f);
    }
    __syncthreads();
}
DI void rot_tile_col(const LAS float* scr, int lane, float (&v)[32]) {
    const int n = lane & 31, half = lane >> 5;
#pragma unroll
    for (int i = 0; i < 32; ++i) v[i] = scr[(32 * half + i) * 33 + n];
    if (HAD_ON) {
#pragma unroll
        for (int b = 1; b < 32; b <<= 1)
#pragma unroll
            for (int i = 0; i < 32; ++i) if (!(i & b)) { const float lo = v[i], hi = v[i | b]; v[i] = lo + hi; v[i | b] = lo - hi; }
#pragma unroll
        for (int i = 0; i < 32; ++i) { const float p = __shfl_xor(v[i], 32); v[i] = (half ? p - v[i] : v[i] + p) * 0.125f; } }
}
DI void strip_quant8_rot(Frame& F, const float* __restrict__ src, float* __restrict__ cm, unsigned char* __restrict__ dst, int K, int N, int strip, LAS float* scr, LAS unsigned* cml) {
    const int n0 = strip << 5, lane = F.lane, kr = lane >> 3, c4 = lane & 7, nkb = K >> 6, n = lane & 31, half = lane >> 5;
    if (F.tid < 32) cml[F.tid] = 0u;
    __syncthreads();
    float mxc = 0.f;
#pragma unroll 1
    for (int pass = 0; pass < 2; ++pass) {
        float inv = 0.f; if (pass) { const float cmx = __builtin_bit_cast(float, cml[n]); inv = cmx > 0.f ? 127.0f / cmx : 0.f; }
#pragma unroll 1
        for (int kb = F.wave; kb < nkb; kb += NWAVES) { const int k0 = kb << 6;
            f32x4 t[8];
#pragma unroll
            for (int it = 0; it < 8; ++it) t[it] = *(const GAS f32x4*)(src + (size_t)(k0 + 8 * it + kr) * N + n0 + 4 * c4);
#pragma unroll
            for (int it = 0; it < 8; ++it) { LAS float* p = scr + (8 * it + kr) * 33 + 4 * c4; p[0] = t[it].x; p[1] = t[it].y; p[2] = t[it].z; p[3] = t[it].w; }
            LDS_WAIT(); asm volatile("" ::: "memory");
            float v[32]; rot_tile_col(scr, lane, v);
            if (!pass) {
#pragma unroll
                for (int i = 0; i < 32; ++i) mxc = __builtin_fmaxf(mxc, __builtin_fabsf(v[i])); }
            else { v4u o[2];
#pragma unroll
                for (int h = 0; h < 2; ++h)
#pragma unroll
                    for (int c = 0; c < 4; ++c) { const int i = 16 * h + 4 * c; o[h][c] = q8x4(v[i], v[i + 1], v[i + 2], v[i + 3], inv); }
                const int nn = n0 + n, kk = k0 + 32 * half;
                unsigned char* p = dst + (size_t)(nn >> 8) * ((size_t)256 * K) + (size_t)(kk >> 7) * (256 * 128) + (size_t)(nn & 255) * 128 + (kk & 127);
                *(GAS v4u*)p = o[0]; *(GAS v4u*)(p + 16) = o[1]; }
            LDS_WAIT(); asm volatile("" ::: "memory"); }
        if (!pass) { mxc = __builtin_fmaxf(mxc, __shfl_xor(mxc, 32)); if (half == 0) __hip_atomic_fetch_max(cml + n, __builtin_bit_cast(unsigned, mxc), __ATOMIC_RELAXED, __HIP_MEMORY_SCOPE_WORKGROUP); __syncthreads(); }
    }
    if (F.tid < 32) cm[n0 + F.tid] = __builtin_bit_cast(float, cml[F.tid]);
    __syncthreads();
}
DI void sq16_load(const float* __restrict__ src, const float* __restrict__ gain, int N, int s0, int kb, int lane, f32x4 (&r)[4], float (&g)[4]) {
#pragma unroll
    for (int it = 0; it < 4; ++it) { const int k = (kb << 6) + 16 * it + (lane >> 2); r[it] = *(const GAS f32x4*)(src + (size_t)k * N + s0 + 4 * (lane & 3)); g[it] = gain ? gain[k] : 1.0f; }
}
DI void strip16_quant8(Frame& F, const float* __restrict__ src, const float* __restrict__ gain, float* __restrict__ cm, unsigned char* __restrict__ dst, int N, int mode, int lim, int strip, LAS float* scr, LAS unsigned* cml) {
    constexpr int K = DM, KPW = (K / 64) / NWAVES;
    const int n0 = strip << 4, s0 = map_col(mode, lim, n0), lane = F.lane, n = lane & 15, kq = lane >> 4;
    float v[KPW][16]; float mx = 0.f;
    f32x4 r[4]; float g[4]; sq16_load(src, gain, N, s0, F.wave, lane, r, g);
#pragma unroll
    for (int b = 0; b < KPW; ++b) {
#pragma unroll
        for (int it = 0; it < 4; ++it) { LAS float* p = scr + (16 * it + (lane >> 2)) * 17 + 4 * (lane & 3); p[0] = r[it].x * g[it]; p[1] = r[it].y * g[it]; p[2] = r[it].z * g[it]; p[3] = r[it].w * g[it]; }
        if (b + 1 < KPW) sq16_load(src, gain, N, s0, F.wave + NWAVES * (b + 1), lane, r, g);
        LDS_WAIT(); asm volatile("" ::: "memory");
#pragma unroll
        for (int i = 0; i < 16; ++i) { v[b][i] = scr[(16 * kq + i) * 17 + n]; mx = __builtin_fmaxf(mx, __builtin_fabsf(v[b][i])); }
        LDS_WAIT(); asm volatile("" ::: "memory"); }
    mx = __builtin_fmaxf(mx, __shfl_xor(mx, 16)); mx = __builtin_fmaxf(mx, __shfl_xor(mx, 32));
    if (lane < 16) __hip_atomic_fetch_max(cml + lane, __builtin_bit_cast(unsigned, mx), __ATOMIC_RELAXED, __HIP_MEMORY_SCOPE_WORKGROUP);
    __syncthreads();
    const float cmx = __builtin_bit_cast(float, cml[n]), inv = cmx > 0.f ? 127.0f / cmx : 0.f;
    const int nn = n0 + n;
    unsigned char* const drow = dst + (size_t)(nn >> 8) * ((size_t)256 * K) + (size_t)(nn & 255) * 128;
#pragma unroll
    for (int b = 0; b < KPW; ++b) { const int kk = ((F.wave + NWAVES * b) << 6) + 16 * kq; v4u o;
#pragma unroll
        for (int c = 0; c < 4; ++c) o[c] = q8x4(v[b][4 * c], v[b][4 * c + 1], v[b][4 * c + 2], v[b][4 * c + 3], inv);
        *(GAS v4u*)(drow + (size_t)(kk >> 7) * (256 * 128) + (kk & 127)) = o; }
    if (F.tid < 16) cm[s0 + F.tid] = cmx;
}
template <int DROP> DI void norm_rows8(Frame& F, const float* x, unsigned char* xq, float* sA, bf16* xb) {
    const int gw = F.vcu * NWAVES + F.wave, NGW = F.G * NWAVES;
    for (int m = gw; m < M; m += NGW) {
        const GAS f32x4* xr = (const GAS f32x4*)(x + (size_t)m * DM) + 4 * F.lane;
        f32x4 v[16]; float s = 0.f, mx = 0.f;
#pragma unroll
        for (int j = 0; j < 4; ++j)
#pragma unroll
            for (int i = 0; i < 4; ++i) { const f32x4 t = xr[256 * j + i]; v[4 * j + i] = t; s += (t.x * t.x + t.y * t.y) + (t.z * t.z + t.w * t.w);
                mx = __builtin_fmaxf(mx, __builtin_fmaxf(__builtin_fmaxf(__builtin_fabsf(t.x), __builtin_fabsf(t.y)), __builtin_fmaxf(__builtin_fabsf(t.z), __builtin_fabsf(t.w)))); }
        const float r = 1.0f / sqrtf(wave_sum(s) * (1.0f / DM) + RMS_EPS);
#pragma unroll
        for (int o = 1; o < 64; o <<= 1) mx = __builtin_fmaxf(mx, __shfl_xor(mx, o));
        const float inv = mx > 0.f ? 127.0f / mx : 0.f;
#pragma unroll
        for (int j = 0; j < 4; ++j) { v4u w;
#pragma unroll
            for (int i = 0; i < 4; ++i) { const f32x4 t = v[4 * j + i]; w[i] = q8x4(t.x, t.y, t.z, t.w, inv); }
            *(GAS v4u*)(xq + (size_t)m * DM + 1024 * j + 16 * F.lane) = w;
            if (xb) {
#pragma unroll
                for (int h = 0; h < 2; ++h) { const f32x4 a = v[4 * j + 2 * h] * r, b = v[4 * j + 2 * h + 1] * r; v4u y;
                    if (DROP > 0) { y.x = f2bf_drop<DROP>(a.x) | (f2bf_drop<DROP>(a.y) << 16); y.y = f2bf_drop<DROP>(a.z) | (f2bf_drop<DROP>(a.w) << 16); y.z = f2bf_drop<DROP>(b.x) | (f2bf_drop<DROP>(b.y) << 16); y.w = f2bf_drop<DROP>(b.z) | (f2bf_drop<DROP>(b.w) << 16); }
                    else { y.x = pk2(a.x, a.y); y.y = pk2(a.z, a.w); y.z = pk2(b.x, b.y); y.w = pk2(b.z, b.w); }
                    *(GAS v4u*)(xb + (size_t)m * DM + 1024 * j + 16 * F.lane + 8 * h) = y; } } }
        if (F.lane == 0) sA[m] = mx * r * (1.0f / 127.0f);
    }
}
DI void quant_rows_bf16(Frame& F, const bf16* o, unsigned char* oq, float* sO) {
    const int gw = F.vcu * NWAVES + F.wave, NGW = F.G * NWAVES;
    for (int m = gw; m < M; m += NGW) {
        const GAS v4u* orow = (const GAS v4u*)(o + (size_t)m * DM) + 2 * F.lane;
        v4u v[8]; float mx = 0.f;
#pragma unroll
        for (int j = 0; j < 4; ++j)
#pragma unroll
            for (int h = 0; h < 2; ++h) { const v4u t = orow[128 * j + h]; v[2 * j + h] = t;
#pragma unroll
                for (int c = 0; c < 4; ++c) mx = __builtin_fmaxf(mx, __builtin_fmaxf(__builtin_fabsf(bf2f(t[c] & 0xffffu)), __builtin_fabsf(bf2f(t[c] >> 16)))); }
#pragma unroll
        for (int s = 1; s < 64; s <<= 1) mx = __builtin_fmaxf(mx, __shfl_xor(mx, s));
        const float inv = mx > 0.f ? 127.0f / mx : 0.f;
#pragma unroll
        for (int j = 0; j < 4; ++j) { v4u w;
#pragma unroll
            for (int h = 0; h < 2; ++h) { const v4u t = v[2 * j + h];
                w[2 * h] = q8x4(bf2f(t[0] & 0xffffu), bf2f(t[0] >> 16), bf2f(t[1] & 0xffffu), bf2f(t[1] >> 16), inv);
                w[2 * h + 1] = q8x4(bf2f(t[2] & 0xffffu), bf2f(t[2] >> 16), bf2f(t[3] & 0xffffu), bf2f(t[3] >> 16), inv); }
            *(GAS v4u*)(oq + (size_t)m * DM + 1024 * j + 16 * F.lane) = w; }
        if (F.lane == 0) sO[m] = mx * (1.0f / 127.0f);
    }
}
DI void norm_rows8_b(Frame& F, const bf16* x, unsigned char* xq, float* sA) {
    const int gw = F.vcu * NWAVES + F.wave, NGW = F.G * NWAVES;
    for (int m = gw; m < M; m += NGW) {
        const GAS v4u* xr = (const GAS v4u*)(x + (size_t)m * DM) + 2 * F.lane;
        v4u t[8]; float s = 0.f, mx = 0.f;
#pragma unroll
        for (int j = 0; j < 4; ++j) { t[2 * j] = xr[128 * j]; t[2 * j + 1] = xr[128 * j + 1]; }
#pragma unroll
        for (int j = 0; j < 8; ++j)
#pragma unroll
            for (int i = 0; i < 4; ++i) { const float a = __builtin_bit_cast(float, t[j][i] << 16), b = __builtin_bit_cast(float, t[j][i] & 0xffff0000u); s += a * a + b * b; mx = __builtin_fmaxf(mx, __builtin_fmaxf(__builtin_fabsf(a), __builtin_fabsf(b))); }
        const float r = 1.0f / sqrtf(wave_sum(s) * (1.0f / DM) + RMS_EPS);
#pragma unroll
        for (int o = 1; o < 64; o <<= 1) mx = __builtin_fmaxf(mx, __shfl_xor(mx, o));
        const float inv = mx > 0.f ? 127.0f / mx : 0.f;
#pragma unroll
        for (int j = 0; j < 4; ++j) { v4u w;
#pragma unroll
            for (int i = 0; i < 4; ++i) { const unsigned w0 = t[2 * j + (i >> 1)][2 * (i & 1)], w1 = t[2 * j + (i >> 1)][2 * (i & 1) + 1];
                w[i] = q8x4(__builtin_bit_cast(float, w0 << 16), __builtin_bit_cast(float, w0 & 0xffff0000u), __builtin_bit_cast(float, w1 << 16), __builtin_bit_cast(float, w1 & 0xffff0000u), inv); }
            *(GAS v4u*)(xq + (size_t)m * DM + 1024 * j + 16 * F.lane) = w; }
        if (F.lane == 0) sA[m] = mx * r * (1.0f / 127.0f);
    }
}
DI void final_norm_rows_b(Frame& F, const bf16* x, float* out, const float* gain, bool poison) {
    const int gw = F.vcu * NWAVES + F.wave, NGW = F.G * NWAVES;
    for (int m = gw; m < M; m += NGW) {
        const GAS v4u* xr = (const GAS v4u*)(x + (size_t)m * DM) + F.lane; GAS f32x4* orow = (GAS f32x4*)(out + (size_t)m * DM) + 2 * F.lane; const GAS f32x4* gr = (const GAS f32x4*)gain + 2 * F.lane;
        v4u t[8]; float s = 0.f;
#pragma unroll
        for (int j = 0; j < 8; ++j) t[j] = xr[64 * j];
#pragma unroll
        for (int j = 0; j < 8; ++j)
#pragma unroll
            for (int i = 0; i < 4; ++i) { const float a = __builtin_bit_cast(float, t[j][i] << 16), b = __builtin_bit_cast(float, t[j][i] & 0xffff0000u); s += a * a + b * b; }
        float r = 1.0f / sqrtf(wave_sum(s) * (1.0f / DM) + RMS_EPS); if (poison) r = __builtin_nanf("");
#pragma unroll
        for (int j = 0; j < 8; ++j) { f32x4 a, b;
            a.x = __builtin_bit_cast(float, t[j].x << 16); a.y = __builtin_bit_cast(float, t[j].x & 0xffff0000u); a.z = __builtin_bit_cast(float, t[j].y << 16); a.w = __builtin_bit_cast(float, t[j].y & 0xffff0000u);
            b.x = __builtin_bit_cast(float, t[j].z << 16); b.y = __builtin_bit_cast(float, t[j].z & 0xffff0000u); b.z = __builtin_bit_cast(float, t[j].w << 16); b.w = __builtin_bit_cast(float, t[j].w & 0xffff0000u);
            orow[128 * j] = a * r * gr[128 * j]; orow[128 * j + 1] = b * r * gr[128 * j + 1]; }
    }
}
DI void final_norm_rows(Frame& F, float* x, const float* gain, bool poison) {
    const int gw = F.vcu * NWAVES + F.wave, NGW = F.G * NWAVES;
    for (int m = gw; m < M; m += NGW) {
        GAS f32x4* xr = (GAS f32x4*)(x + (size_t)m * DM) + F.lane; const GAS f32x4* gr = (const GAS f32x4*)gain + F.lane;
        f32x4 v[16]; float s = 0.f;
#pragma unroll
        for (int j = 0; j < 16; ++j) { v[j] = xr[64 * j]; s += (v[j].x * v[j].x + v[j].y * v[j].y) + (v[j].z * v[j].z + v[j].w * v[j].w); }
        float r = 1.0f / sqrtf(wave_sum(s) * (1.0f / DM) + RMS_EPS); if (poison) r = __builtin_nanf("");
#pragma unroll
        for (int j = 0; j < 16; ++j) xr[64 * j] = v[j] * r * gr[64 * j];
    }
}
DI void kmean_phase(Frame& F) {
    const bf16* Kb = (const bf16*)(F.ws + WS_K); bf16* kh = (bf16*)(F.ws + WS_KMEAN); bf16* kl = kh + 8 * 64 * 128;
    LAS float* red = (LAS float*)(F.lds + RING_OFF);
    const int c = F.tid & 15, rg = F.tid >> 4;
    for (int it = F.vcu; it < 8 * NBLK; it += F.G) {
        const int kvh = it >> 6, n = it & 63; float a[8];
#pragma unroll
        for (int e = 0; e < 8; ++e) a[e] = 0.f;
#pragma unroll
        for (int r = 0; r < 8; ++r) { const v4u w = *(const GAS v4u*)(Kb + (size_t)(n * 256 + rg + 32 * r) * A_KVW + kvh * 128 + c * 8);
            a[0] += bf2f(w.x & 0xffffu); a[1] += bf2f(w.x >> 16); a[2] += bf2f(w.y & 0xffffu); a[3] += bf2f(w.y >> 16); a[4] += bf2f(w.z & 0xffffu); a[5] += bf2f(w.z >> 16); a[6] += bf2f(w.w & 0xffffu); a[7] += bf2f(w.w >> 16); }
#pragma unroll
        for (int e = 0; e < 8; ++e) red[rg * 128 + c * 8 + e] = a[e];
        __syncthreads();
        if (F.tid < 128) { float s = 0.f;
#pragma unroll 8
            for (int g = 0; g < 32; ++g) s += red[g * 128 + F.tid];
            s *= (1.0f / 256.0f); const unsigned h = f2bf(s); const float l = s - bf2f(h);
            kh[(size_t)it * 128 + F.tid] = (bf16)h; kl[(size_t)it * 128 + F.tid] = (bf16)f2bf(l); }
        __syncthreads();
    }
}
namespace att {
template <int D> struct TL { static constexpr int PITCH = D * 2 + 16, BYTES = 64 * PITCH, NCH = D / 8, NLD = (64 * NCH) / 512; };
DI int crow(int reg, int h) { return (reg & 3) + 8 * (reg >> 2) + 4 * h; }
typedef float f32x2_t __attribute__((ext_vector_type(2))); typedef __bf16 bf16x2_t __attribute__((ext_vector_type(2)));
DI unsigned cvtpk(float lo, float hi) { f32x2_t v = {lo, hi}; bf16x2_t b = __builtin_convertvector(v, bf16x2_t); return __builtin_bit_cast(unsigned, b); }
typedef short v4i16_t __attribute__((ext_vector_type(4)));
DI s16x4 vtr(const LAS unsigned char* p) { return __builtin_bit_cast(s16x4, __builtin_amdgcn_ds_read_tr16_b64_v4i16((LAS v4i16_t*)p)); }
#define MFMA32(a, b, c) __builtin_amdgcn_mfma_f32_32x32x16_bf16((a), (b), (c), 0, 0, 0)

template <int D, int NL = TL<D>::NLD> DI void tile_load(v4u (&r)[NL], const bf16* g, int pitch, int tid) {
#pragma unroll
    for (int i = 0; i < NL; ++i) { const int c = tid + 512 * i, row = c / TL<D>::NCH, ch = c % TL<D>::NCH; r[i] = *(const GAS v4u*)(g + (size_t)row * pitch + ch * 8); }
}
template <int D, int NL = TL<D>::NLD> DI void tile_store(LAS unsigned char* t, const v4u (&r)[NL], int tid) {
#pragma unroll
    for (int i = 0; i < NL; ++i) { const int c = tid + 512 * i, row = c / TL<D>::NCH, ch = c % TL<D>::NCH; *(LAS v4u*)(t + row * TL<D>::PITCH + ch * 16) = r[i]; }
}
template <int D, bool INIT = true> DI void qk(f32x16& p0, f32x16& p1, const LAS unsigned char* kt, const bf16x8 (&qf)[D / 16], int r32, int hi) {
    const LAS unsigned char* a = kt + r32 * TL<D>::PITCH + hi * 16;
    if (INIT) {
#pragma unroll
        for (int i = 0; i < 16; ++i) { p0[i] = 0.f; p1[i] = 0.f; } }
#pragma unroll
    for (int s = 0; s < D / 16; ++s) { const bf16x8 a0 = *(const LAS bf16x8*)(a + s * 32), a1 = *(const LAS bf16x8*)(a + 32 * TL<D>::PITCH + s * 32);
        p0 = MFMA32(a0, qf[s], p0); p1 = MFMA32(a1, qf[s], p1); if ((s & 3) == 3) __builtin_amdgcn_sched_barrier(0); }
}
DI bf16x8 pack8(const f32x16& x, int s) {
    v4u p; p.x = cvtpk(x[8 * s], x[8 * s + 1]); p.y = cvtpk(x[8 * s + 2], x[8 * s + 3]); p.z = cvtpk(x[8 * s + 4], x[8 * s + 5]); p.w = cvtpk(x[8 * s + 6], x[8 * s + 7]);
    return __builtin_bit_cast(bf16x8, p);
}
template <int D> DI void pv(f32x16 (&o)[D / 32], const LAS unsigned char* vt, const f32x16& p0, const f32x16& p1, int lane, int hi) {
    bf16x8 pf[4]; pf[0] = pack8(p0, 0); pf[1] = pack8(p0, 1); pf[2] = pack8(p1, 0); pf[3] = pack8(p1, 1);
    const LAS unsigned char* vb = vt + (4 * hi + ((lane & 15) >> 2)) * TL<D>::PITCH + ((lane >> 4) & 1) * 32 + (lane & 3) * 8;
#pragma unroll
    for (int db = 0; db < D / 32; ++db)
#pragma unroll
        for (int ks = 0; ks < 4; ++ks) { const s16x4 lo = vtr(vb + (16 * ks) * TL<D>::PITCH + db * 64), hh = vtr(vb + (16 * ks + 8) * TL<D>::PITCH + db * 64);
            const bf16x8 va = (bf16x8){lo[0], lo[1], lo[2], lo[3], hh[0], hh[1], hh[2], hh[3]};
            o[db] = MFMA32(va, pf[ks], o[db]); if (ks == 3) __builtin_amdgcn_sched_barrier(0); }
}
template <int D> DI void softmax_update(f32x16& p0, f32x16& p1, float& m, float& l, f32x16 (&o)[D / 32]) {
    float mx = __builtin_fmaxf(p0[0], p1[0]);
#pragma unroll
    for (int i = 1; i < 16; ++i) mx = __builtin_fmaxf(mx, __builtin_fmaxf(p0[i], p1[i]));
    mx = __builtin_fmaxf(mx, __shfl_xor(mx, 32));
    const float mn = __builtin_fmaxf(m, mx), al = __builtin_amdgcn_exp2f(m - mn);
    float s = 0.f;
#pragma unroll
    for (int i = 0; i < 16; ++i) { p0[i] = __builtin_amdgcn_exp2f(p0[i] - mn); p1[i] = __builtin_amdgcn_exp2f(p1[i] - mn); s += p0[i] + p1[i]; }
    l = l * al + s; m = mn;
#pragma unroll
    for (int db = 0; db < D / 32; ++db)
#pragma unroll
        for (int i = 0; i < 16; ++i) o[db][i] *= al;
}
template <int D> DI void store_rows16(bf16* orow, const f32x16 (&o)[D / 32], float inv, int hi, bool valid) {
#pragma unroll
    for (int db = 0; db < D / 32; ++db)
#pragma unroll
        for (int gp = 0; gp < 2; ++gp) { const int ge = 8 * gp, go = 8 * gp + 4;
            const unsigned ex = cvtpk(o[db][ge] * inv, o[db][ge + 1] * inv), ey = cvtpk(o[db][ge + 2] * inv, o[db][ge + 3] * inv);
            const unsigned ox = cvtpk(o[db][go] * inv, o[db][go + 1] * inv), oy = cvtpk(o[db][go + 2] * inv, o[db][go + 3] * inv);
            const auto sx = __builtin_amdgcn_permlane32_swap(ex, ox, false, false), sy = __builtin_amdgcn_permlane32_swap(ey, oy, false, false);
            v4u w; w.x = sx[0]; w.y = sy[0]; w.z = sx[1]; w.w = sy[1];
            if (valid) *(GAS v4u*)(orow + db * 32 + 16 * gp + 8 * hi) = w; }
}
template <int D> DI void store_o(bf16* orow  , const f32x16 (&o)[D / 32], float l, int hi) {
    const float L = l + __shfl_xor(l, 32), inv = 1.0f / L;
    store_rows16<D>(orow, o, inv, hi, true);
}

constexpr int MOBA_HIST_OFF = 36864, MOBA_SCAN_OFF = 40960;
DI size_t moba_list_off(int kvh, int n) { return (size_t)kvh * 2064384 + (size_t)1024 * (63 * n - (n * (n - 1)) / 2); }
template <int D> DI void store_part(bf16* po  , float* pml, const f32x16 (&o)[D / 32], float m, float l, int hi, bool valid) {
    const float L = l + __shfl_xor(l, 32), inv = 1.0f / L;
    store_rows16<D>(po, o, inv, hi, valid);
    if (valid && hi == 0) { pml[0] = m; pml[1] = L; }
}
DI void moba_own_item(Frame& F, int b, int h) {
    constexpr int D = 128; typedef TL<D> T;
    LAS unsigned char* kt = F.lds + RING_OFF; LAS unsigned char* vt = kt + T::BYTES;
    LAS unsigned* hist = (LAS unsigned*)(F.lds + RING_OFF + MOBA_HIST_OFF); LAS unsigned* bases = hist + 64;
    const int lane = F.lane, r32 = lane & 31, hi = lane >> 5, w = F.wave, kvh = h >> 2, tid = F.tid;
    const bf16* Kb = (const bf16*)(F.ws + WS_K) + kvh * 128; const bf16* Vb = (const bf16*)(F.ws + WS_V) + kvh * 128;
    const bf16* kmh = (const bf16*)(F.ws + WS_KMEAN) + (size_t)kvh * 64 * 128; const bf16* kml = kmh + 8 * 64 * 128;
    const int tok = b * 256 + w * 32 + r32, pair = tok * 32 + h;
    const bf16* qrow = (const bf16*)(F.ws + WS_Q) + (size_t)tok * DM + h * 128;
    bf16x8 qf[8];
#pragma unroll
    for (int s = 0; s < 8; ++s) qf[s] = *(const GAS bf16x8*)(qrow + 16 * s + 8 * hi);
    v4u rk[T::NLD], rv[T::NLD];
    const float NEG = -__builtin_inff();
    if (b > 0) {
        tile_load<D>(rk, kmh, 128, tid); tile_load<D>(rv, kml, 128, tid);
        if (tid < 64) hist[tid] = 0u;
        __syncthreads(); tile_store<D>(kt, rk, tid); tile_store<D>(vt, rv, tid); __syncthreads();
        int nsel[3]; unsigned rnk[3];
        { f32x16 g0, g1; qk<D>(g0, g1, vt, qf, r32, hi); __builtin_amdgcn_sched_barrier(0); qk<D, false>(g0, g1, kt, qf, r32, hi);
#pragma unroll
          for (int i = 0; i < 16; ++i) { const int n0 = crow(i, hi); g0[i] = (n0 < b) ? g0[i] : NEG; g1[i] = (n0 + 32 < b) ? g1[i] : NEG; }
#pragma unroll
          for (int j = 0; j < 3; ++j) { float bv = NEG; int bi = 64;
#pragma unroll
              for (int i = 0; i < 16; ++i) { const int n0 = crow(i, hi); if (g0[i] > bv) { bv = g0[i]; bi = n0; } }
#pragma unroll
              for (int i = 0; i < 16; ++i) { const int n1 = 32 + crow(i, hi); if (g1[i] > bv) { bv = g1[i]; bi = n1; } }
              const float ov = __shfl_xor(bv, 32); const int oi = __shfl_xor(bi, 32);
              if (ov > bv || (ov == bv && oi < bi)) { bv = ov; bi = oi; }
              nsel[j] = (bv > NEG) ? bi : -1;
#pragma unroll
              for (int i = 0; i < 16; ++i) { const int n0 = crow(i, hi); g0[i] = (n0 == bi) ? NEG : g0[i]; g1[i] = (n0 + 32 == bi) ? NEG : g1[i]; } } }
#pragma unroll
        for (int j = 0; j < 3; ++j) { rnk[j] = 0u; if (hi == 0 && nsel[j] >= 0) rnk[j] = __hip_atomic_fetch_add(hist + nsel[j], 1u, __ATOMIC_RELAXED, __HIP_MEMORY_SCOPE_WORKGROUP); }
        __syncthreads();
        if (tid < 64) { const unsigned hc = hist[tid]; unsigned bs = 0u; if (hc) bs = __hip_atomic_fetch_add((unsigned*)(F.ctl + CW_CNT) + kvh * 64 + tid, hc, RLX_AGENT); bases[tid] = bs; }
        __syncthreads();
        unsigned* lst = (unsigned*)(F.ws + WS_LIST);
#pragma unroll
        for (int j = 0; j < 3; ++j) if (hi == 0 && nsel[j] >= 0) lst[moba_list_off(kvh, nsel[j]) + bases[nsel[j]] + rnk[j]] = ((unsigned)pair << 2) | (unsigned)j;
    }
    float m = -1e30f, l = 0.f; f32x16 o[4];
#pragma unroll
    for (int db = 0; db < 4; ++db)
#pragma unroll
        for (int i = 0; i < 16; ++i) o[db][i] = 0.f;
    tile_load<D>(rk, Kb + (size_t)(b * 256) * A_KVW, A_KVW, tid); tile_load<D>(rv, Vb + (size_t)(b * 256) * A_KVW, A_KVW, tid);
    for (int tt = 0; tt < 4; ++tt) {
        __syncthreads();
        tile_store<D>(kt, rk, tid); tile_store<D>(vt, rv, tid);
        __syncthreads();
        if (tt + 1 < 4) { const size_t r0 = (size_t)b * 256 + (tt + 1) * 64; tile_load<D>(rk, Kb + r0 * A_KVW, A_KVW, tid); tile_load<D>(rv, Vb + r0 * A_KVW, A_KVW, tid); }
        if (tt * 64 <= w * 32 + 31) {
            f32x16 p0, p1; qk<D>(p0, p1, kt, qf, r32, hi);
            const int qrel = w * 32 + r32, kb = tt * 64 + 4 * hi;
#pragma unroll
            for (int i = 0; i < 16; ++i) { const int kv = kb + (i & 3) + 8 * (i >> 2); p0[i] = (kv > qrel) ? NEG : p0[i]; p1[i] = (kv + 32 > qrel) ? NEG : p1[i]; }
            softmax_update<D>(p0, p1, m, l, o);
            pv<D>(o, vt, p0, p1, lane, hi);
        }
    }
    store_part<D>((bf16*)(F.ws + WS_PARTO) + ((size_t)pair * 4 + 3) * 128, (float*)(F.ws + WS_PARTML) + ((size_t)pair * 4 + 3) * 2, o, m, l, hi, true);
    __syncthreads();
}
DI void moba_own_phase(Frame& F) {
#pragma unroll 1
    for (int p2 = 2 * F.vcu; p2 < 2 * 32 * A_H; p2 += (p2 & 1) ? 2 * F.G - 1 : 1) { const int p = p2 >> 1, h = p >> 5, bp = p & 31; moba_own_item(F, (p2 & 1) ? bp : 63 - bp, h); }
}
DI void moba_past_phase(Frame& F) {
    constexpr int D = 128; typedef TL<D> T; constexpr int IMG = 256 * T::PITCH;
    LAS unsigned char* kt = F.lds + RING_OFF; LAS unsigned char* vt = kt + IMG;
    LAS int* sc = (LAS int*)(F.lds + RING_OFF + 2 * IMG); LAS int* pc = sc + 512;
    static_assert(2 * IMG + 4096 <= LDSCTL_OFF, "MoBA past phase LDS map");
    const int lane = F.lane, r32 = lane & 31, hi = lane >> 5, w = F.wave, tid = F.tid;
    { int cv = 0; if (tid < 504) cv = (int)__hip_atomic_load((unsigned*)(F.ctl + CW_CNT) + (tid / 63) * 64 + (tid % 63), RLX_AGENT);
      pc[tid] = cv; sc[tid] = (cv + 255) >> 8; __syncthreads();
      for (int off = 1; off < 512; off <<= 1) { const int x = sc[tid] + (tid >= off ? sc[tid - off] : 0); __syncthreads(); sc[tid] = x; __syncthreads(); } }
    const int total = sc[511];
    const unsigned* lst = (const unsigned*)(F.ws + WS_LIST); const bf16* Qg = (const bf16*)(F.ws + WS_Q);
    const int i_lo = (int)(((long)total * F.vcu) / F.G), i_hi = (int)(((long)total * (F.vcu + 1)) / F.G);
#define MOBA_QLOAD(QF, E) do { const int pr_ = (int)((E) >> 2); const bf16* qrow_ = Qg + (size_t)(pr_ >> 5) * DM + (pr_ & 31) * 128; \
        _Pragma("unroll") for (int s_ = 0; s_ < 8; ++s_) QF[s_] = *(const GAS bf16x8*)(qrow_ + 16 * s_ + 8 * hi); } while (0)
    int t = 0;
    if (i_lo < i_hi) { int lo_ = 0, hi_ = 511; while (lo_ < hi_) { const int mid_ = (lo_ + hi_) >> 1; if (sc[mid_] > i_lo) hi_ = mid_; else lo_ = mid_ + 1; } t = __builtin_amdgcn_readfirstlane(lo_); }
    int t_img = -1; bf16x8 qf[8]; unsigned e = 0u; bool valid = false;
#pragma unroll 1
    for (int idx = i_lo; idx < i_hi; ++idx) {
        while (sc[t] <= idx) ++t;
        t = __builtin_amdgcn_readfirstlane(t);
        const int cnt = pc[t], c = idx - (sc[t] - ((cnt + 255) >> 8)), kvh = t / 63, n = t % 63;
        const size_t lbase = moba_list_off(kvh, n);
        if (t != t_img) {
            const bf16* Kb = (const bf16*)(F.ws + WS_K) + kvh * 128 + (size_t)(n * 256) * A_KVW; const bf16* Vb = (const bf16*)(F.ws + WS_V) + kvh * 128 + (size_t)(n * 256) * A_KVW;
            __syncthreads();
            { v4u r8[8]; tile_load<D, 8>(r8, Kb, A_KVW, tid); tile_store<D, 8>(kt, r8, tid); }
            { v4u r8[8]; tile_load<D, 8>(r8, Vb, A_KVW, tid); tile_store<D, 8>(vt, r8, tid); }
            __syncthreads();
            t_img = t;
            const int ir0 = c * 256 + w * 32 + r32; valid = ir0 < cnt; e = lst[lbase + (valid ? ir0 : 0)]; MOBA_QLOAD(qf, e);
        }
        const bool nxt_same = (idx + 1 < i_hi) && (sc[t] > idx + 1);
        unsigned e2 = 0u; bool valid2 = false;
        if (nxt_same) { const int ir2 = (c + 1) * 256 + w * 32 + r32; valid2 = ir2 < cnt; e2 = lst[lbase + (valid2 ? ir2 : 0)]; }
        const bool wact = __any(valid ? 1 : 0) != 0;
        float m = -1e30f, l = 0.f; f32x16 o[4];
#pragma unroll
        for (int db = 0; db < 4; ++db)
#pragma unroll
            for (int i = 0; i < 16; ++i) o[db][i] = 0.f;
        const int pair = (int)(e >> 2), j = (int)(e & 3u);
#pragma unroll 1
        for (int ss = 0; ss < 4; ++ss) {
            f32x16 p0, p1;
            if (wact) qk<D>(p0, p1, kt + ss * 64 * T::PITCH, qf, r32, hi);
            if (ss == 3 && nxt_same) { __builtin_amdgcn_sched_barrier(0); MOBA_QLOAD(qf, e2); }
            if (wact) { softmax_update<D>(p0, p1, m, l, o); pv<D>(o, vt + ss * 64 * T::PITCH, p0, p1, lane, hi); }
        }
        store_part<D>((bf16*)(F.ws + WS_PARTO) + ((size_t)pair * 4 + j) * 128, (float*)(F.ws + WS_PARTML) + ((size_t)pair * 4 + j) * 2, o, m, l, hi, valid);
        e = e2; valid = valid2;
    }
    __syncthreads();
#undef MOBA_QLOAD
}
DI void moba_combine_phase(Frame& F) {
    const int gw = F.vcu * NWAVES + F.wave, NGW = F.G * NWAVES, sub = F.lane >> 4, ch = F.lane & 15;
    const bf16* po = (const bf16*)(F.ws + WS_PARTO); const float* pml = (const float*)(F.ws + WS_PARTML); bf16* ob = (bf16*)(F.ws + WS_O);
#pragma unroll 1
    for (int it = gw; it < (M * A_H) / 4; it += NGW) {
        const int pair = it * 4 + sub, tok = pair >> 5, h = pair & 31, b = tok >> 8, nv = b < 3 ? b : 3;
        const f32x4 ml01 = *(const GAS f32x4*)(pml + (size_t)pair * 8), ml23 = *(const GAS f32x4*)(pml + (size_t)pair * 8 + 4);
        float mm[4] = {ml01.x, ml01.z, ml23.x, ml23.z}, ll[4] = {ml01.y, ml01.w, ml23.y, ml23.w};
        float mx = mm[3];
#pragma unroll
        for (int s = 0; s < 3; ++s) if (s < nv) mx = __builtin_fmaxf(mx, mm[s]);
        float wgt[4], wsum = 0.f;
#pragma unroll
        for (int s = 0; s < 4; ++s) { const bool ok = (s == 3) || (s < nv); wgt[s] = ok ? __builtin_amdgcn_exp2f(mm[s] - mx) * ll[s] : 0.f; wsum += wgt[s]; }
        const float inv = 1.0f / wsum; float acc[8];
#pragma unroll
        for (int e = 0; e < 8; ++e) acc[e] = 0.f;
#pragma unroll
        for (int s = 0; s < 4; ++s) { const bool ok = (s == 3) || (s < nv);
            if (ok) { const v4u v = *(const GAS v4u*)(po + ((size_t)pair * 4 + s) * 128 + ch * 8); const float ws_ = wgt[s] * inv;
                acc[0] += ws_ * bf2f(v.x & 0xffffu); acc[1] += ws_ * bf2f(v.x >> 16); acc[2] += ws_ * bf2f(v.y & 0xffffu); acc[3] += ws_ * bf2f(v.y >> 16);
                acc[4] += ws_ * bf2f(v.z & 0xffffu); acc[5] += ws_ * bf2f(v.z >> 16); acc[6] += ws_ * bf2f(v.w & 0xffffu); acc[7] += ws_ * bf2f(v.w >> 16); } }
        v4u o; o.x = cvtpk(acc[0], acc[1]); o.y = cvtpk(acc[2], acc[3]); o.z = cvtpk(acc[4], acc[5]); o.w = cvtpk(acc[6], acc[7]);
        *(GAS v4u*)(ob + (size_t)tok * DM + h * 128 + ch * 8) = o;
    }
}

DI void moba_combine_quant_phase(Frame& F, unsigned char* oq, float* sO) {
    const int gw = F.vcu * NWAVES + F.wave, NGW = F.G * NWAVES, sub = F.lane >> 4, ch = F.lane & 15;
    const bf16* po = (const bf16*)(F.ws + WS_PARTO); const float* pml = (const float*)(F.ws + WS_PARTML);
#pragma unroll 1
    for (int tok = gw; tok < M; tok += NGW) {
        const int b = tok >> 8, nv = b < 3 ? b : 3; float acc[8][8]; float amx = 0.f;
#pragma unroll
        for (int j = 0; j < 8; ++j) {
            const int pair = tok * 32 + 4 * j + sub;
            const f32x4 ml01 = *(const GAS f32x4*)(pml + (size_t)pair * 8), ml23 = *(const GAS f32x4*)(pml + (size_t)pair * 8 + 4);
            float mm[4] = {ml01.x, ml01.z, ml23.x, ml23.z}, ll[4] = {ml01.y, ml01.w, ml23.y, ml23.w};
            float mx = mm[3];
#pragma unroll
            for (int s = 0; s < 3; ++s) if (s < nv) mx = __builtin_fmaxf(mx, mm[s]);
            float wgt[4], wsum = 0.f;
#pragma unroll
            for (int s = 0; s < 4; ++s) { const bool ok = (s == 3) || (s < nv); wgt[s] = ok ? __builtin_amdgcn_exp2f(mm[s] - mx) * ll[s] : 0.f; wsum += wgt[s]; }
            const float inv = 1.0f / wsum;
#pragma unroll
            for (int e = 0; e < 8; ++e) acc[j][e] = 0.f;
#pragma unroll
            for (int s = 0; s < 4; ++s) { const bool ok = (s == 3) || (s < nv);
                if (ok) { const v4u v = *(const GAS v4u*)(po + ((size_t)pair * 4 + s) * 128 + ch * 8); const float ws_ = wgt[s] * inv;
                    acc[j][0] += ws_ * bf2f(v.x & 0xffffu); acc[j][1] += ws_ * bf2f(v.x >> 16); acc[j][2] += ws_ * bf2f(v.y & 0xffffu); acc[j][3] += ws_ * bf2f(v.y >> 16);
                    acc[j][4] += ws_ * bf2f(v.z & 0xffffu); acc[j][5] += ws_ * bf2f(v.z >> 16); acc[j][6] += ws_ * bf2f(v.w & 0xffffu); acc[j][7] += ws_ * bf2f(v.w >> 16); } }
#pragma unroll
            for (int e = 0; e < 8; ++e) amx = __builtin_fmaxf(amx, __builtin_fabsf(acc[j][e]));
        }
#pragma unroll
        for (int s = 1; s < 64; s <<= 1) amx = __builtin_fmaxf(amx, __shfl_xor(amx, s));
        const float qi = amx > 0.f ? 127.0f / amx : 0.f;
#pragma unroll
        for (int j = 0; j < 8; ++j) { v2u w; w.x = q8x4(acc[j][0], acc[j][1], acc[j][2], acc[j][3], qi); w.y = q8x4(acc[j][4], acc[j][5], acc[j][6], acc[j][7], qi);
            *(GAS v2u*)(oq + (size_t)tok * DM + (4 * j + sub) * 128 + ch * 8) = w; }
        if (F.lane == 0) sO[tok] = amx * (1.0f / 127.0f);
    }
}

DI void swa_item(Frame& F, int qb, int kvh) {
    constexpr int D = 64; typedef TL<D> T; constexpr int IMG = 384 * T::PITCH;
    LAS unsigned char* kt = F.lds + RING_OFF; LAS unsigned char* vt = kt + IMG;
    const int lane = F.lane, r32 = lane & 31, hi = lane >> 5, w = F.wave, tid = F.tid;
    const long base = (long)qb * 256 - 128; const int tb = (qb == 0) ? 2 : 0;
    const bf16* Kb = (const bf16*)(F.ws + WS_KSH) + kvh * 64 + base * B_KVW; const bf16* Vb = (const bf16*)(F.ws + WS_VSH) + kvh * 64 + base * B_KVW;
    const int tok = qb * 256 + w * 32 + r32;
    const bf16* qrow = (const bf16*)(F.ws + WS_Q) + (size_t)tok * DM + kvh * 8 * 64;
    bf16x8 qf[4];
#pragma unroll
    for (int s = 0; s < 4; ++s) qf[s] = *(const GAS bf16x8*)(qrow + 16 * s + 8 * hi);
    { v4u rk[6], rv[6];
#pragma unroll
      for (int i = 0; i < 6; ++i) { const int c = tid + 512 * i, row = c >> 3, ch = c & 7; if (row >= 64 * tb) { rk[i] = *(const GAS v4u*)(Kb + (size_t)row * B_KVW + ch * 8); rv[i] = *(const GAS v4u*)(Vb + (size_t)row * B_KVW + ch * 8); } }
      __syncthreads();
#pragma unroll
      for (int i = 0; i < 6; ++i) { const int c = tid + 512 * i, row = c >> 3, ch = c & 7; if (row >= 64 * tb) { *(LAS v4u*)(kt + row * T::PITCH + ch * 16) = rk[i]; *(LAS v4u*)(vt + row * T::PITCH + ch * 16) = rv[i]; } }
      __syncthreads(); }
    const float NEG = -__builtin_inff(); const int qs = 32 * w, qrel = qs + r32;
#pragma unroll 1
    for (int g = 0; g < 8; ++g) {
        const int h = kvh * 8 + g;
        bf16x8 qn[4];
        if (g < 7) {
#pragma unroll
            for (int s = 0; s < 4; ++s) qn[s] = *(const GAS bf16x8*)(qrow + (g + 1) * 64 + 16 * s + 8 * hi); }
        float m = F.b_sinks[h] * LOG2E, l = (hi == 0) ? 1.0f : 0.f; f32x16 o[2];
#pragma unroll
        for (int db = 0; db < 2; ++db)
#pragma unroll
            for (int i = 0; i < 16; ++i) o[db][i] = 0.f;
#pragma unroll 1
        for (int tt = tb; tt < 6; ++tt) {
            const int kbr = -128 + 64 * tt;
            if ((kbr <= qs + 31) && (kbr + 63 >= qs - 127)) {
                f32x16 p0, p1; qk<D>(p0, p1, kt + tt * 64 * T::PITCH, qf, r32, hi);
                const int kb = kbr + 4 * hi;
#pragma unroll
                for (int i = 0; i < 16; ++i) { const int kv = kb + (i & 3) + 8 * (i >> 2);
                    p0[i] = (kv <= qrel && qrel - kv < 128) ? p0[i] : NEG; p1[i] = (kv + 32 <= qrel && qrel - kv - 32 < 128) ? p1[i] : NEG; }
                softmax_update<D>(p0, p1, m, l, o);
                pv<D>(o, vt + tt * 64 * T::PITCH, p0, p1, lane, hi);
            }
        }
        store_o<D>((bf16*)(F.ws + WS_O) + (size_t)tok * DM + h * 64, o, l, hi);
        if (g < 7) {
#pragma unroll
            for (int s = 0; s < 4; ++s) qf[s] = qn[s]; }
    }
}
DI void swa_phase(Frame& F) {
#pragma unroll 1
    for (int p = F.vcu; p < 64 * 8; p += F.G) swa_item(F, p & 63, p >> 6);
    __syncthreads();
}
#undef MFMA32
}
struct Args { const float* in[13]; float* out; unsigned char* ws; int ph_lo, ph_hi; };
__global__ void __launch_bounds__(NWAVES * 64, 2) yoco_fwd(Args args) {
    extern __shared__ __attribute__((aligned(16))) unsigned char lds[];
    Frame F;
    F.lds = (LAS unsigned char*)lds;
    F.MISC = (volatile LAS unsigned*)(F.lds + MISC_OFF);
    F.tid = threadIdx.x; F.lane = F.tid & 63; F.wave = __builtin_amdgcn_readfirstlane(F.tid >> 6);
    F.G = gridDim.x; { const int bx = blockIdx.x; F.vcu = (F.G % 8 == 0) ? (bx % 8) * (F.G / 8) + bx / 8 : bx; }
    F.ws = args.ws; F.ctl = (gu32*)(args.ws + WS_CTL);
    F.x = args.in[0]; F.ffn_norm = args.in[1]; F.ffn_w_in = args.in[2]; F.ffn_w_out = args.in[3]; F.attn_norm = args.in[4]; F.a_w_qkv = args.in[5]; F.a_w_o = args.in[6];
    F.kv_norm = args.in[7]; F.w_kv = args.in[8]; F.b_w_q = args.in[9]; F.b_sinks = args.in[10]; F.b_w_o = args.in[11]; F.final_norm = args.in[12]; F.out = args.out;
    for (int u = F.tid; u < (LDS_BYTES - LDSCTL_OFF) / 4; u += NWAVES * 64) ((LAS unsigned*)(F.lds + LDSCTL_OFF))[u] = 0u;
    __syncthreads();
    XcdBarrier bar; bar.bar = (unsigned*)(F.ctl + CW_BAR); bar.x = 0; bar.st = nullptr;
    if (!MK_SPLIT) bar = xcd_barrier_post((unsigned*)(F.ctl + CW_BAR), F.MISC + 8);
#define GRID_BAR(seam) do { if (MK_SPLIT) { if (F.tid == 0) __hip_atomic_store(F.ctl + CW_TMO, 0xBADBA0u | (unsigned)(seam), RLX_AGENT); } else { xcd_barrier(bar); } } while (0)
    const int lo = args.ph_lo, hi = args.ph_hi;
#ifndef PH_MASK
#define PH_MASK 0xffffffffu
#endif
#define IN(k) ((((PH_MASK) >> (k)) & 1u) && lo <= (k) && (k) < hi)
#define SEAM(k) do { if (IN(k) && IN((k) + 1)) GRID_BAR(k); } while (0)
    bf16* const W_IN = (bf16*)(F.ws + WS_WIN); bf16* const W_OUT = (bf16*)(F.ws + WS_WOUT);
    bf16* const W_QKV = (bf16*)(F.ws + WS_WQKV); bf16* const W_AO = (bf16*)(F.ws + WS_WAO); bf16* const W_KV = (bf16*)(F.ws + WS_WKV); bf16* const W_BQ = (bf16*)(F.ws + WS_WBQ); bf16* const W_BO = (bf16*)(F.ws + WS_WBO);
    bf16* const XN = (bf16*)(F.ws + WS_XN); bf16* const ACT = (bf16*)(F.ws + WS_ACT); bf16* const QB = (bf16*)(F.ws + WS_Q); bf16* const KB = (bf16*)(F.ws + WS_K); bf16* const VB = (bf16*)(F.ws + WS_V);
    bf16* const OB = (bf16*)(F.ws + WS_O); bf16* const KSH = (bf16*)(F.ws + WS_KSH); bf16* const VSH = (bf16*)(F.ws + WS_VSH);
    const float* const COSA = (const float*)(F.ws + WS_ROPEA); const float* const SINA = COSA + (size_t)M * 64; const float* const COSB = (const float*)(F.ws + WS_ROPEB); const float* const SINB = COSB + (size_t)M * 32;
    unsigned char* const W8 = (unsigned char*)(F.ws + WS_WIN); unsigned char* const XN8 = (unsigned char*)(F.ws + WS_XN8); float* const SA = (float*)(F.ws + WS_SA);
    float* const COLMAX = (float*)(F.ctl + CW_COLMAX); constexpr int CM_BQ = 4 * 2 * DFF, CM_KV = CM_BQ + DM, CM_AO = CM_KV + 2 * B_KVW, CM_BO = CM_AO + DM, CM_OUT = CM_BO + DM, CM_QKV = CM_OUT + 4 * DM;
    bf16* const XRES = (bf16*)(F.ws + WS_XN);
    unsigned char* const ACT8 = (unsigned char*)(F.ws + WS_ACT8); float* const SACT = (float*)(F.ws + WS_SACT); unsigned char* const W8O = (unsigned char*)(F.ws + WS_WOUT);
    constexpr size_t E_WIN = (size_t)2 * DFF * DM, E_WOUT = (size_t)DFF * DM;

#define GEMM_PHASE_T(EPI_T, EPI_OBJ, A_, B_, N_, K_, TA_, TB_, WGM_) do { pg8::Gemm g_{(A_), (B_), M, (N_), (K_)}; pg8::StaticOrder S_; S_.init(M, (N_), F.G, (int)blockIdx.x, (WGM_)); \
        pg8::gemm_phase<EPI_T, pg8::StaticOrder, PG8_ALIGN, PG8_SP2, TA_, TB_>(F.lds + RING_OFF, g_, S_, (EPI_OBJ)); } while (0)
#ifndef XN_TILED
#define XN_TILED false
#endif
#define GEMM_PHASE_8(EPI_T, EPI_OBJ, A_, B_, N_, K_) do { pg8::Gemm g_{(const bf16*)(A_), (const bf16*)(B_), M, (N_), (K_)}; pg8::StaticOrder S_; S_.init(M, (N_), F.G, (int)blockIdx.x, 8); \
        pg8::gemm_phase<EPI_T, pg8::StaticOrder, PG8_ALIGN, PG8_SP2, false, true, true>(F.lds + RING_OFF, g_, S_, (EPI_OBJ)); } while (0)
#define GEMM_PHASE(EPI_T, EPI_OBJ, A_, B_, N_, K_) GEMM_PHASE_T(EPI_T, EPI_OBJ, A_, B_, N_, K_, false, true, 8)
#define GEMM_PHASE_X(EPI_T, EPI_OBJ, A_, B_, N_, K_) GEMM_PHASE_T(EPI_T, EPI_OBJ, A_, B_, N_, K_, XN_TILED, true, 8)
#ifndef DOWN_WGM
#define DOWN_WGM 2
#endif
#define FFN_UP(f)   do { pg8::EpiSwiGLU8 E_{ACT, DFF, SA, COLMAX + (size_t)(f) * 2 * DFF}; pg8::Gemm g_{(const bf16*)XN8, (const bf16*)(W8 + (size_t)(f) * E_WIN), M, 2 * DFF, DM}; \
        pg8::ClaimOrder S_; S_.init(M, 2 * DFF, F.G, (int)blockIdx.x, 8); S_.setup((unsigned*)(F.ctl + CW_CLAIM + 64 * (f)), F.MISC + 16); \
        pg8::gemm_phase<pg8::EpiSwiGLU8, pg8::ClaimOrder, PG8_ALIGN, PG8_SP2, false, true, true>(F.lds + RING_OFF, g_, S_, E_); } while (0)
#define FFN_DOWN(f, BASE_) do { pg8::EpiResid8 E_{(BASE_), (pg8::bf16_t*)XRES, DM, 0.5f, SACT, COLMAX + CM_OUT + (size_t)(f) * DM}; pg8::Gemm g_{(const bf16*)ACT8, (const bf16*)(W8O + (size_t)(f) * E_WOUT), M, DM, DFF}; \
        pg8::StaticOrder S_; S_.init(M, DM, F.G, (int)blockIdx.x, DOWN_WGM); pg8::gemm_phase<pg8::EpiResid8, pg8::StaticOrder, PG8_ALIGN, PG8_SP2, (ACT8_TILED != 0), true, true>(F.lds + RING_OFF, g_, S_, E_); } while (0)

    LAS float* const scr_ = (LAS float*)(F.lds + RING_OFF + F.wave * 16384);
#ifndef XN_FFN_DROP
#define XN_FFN_DROP 2
#endif
#ifndef FFN_W_DROP
#define FFN_W_DROP 2
#endif
#define TR_WXD(SRC, GAIN, DST, K_, N_, MODE_, LIM_, TL_, GW_, NGW_, DROP_) for (int it_ = (GW_); it_ < ((K_) / 64) * ((N_) / 32); it_ += (NGW_)) tr_item<TL_, DROP_>((SRC), (GAIN), (DST), (K_), (N_), (N_), (MODE_), (LIM_), scr_, it_, F.lane)
#define TR_WX(SRC, GAIN, DST, K_, N_, MODE_, LIM_, TL_, GW_, NGW_) for (int it_ = (GW_); it_ < ((K_) / 64) * ((N_) / 32); it_ += (NGW_)) tr_item<TL_>((SRC), (GAIN), (DST), (K_), (N_), (N_), (MODE_), (LIM_), scr_, it_, F.lane)
    const bool tailconv = false, tailwg = false;
    const int tw_ = ((int)blockIdx.x - 128) * NWAVES + F.wave, NTW_ = 128 * NWAVES;
    if (IN(0)) {
        {
        const int gw = F.vcu * NWAVES + F.wave, NGW = F.G * NWAVES;
#define TR_W(SRC, GAIN, DST, K_, N_, MODE_, LIM_, TL_) TR_WX(SRC, GAIN, DST, K_, N_, MODE_, LIM_, TL_, gw, NGW)
#define TR_WF(SRC, GAIN, DST, K_, N_, MODE_, LIM_, TL_) TR_WXD(SRC, GAIN, DST, K_, N_, MODE_, LIM_, TL_, gw, NGW, FFN_W_DROP)
        if (!tailconv) {
        }
#undef TR_W
#undef TR_WF
        { LAS unsigned* const cmlb_ = (LAS unsigned*)(F.lds + RING_BYTES); constexpr int S_IN = (2 * DFF) / 16, S_D = DM / 16, S_KV = (2 * B_KVW) / 16, S_QKV = NQKV / 16, S_TOT = 4 * S_IN + 3 * S_D + S_KV + S_QKV;
          if (F.tid < 64) cmlb_[F.tid] = 0u;
          __syncthreads();
          int par_ = 0;
#pragma unroll 1
          for (int st_ = F.vcu; st_ < S_TOT; st_ += F.G, par_ = (par_ == 32 ? 0 : par_ + 16)) {
              if (F.tid < 16) cmlb_[(par_ == 32 ? 0 : par_ + 16) + F.tid] = 0u;
              const float* src_; const float* gn_; float* cm_; unsigned char* dst_; int n_, mode_, lim_, sl_;
              if (st_ < 4 * S_IN) { const int fw_ = st_ / S_IN; sl_ = st_ - fw_ * S_IN; src_ = F.ffn_w_in + (size_t)fw_ * E_WIN; gn_ = F.ffn_norm + (size_t)fw_ * DM; cm_ = COLMAX + (size_t)fw_ * 2 * DFF; dst_ = W8 + (size_t)fw_ * E_WIN; n_ = 2 * DFF; mode_ = 1; lim_ = 0; }
              else if (st_ < 4 * S_IN + S_D) { sl_ = st_ - 4 * S_IN; src_ = F.b_w_q; gn_ = F.attn_norm + DM; cm_ = COLMAX + CM_BQ; dst_ = (unsigned char*)W_BQ; n_ = DM; mode_ = 3; lim_ = 4096; }
              else if (st_ < 4 * S_IN + 2 * S_D) { sl_ = st_ - 4 * S_IN - S_D; src_ = F.a_w_o; gn_ = nullptr; cm_ = COLMAX + CM_AO; dst_ = (unsigned char*)W_AO; n_ = DM; mode_ = 0; lim_ = 0; }
              else if (st_ < 4 * S_IN + 3 * S_D) { sl_ = st_ - 4 * S_IN - 2 * S_D; src_ = F.b_w_o; gn_ = nullptr; cm_ = COLMAX + CM_BO; dst_ = (unsigned char*)W_BO; n_ = DM; mode_ = 0; lim_ = 0; }
              else if (st_ >= 4 * S_IN + 3 * S_D + S_KV) { sl_ = st_ - 4 * S_IN - 3 * S_D - S_KV; src_ = F.a_w_qkv; gn_ = F.attn_norm; cm_ = COLMAX + CM_QKV; dst_ = (unsigned char*)W_QKV; n_ = NQKV; mode_ = 2; lim_ = 5120; }
              else { sl_ = st_ - 4 * S_IN - 3 * S_D; src_ = F.w_kv; gn_ = F.kv_norm; cm_ = COLMAX + CM_KV; dst_ = (unsigned char*)W_KV; n_ = 2 * B_KVW; mode_ = 3; lim_ = 512; }
              strip16_quant8(F, src_, gn_, cm_, dst_, n_, mode_, lim_, sl_, scr_, cmlb_ + par_);
          }
          __syncthreads(); }
        { LAS unsigned* const cml_ = (LAS unsigned*)(F.lds + RING_BYTES);
#pragma unroll 1
          for (int st_ = F.vcu; st_ < 4 * (DM / 32); st_ += F.G) { const int fw_ = st_ / (DM / 32), sl_ = st_ - fw_ * (DM / 32);
              strip_quant8_rot(F, F.ffn_w_out + (size_t)fw_ * E_WOUT, COLMAX + CM_OUT + (size_t)fw_ * DM, W8O + (size_t)fw_ * E_WOUT, DFF, DM, sl_, scr_, cml_); } }
        rope_tables(F);
        norm_rows8<0>(F, F.x, XN8, SA, (bf16*)nullptr);
        }
    }
    if (IN(0) && IN(1)) GRID_BAR(0);
    if (IN(1)) { FFN_UP(0);
        if (tailwg) { TR_WX(F.a_w_qkv, F.attn_norm, W_QKV, DM, NQKV, 2, 5120, true, tw_, NTW_); } }
    if (IN(1) && IN(27)) GRID_BAR(1);
    if (IN(27)) act_quant_phase(F, ACT, ACT8, SACT);
    if (IN(27) && IN(2)) GRID_BAR(27);
    if (IN(2)) FFN_DOWN(0, F.x);
    SEAM(2);
    if (IN(3)) norm_rows8_b(F, XRES, XN8, SA);
    SEAM(3);
    if (IN(4)) { pg8::EpiRope8<128> E_{QB, KB, VB, DM, A_KVW, A_KVW, 16, 4, 0.08838834764831845f * LOG2E, COSA, SINA, SA, COLMAX + CM_QKV}; GEMM_PHASE_8(pg8::EpiRope8<128>, E_, XN8, W_QKV, NQKV, DM);
    }
    SEAM(4);
    if (IN(5)) kmean_phase(F);
    SEAM(5);
    if (IN(6)) att::moba_own_phase(F);
    SEAM(6);
    if (IN(22)) att::moba_past_phase(F);
    if (IN(22) && IN(23)) GRID_BAR(22);
    if (IN(23)) att::moba_combine_quant_phase(F, XN8, SA);
    if (IN(23) && IN(7)) GRID_BAR(23);
    if (IN(7)) { pg8::EpiResid8 E_{nullptr, (pg8::bf16_t*)XRES, DM, 1.0f, SA, COLMAX + CM_AO}; GEMM_PHASE_8(pg8::EpiResid8, E_, XN8, W_AO, DM, DM); }
    SEAM(7);
    if (IN(8)) norm_rows8_b(F, XRES, XN8, SA);
    SEAM(8);
    if (IN(9)) { FFN_UP(1);
        if (tailwg) { } }
    if (IN(9) && IN(28)) GRID_BAR(9);
    if (IN(28)) act_quant_phase(F, ACT, ACT8, SACT);
    if (IN(28) && IN(10)) GRID_BAR(28);
    if (IN(10)) FFN_DOWN(1, (const float*)nullptr);
    SEAM(10);
    if (IN(11)) norm_rows8_b(F, XRES, XN8, SA);
    SEAM(11);
    if (IN(12)) { { pg8::EpiRope8<64> E_{KSH, KSH, VSH, B_KVW, B_KVW, B_KVW, 0, 2, 1.0f, COSB, SINB, SA, COLMAX + CM_KV}; GEMM_PHASE_8(pg8::EpiRope8<64>, E_, XN8, W_KV, 2 * B_KVW, DM); }
                  FFN_UP(2);
                  }
    if (IN(12) && IN(29)) GRID_BAR(12);
    if (IN(29)) act_quant_phase(F, ACT, ACT8, SACT);
    if (IN(29) && IN(13)) GRID_BAR(29);
    if (IN(13)) FFN_DOWN(2, (const float*)nullptr);
    SEAM(13);
    if (IN(14)) norm_rows8_b(F, XRES, XN8, SA);
    SEAM(14);
    if (IN(15)) { pg8::EpiRope8<64> E_{QB, QB, QB, DM, DM, DM, 16, 0, 0.125f * LOG2E, COSB, SINB, SA, COLMAX + CM_BQ}; GEMM_PHASE_8(pg8::EpiRope8<64>, E_, XN8, W_BQ, DM, DM); }
    SEAM(15);
    if (IN(16)) att::swa_phase(F);
    if (IN(16) && IN(26)) GRID_BAR(16);
    if (IN(26)) quant_rows_bf16(F, OB, XN8, SA);
    if (IN(26) && IN(17)) GRID_BAR(26);
    if (IN(17)) { pg8::EpiResid8 E_{nullptr, (pg8::bf16_t*)XRES, DM, 1.0f, SA, COLMAX + CM_BO}; GEMM_PHASE_8(pg8::EpiResid8, E_, XN8, W_BO, DM, DM); }
    SEAM(17);
    if (IN(18)) norm_rows8_b(F, XRES, XN8, SA);
    SEAM(18);
    if (IN(19)) FFN_UP(3);
    if (IN(19) && IN(30)) GRID_BAR(19);
    if (IN(30)) act_quant_phase(F, ACT, ACT8, SACT);
    if (IN(30) && IN(20)) GRID_BAR(30);
    if (IN(20)) FFN_DOWN(3, (const float*)nullptr);
    SEAM(20);
    if (IN(21)) { bool poison = false; if (!MK_SPLIT) poison = __hip_atomic_load((gu32*)((unsigned*)(F.ctl + CW_BAR) + XB_TMO), RLX_AGENT) != 0u;
                  final_norm_rows_b(F, XRES, F.out, F.final_norm, poison); }
#undef IN
#undef SEAM
#undef GRID_BAR
}

extern "C" void kernel_launch(void* const* d_in, const int* in_sizes, int n_in, void* d_out, int out_size, void* d_ws, size_t ws_size, hipStream_t stream) {
    static int grid = 0;
    if (grid == 0) {
        if (n_in != 13 || in_sizes[0] != M * DM || out_size != M * DM || ws_size < WS_END) { fprintf(stderr, "kernel_launch: unexpected shapes: n_in %d, in0 %d, out %d, ws %zu (need %zu); nothing launched\n", n_in, n_in > 0 ? in_sizes[0] : -1, out_size, ws_size, (size_t)WS_END); grid = -1; return; }
        int dev = 0, cus = 0, per_cu = 0;
        if (hipGetDevice(&dev) != hipSuccess || hipDeviceGetAttribute(&cus, hipDeviceAttributeMultiprocessorCount, dev) != hipSuccess) { fprintf(stderr, "kernel_launch: device query failed\n"); grid = -1; return; }
        if (hipFuncSetAttribute((const void*)yoco_fwd, hipFuncAttributeMaxDynamicSharedMemorySize, LDS_BYTES) != hipSuccess) { fprintf(stderr, "kernel_launch: hipFuncSetAttribute failed\n"); grid = -1; return; }
        if (hipOccupancyMaxActiveBlocksPerMultiprocessor(&per_cu, (const void*)yoco_fwd, NWAVES * 64, LDS_BYTES) != hipSuccess || per_cu < 1)
            fprintf(stderr, "kernel_launch: note: occupancy query reports %d workgroups per CU\n", per_cu);
        (void)hipGetLastError();
        grid = cus;
    }
    if (grid < 0) return;
    if (hipMemsetAsync((char*)d_ws + WS_CTL, 0, CTL_ZERO_BYTES, stream) != hipSuccess) { fprintf(stderr, "kernel_launch: hipMemsetAsync failed\n"); return; }
    Args a{};
    for (int i = 0; i < 13; ++i) a.in[i] = (const float*)d_in[i];
    a.out = (float*)d_out; a.ws = (unsigned char*)d_ws;
#if MK_SPLIT
    static const int order[N_PHASES] = {0, 24, 25, 1, 27, 2, 3, 4, 5, 6, 22, 23, 7, 8, 9, 28, 10, 11, 12, 29, 13, 14, 15, 16, 26, 17, 18, 19, 30, 20, 21};
    for (int k = 0; k < N_PHASES; ++k) { a.ph_lo = order[k]; a.ph_hi = order[k] + 1; hipLaunchKernelGGL(yoco_fwd, dim3(grid), dim3(NWAVES * 64), LDS_BYTES, stream, a); }
#else
    a.ph_lo = 0; a.ph_hi = N_PHASES;
    hipLaunchKernelGGL(yoco_fwd, dim3(grid), dim3(NWAVES * 64), LDS_BYTES, stream, a);
#endif
    const hipError_t le = hipPeekAtLastError();
    if (le != hipSuccess) fprintf(stderr, "kernel_launch: launch failed: %s\n", hipGetErrorName(le));
}
```

```cpp
#include <hip/hip_runtime.h>
#include <cstdio>
#include <cstdint>
#include <cmath>
namespace pg8 {
#define PG8_LAS __attribute__((address_space(3)))
typedef unsigned short bf16_t;
typedef short bf16x8 __attribute__((ext_vector_type(8)));
typedef float f32x4 __attribute__((ext_vector_type(4)));
typedef unsigned u32x4 __attribute__((ext_vector_type(4)));
typedef unsigned u32x2 __attribute__((ext_vector_type(2)));
constexpr int BM = 256, BK = 64, HALF = 128, HTB = HALF * BK * 2  , STAGE_BYTES = 8 * HTB, NXCD = 8, WGM = 8;

__host__ __device__ __forceinline__ int lds_byte(int r, int c) { const int st = (r >> 4) * 2 + (c >> 5), rr = r & 15, cc = c & 31, ob = rr * 64 + cc * 2; return st * 1024 + (ob ^ (((ob >> 9) & 1) << 5)); }
__host__ __device__ __forceinline__ void stage_rc(int b, int& R, int& C) { const int st = b / 1024, sb = b % 1024, swz = sb ^ (((sb >> 9) & 1) << 5); R = (st >> 1) * 16 + swz / 64; C = (st & 1) * 32 + (swz % 64) / 2; }
__host__ __device__ __forceinline__ int perm32(int rho) { const int n = rho >> 4, i = rho & 15; return 8 * (i >> 2) + 4 * n + (i & 3); }

__host__ __device__ __forceinline__ size_t tiled_off(int r, int k, int K) { return (size_t)(r >> 8) * ((size_t)BM * K) + (size_t)(k >> 6) * (BM * BK) + (size_t)(r & 255) * BK + (k & 63); }
typedef int i32x4 __attribute__((ext_vector_type(4)));
template <bool I8> struct AccType { typedef f32x4 type; };
template <> struct AccType<true> { typedef i32x4 type; };
__device__ __forceinline__ f32x4 mma16(bf16x8 a, bf16x8 b, f32x4 c) { return __builtin_amdgcn_mfma_f32_16x16x32_bf16(a, b, c, 0, 0, 0); }
__device__ __forceinline__ i32x4 mma16(bf16x8 a, bf16x8 b, i32x4 c) { return __builtin_amdgcn_mfma_i32_16x16x64_i8(__builtin_bit_cast(i32x4, a), __builtin_bit_cast(i32x4, b), c, 0, 0, 0); }
struct Unit { int pm, pn; };
struct Gemm { const bf16_t* A; const bf16_t* Bt; int M, N, K; };

struct StaticOrder {
    int nM, nN, nwg, G, c, wgm, i0, i1;
    __host__ __device__ void init(int M, int N, int G_, int c_, int wgm_ = WGM, int i0_ = 0, int i1_ = 1 << 20) { nM = M / BM; nN = N / BM; nwg = nM * nN; G = G_; c = c_; wgm = wgm_; i0 = i0_; i1 = i1_; }
    __host__ __device__ void decode(long L, Unit& u) const {
        int wgid = (int)L; { const int q = nwg / NXCD, r = nwg % NXCD, xcd = wgid % NXCD, off = wgid / NXCD; wgid = (xcd < r ? xcd * (q + 1) : r * (q + 1) + (xcd - r) * q) + off; }
        const int nig = wgm * nN, gid = wgid / nig, fm = gid * wgm, gsz = (nM - fm) < wgm ? (nM - fm) : wgm;
        u.pm = fm + ((wgid % nig) % gsz); u.pn = (wgid % nig) / gsz;
    }
    __host__ __device__ bool next(int i, Unit& u) const {
        if (i + i0 >= i1) return false;
        const long L = (long)(i + i0) * G + c; if (L >= nwg) return false;
        decode(L, u); return true;
    }
    __device__ __forceinline__ void a_ready(const Unit&) const {}
    __device__ __forceinline__ void done(const Unit&) const {}
};
struct UpOrder : StaticOrder {
    bool tailmajor;
    __device__ void decode_up(long L, Unit& u) const {
        decode(L, u);
        if (tailmajor) { const int wgid = (int)L, xcd = wgid % NXCD, w = wgid / NXCD;
            if (w >= 640) { const int t = w - 640; const int hi = t >= 24, tt = hi ? t - 24 : t; u.pm = xcd * 8 + 4 * hi + (tt & 3); u.pn = 80 + (tt >> 2); } }
    }
    __device__ bool next(int i, Unit& u) const {
        if (i + i0 >= i1) return false;
        const long L = (long)(i + i0) * G + c; if (L >= nwg) return false;
        decode_up(L, u); return true;
    }
};
struct ClaimOrder : StaticOrder {
    int nfull, nleft; unsigned* ctr; volatile PG8_LAS unsigned* slot;
    __device__ void setup(unsigned* ctr_, volatile PG8_LAS unsigned* slot_) { nfull = nwg / G; nleft = nwg - nfull * G; ctr = ctr_; slot = slot_; }
    __device__ __forceinline__ bool next(int i, Unit& u) const {
        if (i < nfull) { decode((long)i * G + c, u); return true; }
        if (i > nfull || nleft == 0) return false;
        const int x = c % NXCD, nl = (nleft - x + NXCD - 1) / NXCD;
        if (threadIdx.x == 0) { const unsigned id = __hip_atomic_fetch_add(ctr + x, 1u, __ATOMIC_RELAXED, __HIP_MEMORY_SCOPE_AGENT); *slot = id; }
        asm volatile("s_waitcnt lgkmcnt(0)" ::: "memory"); __builtin_amdgcn_s_barrier(); asm volatile("" ::: "memory");
        const unsigned id = *slot;
        if ((int)id >= nl) return false;
        decode((long)nfull * G + (long)id * NXCD + x, u); return true;
    }
};
__device__ __forceinline__ unsigned cvt_pk_bf16(float lo, float hi) { unsigned r; asm volatile("v_cvt_pk_bf16_f32 %0, %1, %2" : "=v"(r) : "v"(lo), "v"(hi)); return r; }
__device__ __forceinline__ float silu_mul(float g, float u) { return g * u * __builtin_amdgcn_rcpf(1.0f + __builtin_amdgcn_exp2f(g * -1.4426950408889634f)); }
#ifndef ACT_DROP
#define ACT_DROP 0
#endif
struct EpiSwiGLU {
    static constexpr bool PERM = true, AFTER_DRAIN = false;
    bf16_t* O; int ldc;
    __device__ __forceinline__ void operator()(const f32x4 (&acc)[2][2][4][2], const Unit& u, int wr, int wc, int fr, int fq) const {
        const int row0 = u.pm * BM + wr * 64 + fr, col0 = u.pn * HALF + wc * 32 + 8 * fq;
#pragma unroll
        for (int ai = 0; ai < 2; ++ai)
#pragma unroll
            for (int m = 0; m < 4; ++m) { bf16_t* p = O + tiled_off(row0 + ai * HALF + m * 16, col0, ldc);
                const f32x4 g0 = acc[ai][0][m][0], g1 = acc[ai][0][m][1], u0 = acc[ai][1][m][0], u1 = acc[ai][1][m][1];
                u32x4 w; w.x = cvt_pk_bf16(silu_mul(g0[0], u0[0]), silu_mul(g0[1], u0[1])); w.y = cvt_pk_bf16(silu_mul(g0[2], u0[2]), silu_mul(g0[3], u0[3]));
                w.z = cvt_pk_bf16(silu_mul(g1[0], u1[0]), silu_mul(g1[1], u1[1])); w.w = cvt_pk_bf16(silu_mul(g1[2], u1[2]), silu_mul(g1[3], u1[3]));
                if (ACT_DROP > 0) { constexpr unsigned add_ = ((1u << ACT_DROP) >> 1) * 0x00010001u, msk_ = ~(((1u << ACT_DROP) - 1u) * 0x00010001u);
                    w.x = (w.x + add_) & msk_; w.y = (w.y + add_) & msk_; w.z = (w.z + add_) & msk_; w.w = (w.w + add_) & msk_; }
                *(u32x4*)p = w; }
    }
};
struct EpiSwiGLU8 {
    static constexpr bool PERM = true, AFTER_DRAIN = false;
    bf16_t* O; int ldc; const float* sA; const float* colmax;
    typedef float f2 __attribute__((ext_vector_type(2)));
    typedef int i2 __attribute__((ext_vector_type(2)));
    __device__ __forceinline__ void operator()(const i32x4 (&acc)[2][2][4][2], const Unit& u, int wr, int wc, int fr, int fq) const {
        const int row0 = u.pm * BM + wr * 64 + fr, col0 = u.pn * HALF + wc * 32 + 8 * fq;
        f2 kz[4], ku[4];
#pragma unroll
        for (int i = 0; i < 4; i += 2) { const f32x4 sg4 = *(const f32x4*)(colmax + col0 + 2 * i) * (1.0f / 127.0f), su4 = *(const f32x4*)(colmax + ldc + col0 + 2 * i) * (1.0f / 127.0f);
            const f2 sga = {sg4.x, sg4.y}, sgb = {sg4.z, sg4.w}, sua = {su4.x, su4.y}, sub = {su4.z, su4.w};
            kz[i] = sga * -1.4426950408889634f; ku[i] = sga * sua; kz[i + 1] = sgb * -1.4426950408889634f; ku[i + 1] = sgb * sub; }
        float rs[2][4];
#pragma unroll
        for (int ai = 0; ai < 2; ++ai)
#pragma unroll
            for (int m = 0; m < 4; ++m) rs[ai][m] = sA[row0 + ai * HALF + m * 16];
#pragma unroll
        for (int ai = 0; ai < 2; ++ai)
#pragma unroll
            for (int m = 0; m < 4; ++m) { bf16_t* p = O + (size_t)(row0 + ai * HALF + m * 16) * ldc + col0;
                const float r = rs[ai][m]; const f2 rr = {r, r}, r2 = rr * rr; u32x4 w;
#pragma unroll
                for (int i = 0; i < 4; ++i) { const i32x4 G = acc[ai][0][m][i >> 1], U = acc[ai][1][m][i >> 1];
                    const i2 gi = (i & 1) ? i2{G.z, G.w} : i2{G.x, G.y}, ui = (i & 1) ? i2{U.z, U.w} : i2{U.x, U.y};
                    const f2 a = __builtin_convertvector(gi, f2), b = __builtin_convertvector(ui, f2);
                    const f2 z = a * (kz[i] * rr);
                    f2 ex; ex.x = __builtin_amdgcn_exp2f(z.x); ex.y = __builtin_amdgcn_exp2f(z.y);
                    const f2 d = ex + 1.0f;
                    f2 q; q.x = __builtin_amdgcn_rcpf(d.x); q.y = __builtin_amdgcn_rcpf(d.y);
                    const f2 o = (a * b) * (ku[i] * r2) * q;
                    w[i] = cvt_pk_bf16(o.x, o.y); }
                *(u32x4*)p = w; }
    }
};
struct EpiResid {
    static constexpr bool PERM = false, AFTER_DRAIN = false;
    const float* base; float* out; int ldc; float alpha;
    __device__ __forceinline__ void operator()(const f32x4 (&acc)[2][2][4][2], const Unit& u, int wr, int wc, int fr, int fq) const {
        const int row0 = u.pm * BM + wr * 64 + fr, col0 = u.pn * BM + wc * 32 + 4 * fq;
#pragma unroll
        for (int ai = 0; ai < 2; ++ai)
#pragma unroll
            for (int m = 0; m < 4; ++m) { const size_t off = (size_t)(row0 + ai * HALF + m * 16) * ldc + col0;
#pragma unroll
                for (int bj = 0; bj < 2; ++bj)
#pragma unroll
                    for (int n = 0; n < 2; ++n) { const f32x4 b = *(const f32x4*)(base + off + bj * HALF + n * 16); *(f32x4*)(out + off + bj * HALF + n * 16) = b + acc[ai][bj][m][n] * alpha; }
                asm volatile("" ::: "memory"); }
    }
};
template <int DH> struct EpiRope {
    static constexpr bool PERM = true, AFTER_DRAIN = false;
    bf16_t *dq, *dk, *dv; int ldq, ldk, ldv, nq, nk; float qscale; const float *cosT, *sinT;
    __device__ __forceinline__ void operator()(const f32x4 (&acc)[2][2][4][2], const Unit& u, int wr, int wc, int fr, int fq) const {
        const int row0 = u.pm * BM + wr * 64 + fr;
        if (u.pn >= nq + nk) {
            const int col0 = (u.pn - nq - nk) * BM + wc * 32 + 8 * fq;
#pragma unroll
            for (int ai = 0; ai < 2; ++ai)
#pragma unroll
                for (int m = 0; m < 4; ++m) { bf16_t* p = dv + (size_t)(row0 + ai * HALF + m * 16) * ldv + col0;
#pragma unroll
                    for (int bj = 0; bj < 2; ++bj) { const f32x4 v0 = acc[ai][bj][m][0], v1 = acc[ai][bj][m][1];
                        u32x4 w; w.x = cvt_pk_bf16(v0[0], v0[1]); w.y = cvt_pk_bf16(v0[2], v0[3]); w.z = cvt_pk_bf16(v1[0], v1[1]); w.w = cvt_pk_bf16(v1[2], v1[3]);
                        *(u32x4*)(p + bj * HALF) = w; } }
            return;
        }
        const bool isq = u.pn < nq; bf16_t* dst = isq ? dq : dk; const int ld = isq ? ldq : ldk, pt = isq ? u.pn : u.pn - nq; const float sc = isq ? qscale : 1.0f;
        constexpr int HD2 = DH / 2, HPT = BM / DH;
        const int t = wc * 32 + 8 * fq, hl = t / HD2, i0 = t % HD2, col1 = (HPT * pt + hl) * DH + i0;
#pragma unroll
        for (int ai = 0; ai < 2; ++ai)
#pragma unroll
            for (int m = 0; m < 4; ++m) { const int row = row0 + ai * HALF + m * 16;
                const f32x4 c0 = *(const f32x4*)(cosT + (size_t)row * HD2 + i0), c1 = *(const f32x4*)(cosT + (size_t)row * HD2 + i0 + 4);
                const f32x4 s0 = *(const f32x4*)(sinT + (size_t)row * HD2 + i0), s1 = *(const f32x4*)(sinT + (size_t)row * HD2 + i0 + 4);
                const f32x4 xa0 = acc[ai][0][m][0], xa1 = acc[ai][0][m][1], xb0 = acc[ai][1][m][0], xb1 = acc[ai][1][m][1];
                const f32x4 o10 = (xa0 * c0 - xb0 * s0) * sc, o11 = (xa1 * c1 - xb1 * s1) * sc, o20 = (xb0 * c0 + xa0 * s0) * sc, o21 = (xb1 * c1 + xa1 * s1) * sc;
                bf16_t* p = dst + (size_t)row * ld + col1;
                u32x4 w; w.x = cvt_pk_bf16(o10[0], o10[1]); w.y = cvt_pk_bf16(o10[2], o10[3]); w.z = cvt_pk_bf16(o11[0], o11[1]); w.w = cvt_pk_bf16(o11[2], o11[3]);
                *(u32x4*)p = w;
                w.x = cvt_pk_bf16(o20[0], o20[1]); w.y = cvt_pk_bf16(o20[2], o20[3]); w.z = cvt_pk_bf16(o21[0], o21[1]); w.w = cvt_pk_bf16(o21[2], o21[3]);
                *(u32x4*)(p + HD2) = w;
                asm volatile("" ::: "memory"); }
    }
};
template <int DH> struct EpiRope8 {
    static constexpr bool PERM = true, AFTER_DRAIN = false;
    bf16_t *dq, *dk, *dv; int ldq, ldk, ldv, nq, nk; float qscale; const float *cosT, *sinT; const float* sA; const float* colmax;
    __device__ __forceinline__ void operator()(const i32x4 (&acc)[2][2][4][2], const Unit& u, int wr, int wc, int fr, int fq) const {
        const int row0 = u.pm * BM + wr * 64 + fr;
        float rs[2][4];
#pragma unroll
        for (int ai = 0; ai < 2; ++ai)
#pragma unroll
            for (int m = 0; m < 4; ++m) rs[ai][m] = sA[row0 + ai * HALF + m * 16];
        if (u.pn >= nq + nk) {
            const int col0 = (u.pn - nq - nk) * BM + wc * 32 + 8 * fq, src0 = u.pn * BM + wc * 32 + 8 * fq;
            f32x4 sc[2][2];
#pragma unroll
            for (int bj = 0; bj < 2; ++bj) { sc[bj][0] = *(const f32x4*)(colmax + src0 + bj * HALF) * (1.0f / 127.0f); sc[bj][1] = *(const f32x4*)(colmax + src0 + bj * HALF + 4) * (1.0f / 127.0f); }
#pragma unroll
            for (int ai = 0; ai < 2; ++ai)
#pragma unroll
                for (int m = 0; m < 4; ++m) { bf16_t* p = dv + (size_t)(row0 + ai * HALF + m * 16) * ldv + col0; const float r = rs[ai][m];
#pragma unroll
                    for (int bj = 0; bj < 2; ++bj) { const f32x4 v0 = __builtin_convertvector(acc[ai][bj][m][0], f32x4) * sc[bj][0] * r, v1 = __builtin_convertvector(acc[ai][bj][m][1], f32x4) * sc[bj][1] * r;
                        u32x4 w; w.x = cvt_pk_bf16(v0[0], v0[1]); w.y = cvt_pk_bf16(v0[2], v0[3]); w.z = cvt_pk_bf16(v1[0], v1[1]); w.w = cvt_pk_bf16(v1[2], v1[3]);
                        *(u32x4*)(p + bj * HALF) = w; } }
            return;
        }
        const bool isq = u.pn < nq; bf16_t* dst = isq ? dq : dk; const int ld = isq ? ldq : ldk, pt = isq ? u.pn : u.pn - nq; const float scq = isq ? qscale : 1.0f;
        constexpr int HD2 = DH / 2, HPT = BM / DH;
        const int t = wc * 32 + 8 * fq, hl = t / HD2, i0 = t % HD2, col1 = (HPT * pt + hl) * DH + i0, src1 = (HPT * u.pn + hl) * DH + i0;
        const f32x4 sa0 = *(const f32x4*)(colmax + src1) * (1.0f / 127.0f), sa1 = *(const f32x4*)(colmax + src1 + 4) * (1.0f / 127.0f);
        const f32x4 sb0 = *(const f32x4*)(colmax + src1 + HD2) * (1.0f / 127.0f), sb1 = *(const f32x4*)(colmax + src1 + HD2 + 4) * (1.0f / 127.0f);
#pragma unroll
        for (int ai = 0; ai < 2; ++ai)
#pragma unroll
            for (int m = 0; m < 4; ++m) { const int row = row0 + ai * HALF + m * 16; const float r = rs[ai][m];
                const f32x4 c0 = *(const f32x4*)(cosT + (size_t)row * HD2 + i0), c1 = *(const f32x4*)(cosT + (size_t)row * HD2 + i0 + 4);
                const f32x4 s0 = *(const f32x4*)(sinT + (size_t)row * HD2 + i0), s1 = *(const f32x4*)(sinT + (size_t)row * HD2 + i0 + 4);
                const f32x4 xa0 = __builtin_convertvector(acc[ai][0][m][0], f32x4) * sa0 * r, xa1 = __builtin_convertvector(acc[ai][0][m][1], f32x4) * sa1 * r;
                const f32x4 xb0 = __builtin_convertvector(acc[ai][1][m][0], f32x4) * sb0 * r, xb1 = __builtin_convertvector(acc[ai][1][m][1], f32x4) * sb1 * r;
                const f32x4 o10 = (xa0 * c0 - xb0 * s0) * scq, o11 = (xa1 * c1 - xb1 * s1) * scq, o20 = (xb0 * c0 + xa0 * s0) * scq, o21 = (xb1 * c1 + xa1 * s1) * scq;
                bf16_t* p = dst + (size_t)row * ld + col1;
                u32x4 w; w.x = cvt_pk_bf16(o10[0], o10[1]); w.y = cvt_pk_bf16(o10[2], o10[3]); w.z = cvt_pk_bf16(o11[0], o11[1]); w.w = cvt_pk_bf16(o11[2], o11[3]);
                *(u32x4*)p = w;
                w.x = cvt_pk_bf16(o20[0], o20[1]); w.y = cvt_pk_bf16(o20[2], o20[3]); w.z = cvt_pk_bf16(o21[0], o21[1]); w.w = cvt_pk_bf16(o21[2], o21[3]);
                *(u32x4*)(p + HD2) = w;
                asm volatile("" ::: "memory"); }
    }
};
struct EpiResid8 {
    static constexpr bool PERM = true, AFTER_DRAIN = false;
    const float* base; bf16_t* xr; int ldc; float alpha; const float* sA; const float* colmax;
    __device__ __forceinline__ void operator()(const i32x4 (&acc)[2][2][4][2], const Unit& u, int wr, int wc, int fr, int fq) const {
        const int row0 = u.pm * BM + wr * 64 + fr, col0 = u.pn * BM + wc * 32 + 8 * fq;
        f32x4 sc[2][2];
#pragma unroll
        for (int bj = 0; bj < 2; ++bj)
#pragma unroll
            for (int n = 0; n < 2; ++n) sc[bj][n] = *(const f32x4*)(colmax + col0 + bj * HALF + n * 4) * (alpha * (1.0f / 127.0f));
        float rs[2][4];
#pragma unroll
        for (int ai = 0; ai < 2; ++ai)
#pragma unroll
            for (int m = 0; m < 4; ++m) rs[ai][m] = sA[row0 + ai * HALF + m * 16];
        if (!base) {
#pragma unroll
            for (int ai = 0; ai < 2; ++ai) {
                u32x4 w[2][4][2];
#pragma unroll
                for (int m = 0; m < 4; ++m)
#pragma unroll
                    for (int bj = 0; bj < 2; ++bj) w[ai][m][bj] = *(const u32x4*)(xr + (size_t)(row0 + ai * HALF + m * 16) * ldc + col0 + bj * HALF);
#pragma unroll
                for (int m = 0; m < 4; ++m) { const size_t off = (size_t)(row0 + ai * HALF + m * 16) * ldc + col0; const float r = rs[ai][m];
#pragma unroll
                    for (int bj = 0; bj < 2; ++bj) { const u32x4 x = w[ai][m][bj]; f32x4 b0, b1;
                        b0[0] = __builtin_bit_cast(float, x.x << 16); b0[1] = __builtin_bit_cast(float, x.x & 0xffff0000u); b0[2] = __builtin_bit_cast(float, x.y << 16); b0[3] = __builtin_bit_cast(float, x.y & 0xffff0000u);
                        b1[0] = __builtin_bit_cast(float, x.z << 16); b1[1] = __builtin_bit_cast(float, x.z & 0xffff0000u); b1[2] = __builtin_bit_cast(float, x.w << 16); b1[3] = __builtin_bit_cast(float, x.w & 0xffff0000u);
                        const f32x4 o0 = b0 + __builtin_convertvector(acc[ai][bj][m][0], f32x4) * sc[bj][0] * r, o1 = b1 + __builtin_convertvector(acc[ai][bj][m][1], f32x4) * sc[bj][1] * r;
                        u32x4 y; y.x = cvt_pk_bf16(o0[0], o0[1]); y.y = cvt_pk_bf16(o0[2], o0[3]); y.z = cvt_pk_bf16(o1[0], o1[1]); y.w = cvt_pk_bf16(o1[2], o1[3]);
                        *(u32x4*)(xr + off + bj * HALF) = y; } }
                asm volatile("" ::: "memory"); }
            return;
        }
#pragma unroll
        for (int ai = 0; ai < 2; ++ai)
#pragma unroll
            for (int m = 0; m < 4; ++m) { const size_t off = (size_t)(row0 + ai * HALF + m * 16) * ldc + col0; const float r = rs[ai][m];
#pragma unroll
                for (int bj = 0; bj < 2; ++bj) { const f32x4 b0 = *(const f32x4*)(base + off + bj * HALF), b1 = *(const f32x4*)(base + off + bj * HALF + 4);
                    const f32x4 o0 = b0 + __builtin_convertvector(acc[ai][bj][m][0], f32x4) * sc[bj][0] * r, o1 = b1 + __builtin_convertvector(acc[ai][bj][m][1], f32x4) * sc[bj][1] * r;
                    u32x4 y; y.x = cvt_pk_bf16(o0[0], o0[1]); y.y = cvt_pk_bf16(o0[2], o0[3]); y.z = cvt_pk_bf16(o1[0], o1[1]); y.w = cvt_pk_bf16(o1[2], o1[3]);
                    *(u32x4*)(xr + off + bj * HALF) = y; }
                asm volatile("" ::: "memory"); }
    }
};
template <class Epi, class Sched, bool ALIGN_EPI = false, bool SP2 = false, bool TA = false, bool TB = false, bool I8 = false>
__device__ __forceinline__ void gemm_phase(PG8_LAS unsigned char* lds, const Gemm g, const Sched& S, const Epi& E) {
    const int tid = threadIdx.x, wid = __builtin_amdgcn_readfirstlane(tid >> 6), lane = tid & 63, wr = wid >> 2, wc = wid & 3, fr = lane & 15, fq = lane >> 4;
    const int KB = I8 ? g.K : 2 * g.K, nt = KB / (BK * 2);
    unsigned voffA[2], voffB[2];
#pragma unroll
    for (int i = 0; i < 2; ++i) { int R, C; stage_rc(tid * 16 + i * 8192, R, C); const int Rb = Epi::PERM ? ((R & ~31) + perm32(R & 31)) : R;
        voffA[i] = (unsigned)(R * (TA ? BK * 2 : KB) + C * 2); voffB[i] = (unsigned)(Rb * (TB ? BK * 2 : KB) + C * 2); }
    const size_t kstepA = TA ? (size_t)(BM * BK * 2) : (size_t)(BK * 2), kstepB = TB ? (size_t)(BM * BK * 2) : (size_t)(BK * 2);
    const size_t hstepA = TA ? (size_t)(HALF * BK * 2) : (size_t)HALF * KB, hstepB = TB ? (size_t)(HALF * BK * 2) : (size_t)HALF * KB;
    const size_t tstep = (size_t)BM * KB;
    const unsigned ldsw = (unsigned)wid * 1024u;
    const int aoff = lds_byte(wr * 64 + fr, fq * 8), boff = lds_byte(wc * 32 + fr, fq * 8);
#define PG8_SA(b, h) (((b) * 2 + (h)) * HTB)
#define PG8_SB(b, h) ((4 + (b) * 2 + (h)) * HTB)
#define PG8_STAGE(bufoff, gbase, voff) do { _Pragma("unroll") for (int _i = 0; _i < 2; ++_i) \
        __builtin_amdgcn_global_load_lds((const unsigned*)((const char*)(gbase) + (voff)[_i]), (PG8_LAS unsigned*)(lds + (bufoff) + ldsw + _i * 8192), 16, 0, 0); } while (0)
#define PG8_LDA(dst, b, h) do { _Pragma("unroll") for (int m = 0; m < 4; ++m) _Pragma("unroll") for (int k = 0; k < 2; ++k) dst[m][k] = *(const PG8_LAS bf16x8*)(lds + PG8_SA(b, h) + aoff + m * 2048 + k * 1024); } while (0)
#define PG8_LDB(dst, b, h) do { _Pragma("unroll") for (int n = 0; n < 2; ++n) _Pragma("unroll") for (int k = 0; k < 2; ++k) dst[n][k] = *(const PG8_LAS bf16x8*)(lds + PG8_SB(b, h) + boff + n * 2048 + k * 1024); } while (0)
#define PG8_MMA(ai, bj, At, Bt) do { __builtin_amdgcn_s_setprio(1); _Pragma("unroll") for (int m = 0; m < 4; ++m) _Pragma("unroll") for (int n = 0; n < 2; ++n) _Pragma("unroll") for (int k = 0; k < 2; ++k) \
        acc[ai][bj][m][n] = mma16(Bt[n][k], At[m][k], acc[ai][bj][m][n]); __builtin_amdgcn_s_setprio(0); } while (0)
#define PG8_WAIT_V(n) asm volatile("s_waitcnt vmcnt(" #n ")" ::: "memory")
#define PG8_WAIT_L(n) asm volatile("s_waitcnt lgkmcnt(" #n ")" ::: "memory")
#define PG8_BAR __builtin_amdgcn_s_barrier()
#define PG8_SCHED __builtin_amdgcn_sched_barrier(0)
    Unit cur, nxt; int ui = 0;
    if (!S.next(0, cur)) return;
    typedef typename AccType<I8>::type accv;
    accv acc[2][2][4][2];
#pragma unroll
    for (int a = 0; a < 2; ++a)
#pragma unroll
        for (int b = 0; b < 2; ++b)
#pragma unroll
            for (int m = 0; m < 4; ++m)
#pragma unroll
                for (int n = 0; n < 2; ++n) acc[a][b][m][n] = (accv){0, 0, 0, 0};
    bf16x8 At[4][2], B0[2][2], B1[2][2];
    const char* cA = (const char*)g.A + (size_t)cur.pm * tstep; const char* cB = (const char*)g.Bt + (size_t)cur.pn * tstep;
    S.a_ready(cur);
    if constexpr (SP2) {
        PG8_STAGE(PG8_SB(0, 0), cB, voffB); PG8_STAGE(PG8_SB(0, 1), cB + hstepB, voffB); PG8_STAGE(PG8_SA(0, 0), cA, voffA); PG8_STAGE(PG8_SA(0, 1), cA + hstepA, voffA);
        if (wr == 1) PG8_BAR;
        PG8_WAIT_V(2); PG8_BAR;
        PG8_STAGE(PG8_SB(1, 0), cB + kstepB, voffB); PG8_STAGE(PG8_SA(1, 0), cA + kstepA, voffA); PG8_STAGE(PG8_SB(1, 1), cB + hstepB + kstepB, voffB);
        PG8_WAIT_V(6); PG8_BAR;
    } else {
        PG8_STAGE(PG8_SB(0, 0), cB, voffB); PG8_STAGE(PG8_SA(0, 0), cA, voffA); PG8_STAGE(PG8_SB(0, 1), cB + hstepB, voffB); PG8_STAGE(PG8_SA(0, 1), cA + hstepA, voffA);
        if (wr == 1) PG8_BAR;
        PG8_WAIT_V(4); PG8_BAR;
        PG8_STAGE(PG8_SB(1, 0), cB + kstepB, voffB); PG8_STAGE(PG8_SA(1, 0), cA + kstepA, voffA); PG8_STAGE(PG8_SB(1, 1), cB + hstepB + kstepB, voffB);
        PG8_WAIT_V(6); PG8_BAR;
    }
    for (;;) {
        const bool has_next = S.next(ui + 1, nxt);
        const char* nA = has_next ? (const char*)g.A + (size_t)nxt.pm * tstep : cA; const char* nB = has_next ? (const char*)g.Bt + (size_t)nxt.pn * tstep : cB;
        for (int t = 0; t < nt; t += 2) {
            const bool last = (t == nt - 2);
            const char* a1 = cA + (size_t)(t + 1) * kstepA;
            const char* a2 = last ? nA : cA + (size_t)(t + 2) * kstepA; const char* b2 = last ? nB : cB + (size_t)(t + 2) * kstepB;
            const char* a3 = a2 + kstepA; const char* b3 = b2 + kstepB;
            if (last && has_next) S.a_ready(nxt);
            if constexpr (SP2) {
            PG8_LDB(B0, 0, 0); PG8_LDB(B1, 0, 1); PG8_SCHED; PG8_LDA(At, 0, 0); PG8_STAGE(PG8_SA(1, 1), a1 + hstepA, voffA);
            PG8_WAIT_V(8); PG8_WAIT_L(0); PG8_BAR; PG8_MMA(0, 0, At, B0); PG8_MMA(0, 1, At, B1); PG8_BAR; PG8_SCHED;
            PG8_LDA(At, 0, 1); PG8_STAGE(PG8_SB(0, 0), b2, voffB); PG8_STAGE(PG8_SB(0, 1), b2 + hstepB, voffB); PG8_STAGE(PG8_SA(0, 0), a2, voffA);
            PG8_WAIT_V(8); PG8_WAIT_L(0); PG8_BAR; PG8_MMA(1, 0, At, B0); PG8_MMA(1, 1, At, B1); PG8_BAR; PG8_SCHED;
            PG8_LDB(B0, 1, 0); PG8_LDB(B1, 1, 1); PG8_SCHED; PG8_LDA(At, 1, 0); PG8_STAGE(PG8_SA(0, 1), a2 + hstepA, voffA);
            PG8_WAIT_V(8); PG8_WAIT_L(0); PG8_BAR; PG8_MMA(0, 0, At, B0); PG8_MMA(0, 1, At, B1); PG8_BAR; PG8_SCHED;
            PG8_LDA(At, 1, 1); PG8_STAGE(PG8_SB(1, 0), b3, voffB); PG8_STAGE(PG8_SB(1, 1), b3 + hstepB, voffB); PG8_STAGE(PG8_SA(1, 0), a3, voffA);
            PG8_WAIT_V(8); PG8_WAIT_L(0); PG8_BAR; PG8_MMA(1, 0, At, B0); PG8_MMA(1, 1, At, B1); PG8_BAR; PG8_SCHED;
            } else {
            PG8_LDB(B0, 0, 0); PG8_SCHED; PG8_LDA(At, 0, 0); PG8_STAGE(PG8_SA(1, 1), a1 + hstepA, voffA);
            PG8_WAIT_L(8); PG8_BAR; PG8_WAIT_L(0); PG8_MMA(0, 0, At, B0); PG8_BAR; PG8_SCHED;
            PG8_LDB(B1, 0, 1); PG8_STAGE(PG8_SB(0, 0), b2, voffB);
            PG8_BAR; PG8_WAIT_L(0); PG8_MMA(0, 1, At, B1); PG8_BAR;
            PG8_LDA(At, 0, 1); PG8_STAGE(PG8_SA(0, 0), a2, voffA);
            PG8_BAR; PG8_WAIT_L(0); PG8_MMA(1, 0, At, B0); PG8_BAR; PG8_SCHED;
            PG8_STAGE(PG8_SB(0, 1), b2 + hstepB, voffB);
            PG8_WAIT_V(6); PG8_BAR; PG8_MMA(1, 1, At, B1); PG8_BAR;
            PG8_LDB(B0, 1, 0); PG8_SCHED; PG8_LDA(At, 1, 0); PG8_STAGE(PG8_SA(0, 1), a2 + hstepA, voffA);
            PG8_WAIT_L(8); PG8_BAR; PG8_WAIT_L(0); PG8_MMA(0, 0, At, B0); PG8_BAR; PG8_SCHED;
            PG8_LDB(B1, 1, 1); PG8_STAGE(PG8_SB(1, 0), b3, voffB);
            PG8_BAR; PG8_WAIT_L(0); PG8_MMA(0, 1, At, B1); PG8_BAR;
            PG8_LDA(At, 1, 1); PG8_STAGE(PG8_SA(1, 0), a3, voffA);
            PG8_BAR; PG8_WAIT_L(0); PG8_MMA(1, 0, At, B0); PG8_BAR; PG8_SCHED;
            PG8_STAGE(PG8_SB(1, 1), b3 + hstepB, voffB);
            PG8_WAIT_V(6); PG8_BAR; PG8_MMA(1, 1, At, B1); PG8_BAR;
            }
        }
        if constexpr (ALIGN_EPI) { if (wr == 0) PG8_BAR; }
        if constexpr (!Epi::AFTER_DRAIN) { E(acc, cur, wr, wc, fr, fq); S.done(cur); }
        if (!has_next) break;
#pragma unroll
        for (int a = 0; a < 2; ++a)
#pragma unroll
            for (int b = 0; b < 2; ++b)
#pragma unroll
                for (int m = 0; m < 4; ++m)
#pragma unroll
                    for (int n = 0; n < 2; ++n) acc[a][b][m][n] = (accv){0, 0, 0, 0};
        cur = nxt; cA = nA; cB = nB; ++ui;
        if constexpr (ALIGN_EPI) { if (wr == 1) PG8_BAR; }
    }
    PG8_WAIT_V(0);
    if constexpr (!ALIGN_EPI) { if (wr == 0) PG8_BAR; }
    PG8_BAR;
    if constexpr (Epi::AFTER_DRAIN) { E.fused(acc, cur, wr, wc, fr, fq, lds, wid, lane); S.done(cur); }
#undef PG8_SA
#undef PG8_SB
#undef PG8_STAGE
#undef PG8_LDA
#undef PG8_LDB
#undef PG8_MMA
#undef PG8_WAIT_V
#undef PG8_WAIT_L
#undef PG8_BAR
#undef PG8_SCHED
}
}
constexpr int NWAVES = 8;
#ifndef MK_SPLIT
#define MK_SPLIT 0
#endif
#ifndef PG8_SP2
#define PG8_SP2 true
#endif
#ifndef PG8_ALIGN
#define PG8_ALIGN true
#endif
#ifndef XN_TILED
#define XN_TILED false
#endif
constexpr int N_PHASES = 31;

constexpr int SEQ = 16384, DM = 4096, DFF = 11008, M = SEQ;
constexpr int A_H = 32, A_D = 128, A_KVW = 1024, NQKV = 6144;
constexpr int B_H = 64, B_D = 64, B_KVW = 512;
constexpr int NBLK = 64;
constexpr float RMS_EPS = 1e-6f;
constexpr float LOG2E = 1.4426950408889634f;

constexpr size_t MiB = 1u << 20;
constexpr size_t WS_CTL = 0, CTL_ZERO_BYTES = 1 * MiB;
constexpr size_t SZ_WIN = 172 * MiB, SZ_WOUT = 86 * MiB;
constexpr size_t WS_WIN = 1 * MiB;
constexpr size_t WS_WOUT = WS_WIN + 4 * SZ_WIN;
constexpr size_t WS_WQKV = WS_WOUT + 4 * SZ_WOUT;
constexpr size_t WS_WAO = WS_WQKV + 48 * MiB;
constexpr size_t WS_WKV = WS_WAO + 32 * MiB;
constexpr size_t WS_WBQ = WS_WKV + 8 * MiB;
constexpr size_t WS_WBO = WS_WBQ + 32 * MiB;
constexpr size_t WS_XN = WS_WBO + 32 * MiB;
constexpr size_t WS_ACT = WS_XN + 128 * MiB;
constexpr size_t WS_Q = WS_ACT + 344 * MiB;
constexpr size_t WS_K = WS_Q + 128 * MiB;
constexpr size_t WS_V = WS_K + 32 * MiB;
constexpr size_t WS_O = WS_V + 32 * MiB;
constexpr size_t WS_KSH = WS_O + 128 * MiB;
constexpr size_t WS_VSH = WS_KSH + 16 * MiB;
constexpr size_t WS_ROPEA = WS_VSH + 16 * MiB;
constexpr size_t WS_ROPEB = WS_ROPEA + 8 * MiB;
constexpr size_t WS_KMEAN = WS_ROPEB + 4 * MiB;
constexpr size_t WS_LIST = WS_KMEAN + 1 * MiB;
constexpr size_t WS_PARTO = WS_LIST + 63 * MiB;
constexpr size_t WS_PARTML = WS_PARTO + 512 * MiB;
constexpr size_t WS_XN8 = WS_PARTML + 16 * MiB;
constexpr size_t WS_SA = WS_XN8 + 64 * MiB;
constexpr size_t WS_ACT8 = WS_SA + 1 * MiB;
constexpr size_t WS_SACT = WS_ACT8 + 172 * MiB;
constexpr size_t WS_END = WS_SACT + 1 * MiB;
static_assert(SZ_WIN == (size_t)22016 * 4096 * 2 && SZ_WOUT == (size_t)4096 * 11008 * 2, "weight sizes");
constexpr int CW_TMO = 0, CW_CODE = 1;
constexpr int CW_BAR = 4096;
constexpr int CW_CLAIM = 12288;
constexpr int CW_COLMAX = 32768;
constexpr int CW_LBAR = 200704, CW_LFLAG = 204800;
constexpr int CW_UPARR = 205824;
constexpr int CW_CNT = 8192;

constexpr int RING_OFF = 0, RING_BYTES = 131072;
constexpr int LDSCTL_OFF = 146944, MISC_OFF = LDSCTL_OFF + 256;
constexpr int LDS_BYTES = 147456;
static_assert(MISC_OFF + 128 <= 147456 && RING_BYTES <= LDSCTL_OFF, "LDS map");

#define GAS __attribute__((address_space(1)))
#define LAS __attribute__((address_space(3)))
#define DI __device__ __forceinline__
typedef unsigned short bf16;
typedef unsigned v4u __attribute__((ext_vector_type(4)));
typedef unsigned v2u __attribute__((ext_vector_type(2)));
typedef float f32x4 __attribute__((ext_vector_type(4)));
typedef float f32x16 __attribute__((ext_vector_type(16)));
typedef short bf16x8 __attribute__((ext_vector_type(8)));
typedef short s16x4 __attribute__((ext_vector_type(4)));
typedef GAS unsigned gu32;
#define RLX_AGENT __ATOMIC_RELAXED, __HIP_MEMORY_SCOPE_AGENT
#define LDS_WAIT() asm volatile("s_waitcnt lgkmcnt(0)" ::: "memory")
#define VM_WAIT() asm volatile("s_waitcnt vmcnt(0)" ::: "memory")
DI unsigned f2bf(float f) { unsigned u = __builtin_bit_cast(unsigned, f); return (u + 0x7fffu + ((u >> 16) & 1u)) >> 16; }
DI unsigned pk2(float lo, float hi) { return f2bf(lo) | (f2bf(hi) << 16); }
DI float bf2f(unsigned b) { return __builtin_bit_cast(float, b << 16); }
#define XB_TMO      128
#define XB_XCNT(j)  (256  + 64 * (j))
#define XB_XSUB(j)  (1280 + 64 * (j))
#define XB_XGEN(j)  (2304 + 64 * (j))
#define XB_TOP      3328
#define XB_TOPGEN   3392
#define XCD_BAR_WORDS 3456
#define XB_SPIN_CAP (1u << 18)

__device__ __forceinline__ unsigned xb_ld(unsigned* p)              { return __hip_atomic_load(p, __ATOMIC_RELAXED, __HIP_MEMORY_SCOPE_AGENT); }
__device__ __forceinline__ unsigned xb_add(unsigned* p, unsigned v) { return __hip_atomic_fetch_add(p, v, __ATOMIC_RELAXED, __HIP_MEMORY_SCOPE_AGENT); }
__device__ __forceinline__ unsigned xb_xcc_id() { return (unsigned)__builtin_amdgcn_s_getreg((3 << 11) | 20) & 0xFu; }
#define XB_SPIN(cond, bar) do { unsigned _sp = 0; while (cond) { __builtin_amdgcn_s_sleep(1); \
    if ((++_sp & 255u) == 0u) { if (xb_ld(&(bar)[XB_TMO])) break; if (_sp > XB_SPIN_CAP) { atomicAdd(&(bar)[XB_TMO], 1u); break; } } } } while (0)

struct XcdBarrier {
    unsigned* bar; unsigned x;
    volatile LAS unsigned* st;
};

__device__ __forceinline__ XcdBarrier xcd_barrier_post(unsigned* bar, volatile LAS unsigned* st) {
    XcdBarrier b; b.bar = bar; b.x = xb_xcc_id(); b.st = st;
    if (threadIdx.x == 0) (void)xb_add(&bar[XB_XCNT(b.x)], 1u);
    return b;
}
__device__ __forceinline__ void xcd_barrier_complete(unsigned* bar, unsigned x, unsigned& nloc, unsigned& nx) {
    const unsigned G = gridDim.x * gridDim.y * gridDim.z;
    unsigned sum, cnt, mine, sp = 0u;
    for (;;) {
        sum = 0u; cnt = 0u; mine = 0u;
#pragma unroll
        for (unsigned j = 0; j < 16; ++j) { const unsigned c = xb_ld(&bar[XB_XCNT(j)]); sum += c; cnt += (c > 0u) ? 1u : 0u; mine = (j == x) ? c : mine; }
        if (sum == G) break;
        __builtin_amdgcn_s_sleep(1);
        if ((++sp & 255u) == 0u) { if (xb_ld(&bar[XB_TMO])) break; if (sp > XB_SPIN_CAP) { atomicAdd(&bar[XB_TMO], 1u); break; } }
    }
    nloc = mine > 0u ? mine : 1u; nx = cnt > 0u ? cnt : 1u;
}

__device__ __forceinline__ void xcd_barrier(const XcdBarrier& b) {
    asm volatile("s_waitcnt vmcnt(0)" ::: "memory");
    __syncthreads();
    if (threadIdx.x == 0) {
        unsigned* bar = b.bar;
        __builtin_amdgcn_s_waitcnt(0);
        unsigned nloc = b.st[0], nx = b.st[1];
        if (nloc == 0u) { xcd_barrier_complete(bar, b.x, nloc, nx); b.st[0] = nloc; b.st[1] = nx; }
        const unsigned old = xb_add(&bar[XB_XSUB(b.x)], 1u);
        const unsigned gen = old / nloc;
        if (old + 1u == (gen + 1u) * nloc) {
            __builtin_amdgcn_fence(__ATOMIC_RELEASE, "agent");
            asm volatile("s_waitcnt vmcnt(0)" ::: "memory");
            const unsigned og = xb_add(&bar[XB_TOP], 1u);
            const unsigned tg = og / nx;
            if (og + 1u == (tg + 1u) * nx) xb_add(&bar[XB_TOPGEN], 1u);
            else XB_SPIN(xb_ld(&bar[XB_TOPGEN]) == tg, bar);
            __builtin_amdgcn_fence(__ATOMIC_ACQUIRE, "agent");
            xb_add(&bar[XB_XGEN(b.x)], 1u);
            asm volatile("s_waitcnt vmcnt(0)" ::: "memory");
        } else {
            XB_SPIN(xb_ld(&bar[XB_XGEN(b.x)]) == gen, bar);
            __builtin_amdgcn_fence(__ATOMIC_ACQUIRE, "agent");
            asm volatile("s_waitcnt vmcnt(0)" ::: "memory");
        }
    }
    __syncthreads();
}

__device__ __forceinline__ void xcd_local_barrier(const XcdBarrier& b, unsigned* lw) {
    asm volatile("s_waitcnt vmcnt(0)" ::: "memory");
    __syncthreads();
    if (threadIdx.x == 0) {
        __builtin_amdgcn_s_waitcnt(0);
        const unsigned nloc = b.st[0];
        const unsigned old = xb_add(&lw[64 * b.x], 1u);
        const unsigned gen = old / nloc;
        if (old + 1u == (gen + 1u) * nloc) xb_add(&lw[1024 + 64 * b.x], 1u);
        else XB_SPIN(xb_ld(&lw[1024 + 64 * b.x]) == gen, b.bar);
        __builtin_amdgcn_fence(__ATOMIC_ACQUIRE, "agent");
        asm volatile("s_waitcnt vmcnt(0)" ::: "memory");
    }
    __syncthreads();
}
struct Frame {
    LAS unsigned char* lds;
    volatile LAS unsigned* MISC;
    gu32* ctl;
    int tid, lane, wave;
    int vcu, G;
    unsigned char* ws;
    const float* x; const float* ffn_norm; const float* ffn_w_in; const float* ffn_w_out; const float* attn_norm; const float* a_w_qkv; const float* a_w_o;
    const float* kv_norm; const float* w_kv; const float* b_w_q; const float* b_sinks; const float* b_w_o; const float* final_norm;
    float* out;
};
DI float wave_sum(float v) {
#pragma unroll
    for (int o = 1; o < 64; o <<= 1) v += __shfl_xor(v, o);
    return v;
}
__device__ const float ROPE_INV[64] = {
1.000000000e+00f, 8.659643531e-01f, 7.498942018e-01f, 6.493816376e-01f, 5.623413324e-01f, 4.869675338e-01f, 4.216965139e-01f, 3.651741147e-01f, 3.162277639e-01f, 2.738419771e-01f, 2.371373922e-01f, 2.053525001e-01f, 1.778279394e-01f, 1.539926529e-01f, 1.333521456e-01f, 1.154782027e-01f,
1.000000015e-01f, 8.659642935e-02f, 7.498941571e-02f, 6.493816525e-02f, 5.623412877e-02f, 4.869675264e-02f, 4.216964915e-02f, 3.651741147e-02f, 3.162277862e-02f, 2.738419734e-02f, 2.371373586e-02f, 2.053524926e-02f, 1.778279431e-02f, 1.539926510e-02f, 1.333521493e-02f, 1.154781971e-02f,
9.999999776e-03f, 8.659643121e-03f, 7.498942316e-03f, 6.493816618e-03f, 5.623413250e-03f, 4.869675264e-03f, 4.216964822e-03f, 3.651741426e-03f, 3.162277862e-03f, 2.738419687e-03f, 2.371373819e-03f, 2.053525066e-03f, 1.778279431e-03f, 1.539926627e-03f, 1.333521446e-03f, 1.154781901e-03f,
1.000000047e-03f, 8.659643354e-04f, 7.498941850e-04f, 6.493816618e-04f, 5.623413017e-04f, 4.869675031e-04f, 4.216965463e-04f, 3.651741135e-04f, 3.162277862e-04f, 2.738419571e-04f, 2.371373848e-04f, 2.053525241e-04f, 1.778279402e-04f, 1.539926452e-04f, 1.333521504e-04f, 1.154782076e-04f };

template <int DROP> DI unsigned f2bf_drop(float f) { unsigned u = __builtin_bit_cast(unsigned, f); constexpr int sh = 16 + DROP; u += ((1u << (sh - 1)) - 1u) + ((u >> sh) & 1u); return ((u >> sh) << DROP) & 0xffffu; }

DI int map_col(int mode, int lim, int c) {
    const int pn = c >> 8, bj = (c >> 7) & 1, t = c & 127;
    if (mode == 1) return bj * DFF + 128 * pn + t;
    if (mode == 2 && c < lim) return (2 * pn + (t >> 6)) * 128 + 64 * bj + (t & 63);
    if (mode == 3 && c < lim) return (4 * pn + (t >> 5)) * 64 + 32 * bj + (t & 31);
    return c;
}
template <bool TILED, int DROP = 0> DI void tr_item(const float* __restrict__ src, const float* __restrict__ gain, bf16* __restrict__ dst, int K, int N, int ld, int mode, int lim, LAS float* scr, int item, int lane) {
    const int nblk = N >> 5, kb = item / nblk, nb = item - kb * nblk, k0 = kb << 6, n0 = nb << 5, s0 = map_col(mode, lim, n0);
    const int kr = lane >> 3, c4 = lane & 7;
    f32x4 v[8]; float g[8];
#pragma unroll
    for (int it = 0; it < 8; ++it) { v[it] = *(const GAS f32x4*)(src + (size_t)(k0 + 8 * it + kr) * ld + s0 + 4 * c4); g[it] = gain ? gain[k0 + 8 * it + kr] : 1.0f; }
#pragma unroll
    for (int it = 0; it < 8; ++it) { LAS float* p = scr + (8 * it + kr) * 33 + 4 * c4; p[0] = v[it].x * g[it]; p[1] = v[it].y * g[it]; p[2] = v[it].z * g[it]; p[3] = v[it].w * g[it]; }
    LDS_WAIT(); asm volatile("" ::: "memory");
#pragma unroll
    for (int j = 0; j < 4; ++j) { const int n = kr + 8 * j; const LAS float* s = scr + (8 * c4) * 33 + n;
#define PKW(a_, b_) (DROP > 0 ? (f2bf_drop<DROP>(a_) | (f2bf_drop<DROP>(b_) << 16)) : pk2(a_, b_))
        v4u o; o.x = PKW(s[0 * 33], s[1 * 33]); o.y = PKW(s[2 * 33], s[3 * 33]); o.z = PKW(s[4 * 33], s[5 * 33]); o.w = PKW(s[6 * 33], s[7 * 33]);
#undef PKW
        *(GAS v4u*)(dst + (TILED ? pg8::tiled_off(n0 + n, k0 + 8 * c4, K) : (size_t)(n0 + n) * K + k0 + 8 * c4)) = o; }
    LDS_WAIT(); asm volatile("" ::: "memory");
}
DI void sincos_acc(float angf, float& s, float& c) {
    const double x = (double)angf, q = __builtin_rint(x * 0.63661977236758134308);
    double r = __builtin_fma(-q, 1.57079632679489655800e+00, x); r = __builtin_fma(-q, 6.12323399573676603587e-17, r);
    const int qi = (int)q & 3; const double r2 = r * r;
    const double sp = r + r * r2 * (-1.0 / 6 + r2 * (1.0 / 120 + r2 * (-1.0 / 5040 + r2 * (1.0 / 362880 + r2 * (-1.0 / 39916800 + r2 * (1.0 / 6227020800.0))))));
    const double cp = 1.0 + r2 * (-0.5 + r2 * (1.0 / 24 + r2 * (-1.0 / 720 + r2 * (1.0 / 40320 + r2 * (-1.0 / 3628800 + r2 * (1.0 / 479001600 + r2 * (-1.0 / 87178291200.0)))))));
    const double ss = (qi & 1) ? cp : sp, cc = (qi & 1) ? sp : cp;
    s = (float)((qi & 2) ? -ss : ss); c = (float)(((qi + 1) & 2) ? -cc : cc);
}
DI void rope_tables(Frame& F) {
    const int gt = (F.vcu * NWAVES + F.wave) * 64 + F.lane, NT = F.G * NWAVES * 64;
    float* ca = (float*)(F.ws + WS_ROPEA); float* sa = ca + (size_t)M * 64; float* cb = (float*)(F.ws + WS_ROPEB); float* sb = cb + (size_t)M * 32;
    for (int e = gt; e < M * 64; e += NT) { const int pos = e >> 6, i = e & 63; float s, c; sincos_acc((float)pos * ROPE_INV[i], s, c); ca[e] = c; sa[e] = s; }
    for (int e = gt; e < M * 32; e += NT) { const int pos = e >> 5, i = e & 31; float s, c; sincos_acc((float)pos * ROPE_INV[2 * i], s, c); cb[e] = c; sb[e] = s; }
}
template <int DROP = 0> DI void norm_rows(Frame& F, const float* x, bf16* xn) {
    const int gw = F.vcu * NWAVES + F.wave, NGW = F.G * NWAVES;
    for (int m = gw; m < M; m += NGW) {
        const GAS f32x4* xr = (const GAS f32x4*)(x + (size_t)m * DM) + F.lane;
        f32x4 v[16]; float s = 0.f;
#pragma unroll
        for (int j = 0; j < 16; ++j) { v[j] = xr[64 * j]; s += (v[j].x * v[j].x + v[j].y * v[j].y) + (v[j].z * v[j].z + v[j].w * v[j].w); }
        const float r = 1.0f / sqrtf(wave_sum(s) * (1.0f / DM) + RMS_EPS);
#pragma unroll
        for (int j = 0; j < 16; ++j) { v2u w; if (DROP > 0) { w.x = f2bf_drop<DROP>(v[j].x * r) | (f2bf_drop<DROP>(v[j].y * r) << 16); w.y = f2bf_drop<DROP>(v[j].z * r) | (f2bf_drop<DROP>(v[j].w * r) << 16); }
            else { w.x = pk2(v[j].x * r, v[j].y * r); w.y = pk2(v[j].z * r, v[j].w * r); } const int col = 256 * j + 4 * F.lane;
            *(GAS v2u*)(xn + (XN_TILED ? pg8::tiled_off(m, col, DM) : (size_t)m * DM + col)) = w; }
    }
}
DI void colmax_item(const float* __restrict__ src, const float* __restrict__ gain, unsigned* cm, int N, int item, int lane) {
    const int ncg = N >> 8, rb = item / ncg, cg = item - rb * ncg; const int c0 = cg * 256 + 4 * lane;
    f32x4 mx = {0.f, 0.f, 0.f, 0.f};
#pragma unroll 8
    for (int r = 0; r < 256; ++r) { const int k = rb * 256 + r; const f32x4 v = *(const GAS f32x4*)(src + (size_t)k * N + c0) * (gain ? gain[k] : 1.0f);
        mx.x = __builtin_fmaxf(mx.x, __builtin_fabsf(v.x)); mx.y = __builtin_fmaxf(mx.y, __builtin_fabsf(v.y)); mx.z = __builtin_fmaxf(mx.z, __builtin_fabsf(v.z)); mx.w = __builtin_fmaxf(mx.w, __builtin_fabsf(v.w)); }
    __hip_atomic_fetch_max(cm + c0 + 0, __builtin_bit_cast(unsigned, mx.x), RLX_AGENT); __hip_atomic_fetch_max(cm + c0 + 1, __builtin_bit_cast(unsigned, mx.y), RLX_AGENT);
    __hip_atomic_fetch_max(cm + c0 + 2, __builtin_bit_cast(unsigned, mx.z), RLX_AGENT); __hip_atomic_fetch_max(cm + c0 + 3, __builtin_bit_cast(unsigned, mx.w), RLX_AGENT);
}
DI unsigned q8x4(float a, float b, float c, float d, float inv) { unsigned w = 0u;
    w = __builtin_amdgcn_cvt_pk_u8_f32(__builtin_rintf(__builtin_fmaf(a, inv, 128.f)), 0, w); w = __builtin_amdgcn_cvt_pk_u8_f32(__builtin_rintf(__builtin_fmaf(b, inv, 128.f)), 1, w);
    w = __builtin_amdgcn_cvt_pk_u8_f32(__builtin_rintf(__builtin_fmaf(c, inv, 128.f)), 2, w); w = __builtin_amdgcn_cvt_pk_u8_f32(__builtin_rintf(__builtin_fmaf(d, inv, 128.f)), 3, w); return w ^ 0x80808080u; }
DI unsigned q8(float v) { const float r = __builtin_rintf(v); const int i = (int)__builtin_fminf(__builtin_fmaxf(r, -127.f), 127.f); return (unsigned)i & 0xffu; }
DI void tr_item8(const float* __restrict__ src, const float* __restrict__ gain, const float* __restrict__ cm, unsigned char* __restrict__ dst, int K, int N, int mode, int lim, int item, LAS float* scr, int lane) {
    const int nblk = N >> 5, kb = item / nblk, nb = item - kb * nblk, k0 = kb << 6, n0 = nb << 5, s0 = map_col(mode, lim, n0);
    const int kr = lane >> 3, c4 = lane & 7;
    f32x4 v[8]; float g[8];
#pragma unroll
    for (int it = 0; it < 8; ++it) { v[it] = *(const GAS f32x4*)(src + (size_t)(k0 + 8 * it + kr) * N + s0 + 4 * c4); g[it] = gain ? gain[k0 + 8 * it + kr] : 1.0f; }
#pragma unroll
    for (int it = 0; it < 8; ++it) { LAS float* p = scr + (8 * it + kr) * 33 + 4 * c4; p[0] = v[it].x * g[it]; p[1] = v[it].y * g[it]; p[2] = v[it].z * g[it]; p[3] = v[it].w * g[it]; }
    LDS_WAIT(); asm volatile("" ::: "memory");
#pragma unroll
    for (int j = 0; j < 4; ++j) { const int n = kr + 8 * j; const LAS float* s = scr + (8 * c4) * 33 + n;
        const float cmx = cm[s0 + n], inv = cmx > 0.f ? 127.0f / cmx : 0.f;
        v2u o; o.x = q8x4(s[0 * 33], s[1 * 33], s[2 * 33], s[3 * 33], inv);
        o.y = q8x4(s[4 * 33], s[5 * 33], s[6 * 33], s[7 * 33], inv);
        const int nn = n0 + n, kk = k0 + 8 * c4;
        *(GAS v2u*)(dst + (size_t)(nn >> 8) * ((size_t)256 * K) + (size_t)(kk >> 7) * (256 * 128) + (size_t)(nn & 255) * 128 + (kk & 127)) = o; }
    LDS_WAIT(); asm volatile("" ::: "memory");
}
DI void strip_quant8(Frame& F, const float* __restrict__ src, const float* __restrict__ gain, float* __restrict__ cm, unsigned char* __restrict__ dst, int K, int N, int mode, int lim, int strip, LAS float* scr, LAS unsigned* cml) {
    const int n0 = strip << 5, s0 = map_col(mode, lim, n0), lane = F.lane, kr = lane >> 3, c4 = lane & 7, nkb = K >> 6;
    if (F.tid < 32) cml[F.tid] = 0u;
    __syncthreads();
    f32x4 mx = {0.f, 0.f, 0.f, 0.f};
#pragma unroll 1
    for (int kb = F.wave; kb < nkb; kb += NWAVES) {
#pragma unroll
        for (int it = 0; it < 8; ++it) { const int k = (kb << 6) + 8 * it + kr; const f32x4 v = *(const GAS f32x4*)(src + (size_t)k * N + s0 + 4 * c4) * (gain ? gain[k] : 1.0f);
            mx.x = __builtin_fmaxf(mx.x, __builtin_fabsf(v.x)); mx.y = __builtin_fmaxf(mx.y, __builtin_fabsf(v.y)); mx.z = __builtin_fmaxf(mx.z, __builtin_fabsf(v.z)); mx.w = __builtin_fmaxf(mx.w, __builtin_fabsf(v.w)); } }
#pragma unroll
    for (int o = 8; o < 64; o <<= 1) { mx.x = __builtin_fmaxf(mx.x, __shfl_xor(mx.x, o)); mx.y = __builtin_fmaxf(mx.y, __shfl_xor(mx.y, o)); mx.z = __builtin_fmaxf(mx.z, __shfl_xor(mx.z, o)); mx.w = __builtin_fmaxf(mx.w, __shfl_xor(mx.w, o)); }
    if (lane < 8) { __hip_atomic_fetch_max(cml + 4 * lane + 0, __builtin_bit_cast(unsigned, mx.x), __ATOMIC_RELAXED, __HIP_MEMORY_SCOPE_WORKGROUP); __hip_atomic_fetch_max(cml + 4 * lane + 1, __builtin_bit_cast(unsigned, mx.y), __ATOMIC_RELAXED, __HIP_MEMORY_SCOPE_WORKGROUP);
                    __hip_atomic_fetch_max(cml + 4 * lane + 2, __builtin_bit_cast(unsigned, mx.z), __ATOMIC_RELAXED, __HIP_MEMORY_SCOPE_WORKGROUP); __hip_atomic_fetch_max(cml + 4 * lane + 3, __builtin_bit_cast(unsigned, mx.w), __ATOMIC_RELAXED, __HIP_MEMORY_SCOPE_WORKGROUP); }
    __syncthreads();
#pragma unroll 1
    for (int kb = F.wave; kb < nkb; kb += NWAVES) { const int k0 = kb << 6;
        f32x4 v[8]; float g[8];
#pragma unroll
        for (int it = 0; it < 8; ++it) { v[it] = *(const GAS f32x4*)(src + (size_t)(k0 + 8 * it + kr) * N + s0 + 4 * c4); g[it] = gain ? gain[k0 + 8 * it + kr] : 1.0f; }
#pragma unroll
        for (int it = 0; it < 8; ++it) { LAS float* p = scr + (8 * it + kr) * 33 + 4 * c4; p[0] = v[it].x * g[it]; p[1] = v[it].y * g[it]; p[2] = v[it].z * g[it]; p[3] = v[it].w * g[it]; }
        LDS_WAIT(); asm volatile("" ::: "memory");
#pragma unroll
        for (int j = 0; j < 4; ++j) { const int n = kr + 8 * j; const LAS float* s = scr + (8 * c4) * 33 + n;
            const float cmx = __builtin_bit_cast(float, cml[n]), inv = cmx > 0.f ? 127.0f / cmx : 0.f;
            v2u o; o.x = q8x4(s[0 * 33], s[1 * 33], s[2 * 33], s[3 * 33], inv);
            o.y = q8x4(s[4 * 33], s[5 * 33], s[6 * 33], s[7 * 33], inv);
            const int nn = n0 + n, kk = k0 + 8 * c4;
            *(GAS v2u*)(dst + (size_t)(nn >> 8) * ((size_t)256 * K) + (size_t)(kk >> 7) * (256 * 128) + (size_t)(nn & 255) * 128 + (kk & 127)) = o; }
        LDS_WAIT(); asm volatile("" ::: "memory"); }
    if (F.tid < 32) cm[s0 + F.tid] = __builtin_bit_cast(float, cml[F.tid]);
    __syncthreads();
}
#ifndef HAD_ON
#define HAD_ON 1
#endif
#ifndef ACT8_TILED
#define ACT8_TILED 0
#endif
DI void fwht_inlane8(float (&v)[8]) {
#pragma unroll
    for (int b = 1; b < 8; b <<= 1)
#pragma unroll
        for (int i = 0; i < 8; ++i) if (!(i & b)) { const float lo = v[i], hi = v[i | b]; v[i] = lo + hi; v[i | b] = lo - hi; }
}
template <int CTRL> DI float dpp_f(float v) { return __builtin_bit_cast(float, __builtin_amdgcn_update_dpp(0, __builtin_bit_cast(int, v), CTRL, 0xf, 0xf, false)); }
DI float swz_xor4(float v) { return __builtin_bit_cast(float, __builtin_amdgcn_ds_swizzle(__builtin_bit_cast(int, v), 0x101f)); }
constexpr int AQ_NIT = 11;
DI void aq_load(const bf16* act, int m, int sub, int lane, v4u (&t)[AQ_NIT]) {
    const bf16* row = act + (size_t)m * DFF + sub * (AQ_NIT * 512) + lane * 8;
#pragma unroll
    for (int it = 0; it < AQ_NIT; ++it) { t[it] = v4u{0u, 0u, 0u, 0u}; if (sub * (AQ_NIT * 512) + it * 512 + lane * 8 < DFF) t[it] = *(const GAS v4u*)(row + it * 512); }
}
DI void act_quant_rows(Frame& F, const bf16* act, unsigned char* aq, float* sact, int rowlo, int rowhi, int slot, int nslots) {
    const int lane = F.lane, pair = F.wave >> 1, sub = F.wave & 1;
    LAS float* const smx = (LAS float*)(F.lds + RING_BYTES);
    const float s1 = (lane & 1) ? -1.f : 1.f, s2 = (lane & 2) ? -1.f : 1.f, s4 = (lane & 4) ? -1.f : 1.f;
    int par = 0;
    v4u t[AQ_NIT];
    const int mbase = rowlo + slot * (NWAVES / 2), mstep = nslots * (NWAVES / 2), mend = rowhi;
    { const int m = mbase + pair; aq_load(act, m < M ? m : 0, sub, lane, t); }
#pragma unroll 1
    for (int m0 = mbase; m0 < mend; m0 += mstep, par ^= 8) {
        const int m = m0 + pair; const bool rowok = m < mend;
        float r[AQ_NIT][8]; float mx = 0.f;
#pragma unroll
        for (int it = 0; it < AQ_NIT; ++it) {
            float v[8] = {bf2f(t[it].x & 0xffffu), __builtin_bit_cast(float, t[it].x & 0xffff0000u), bf2f(t[it].y & 0xffffu), __builtin_bit_cast(float, t[it].y & 0xffff0000u),
                          bf2f(t[it].z & 0xffffu), __builtin_bit_cast(float, t[it].z & 0xffff0000u), bf2f(t[it].w & 0xffffu), __builtin_bit_cast(float, t[it].w & 0xffff0000u)};
            if (HAD_ON) { fwht_inlane8(v);
#pragma unroll
                for (int i = 0; i < 8; ++i) v[i] = __builtin_fmaf(v[i], s1, dpp_f<0xB1>(v[i]));
#pragma unroll
                for (int i = 0; i < 8; ++i) v[i] = __builtin_fmaf(v[i], s2, dpp_f<0x4E>(v[i]));
#pragma unroll
                for (int i = 0; i < 8; ++i) v[i] = __builtin_fmaf(v[i], s4, swz_xor4(v[i])); }
#pragma unroll
            for (int i = 0; i < 8; ++i) { mx = __builtin_fmaxf(mx, __builtin_fabsf(v[i])); r[it][i] = v[i]; } }
        { const int mn = m + mstep; aq_load(act, mn < M ? mn : 0, sub, lane, t); }
#pragma unroll
        for (int s = 1; s < 64; s <<= 1) mx = __builtin_fmaxf(mx, __shfl_xor(mx, s));
        if (lane == 0) smx[par + F.wave] = mx;
        __syncthreads();
        mx = __builtin_fmaxf(smx[par + 2 * pair], smx[par + 2 * pair + 1]);
        const float inv = mx > 0.f ? 127.0f / mx : 0.f;
#pragma unroll
        for (int it = 0; it < AQ_NIT; ++it) { const int e0 = sub * (AQ_NIT * 512) + it * 512 + lane * 8;
            v2u w = {0u, 0u};
#pragma unroll
            for (int i = 0; i < 4; ++i) { w.x = __builtin_amdgcn_cvt_pk_u8_f32(__builtin_rintf(__builtin_fmaf(r[it][i], inv, 128.f)), i, w.x);
                                          w.y = __builtin_amdgcn_cvt_pk_u8_f32(__builtin_rintf(__builtin_fmaf(r[it][4 + i], inv, 128.f)), i, w.y); }
            w.x ^= 0x80808080u; w.y ^= 0x80808080u;
            if (rowok && e0 < DFF) *(GAS v2u*)(aq + (ACT8_TILED ? (size_t)(m >> 8) * ((size_t)256 * DFF) + (size_t)(e0 >> 7) * (256 * 128) + (size_t)(m & 255) * 128 + (e0 & 127) : (size_t)m * DFF + e0)) = w; }
        if (rowok && sub == 0 && lane == 0) sact[m] = mx * (HAD_ON ? 0.125f / 127.0f : 1.0f / 127.0f);
    }
    __syncthreads();
}
DI void act_quant_phase(Frame& F, const bf16* act, unsigned char* aq, float* sact) {
    if (F.G == 256) act_quant_rows(F, act, aq, sact, (F.vcu >> 5) * 2048, (F.vcu >> 5) * 2048 + 2048, F.vcu & 31, 32); else act_quant_rows(F, act, aq, sact, 0, M, F.vcu, F.G);
}
DI void rot_tile_col(const LAS float* scr, int lane, float (&v)[32]) {
    const int n = lane & 31, half = lane >> 5;
#pragma unroll
    for (int i = 0; i < 32; ++i) v[i] = scr[(32 * half + i) * 33 + n];
    if (HAD_ON) {
#pragma unroll
        for (int b = 1; b < 32; b <<= 1)
#pragma unroll
            for (int i = 0; i < 32; ++i) if (!(i & b)) { const float lo = v[i], hi = v[i | b]; v[i] = lo + hi; v[i | b] = lo - hi; }
#pragma unroll
        for (int i = 0; i < 32; ++i) { const float p = __shfl_xor(v[i], 32); v[i] = (half ? p - v[i] : v[i] + p) * 0.125f; } }
}
DI void strip_quant8_rot(Frame& F, const float* __restrict__ src, float* __restrict__ cm, unsigned char* __restrict__ dst, int K, int N, int strip, LAS float* scr, LAS unsigned* cml) {
    const int n0 = strip << 5, lane = F.lane, kr = lane >> 3, c4 = lane & 7, nkb = K >> 6, n = lane & 31, half = lane >> 5;
    if (F.tid < 32) cml[F.tid] = 0u;
    __syncthreads();
    float mxc = 0.f;
#pragma unroll 1
    for (int pass = 0; pass < 2; ++pass) {
        float inv = 0.f; if (pass) { const float cmx = __builtin_bit_cast(float, cml[n]); inv = cmx > 0.f ? 127.0f / cmx : 0.f; }
#pragma unroll 1
        for (int kb = F.wave; kb < nkb; kb += NWAVES) { const int k0 = kb << 6;
            f32x4 t[8];
#pragma unroll
            for (int it = 0; it < 8; ++it) t[it] = *(const GAS f32x4*)(src + (size_t)(k0 + 8 * it + kr) * N + n0 + 4 * c4);
#pragma unroll
            for (int it = 0; it < 8; ++it) { LAS float* p = scr + (8 * it + kr) * 33 + 4 * c4; p[0] = t[it].x; p[1] = t[it].y; p[2] = t[it].z; p[3] = t[it].w; }
            LDS_WAIT(); asm volatile("" ::: "memory");
            float v[32]; rot_tile_col(scr, lane, v);
            if (!pass) {
#pragma unroll
                for (int i = 0; i < 32; ++i) mxc = __builtin_fmaxf(mxc, __builtin_fabsf(v[i])); }
            else { v4u o[2];
#pragma unroll
                for (int h = 0; h < 2; ++h)
#pragma unroll
                    for (int c = 0; c < 4; ++c) { const int i = 16 * h + 4 * c; o[h][c] = q8x4(v[i], v[i + 1], v[i + 2], v[i + 3], inv); }
                const int nn = n0 + n, kk = k0 + 32 * half;
                unsigned char* p = dst + (size_t)(nn >> 8) * ((size_t)256 * K) + (size_t)(kk >> 7) * (256 * 128) + (size_t)(nn & 255) * 128 + (kk & 127);
                *(GAS v4u*)p = o[0]; *(GAS v4u*)(p + 16) = o[1]; }
            LDS_WAIT(); asm volatile("" ::: "memory"); }
        if (!pass) { mxc = __builtin_fmaxf(mxc, __shfl_xor(mxc, 32)); if (half == 0) __hip_atomic_fetch_max(cml + n, __builtin_bit_cast(unsigned, mxc), __ATOMIC_RELAXED, __HIP_MEMORY_SCOPE_WORKGROUP); __syncthreads(); }
    }
    if (F.tid < 32) cm[n0 + F.tid] = __builtin_bit_cast(float, cml[F.tid]);
    __syncthreads();
}
DI void sq16_load(const float* __restrict__ src, const float* __restrict__ gain, int N, int s0, int kb, int lane, f32x4 (&r)[4], float (&g)[4]) {
#pragma unroll
    for (int it = 0; it < 4; ++it) { const int k = (kb << 6) + 16 * it + (lane >> 2); r[it] = *(const GAS f32x4*)(src + (size_t)k * N + s0 + 4 * (lane & 3)); g[it] = gain ? gain[k] : 1.0f; }
}
DI void strip16_quant8(Frame& F, const float* __restrict__ src, const float* __restrict__ gain, float* __restrict__ cm, unsigned char* __restrict__ dst, int N, int mode, int lim, int strip, LAS float* scr, LAS unsigned* cml) {
    constexpr int K = DM, KPW = (K / 64) / NWAVES;
    const int n0 = strip << 4, s0 = map_col(mode, lim, n0), lane = F.lane, n = lane & 15, kq = lane >> 4;
    float v[KPW][16]; float mx = 0.f;
    f32x4 r[4]; float g[4]; sq16_load(src, gain, N, s0, F.wave, lane, r, g);
#pragma unroll
    for (int b = 0; b < KPW; ++b) {
#pragma unroll
        for (int it = 0; it < 4; ++it) { LAS float* p = scr + (16 * it + (lane >> 2)) * 17 + 4 * (lane & 3); p[0] = r[it].x * g[it]; p[1] = r[it].y * g[it]; p[2] = r[it].z * g[it]; p[3] = r[it].w * g[it]; }
        if (b + 1 < KPW) sq16_load(src, gain, N, s0, F.wave + NWAVES * (b + 1), lane, r, g);
        LDS_WAIT(); asm volatile("" ::: "memory");
#pragma unroll
        for (int i = 0; i < 16; ++i) { v[b][i] = scr[(16 * kq + i) * 17 + n]; mx = __builtin_fmaxf(mx, __builtin_fabsf(v[b][i])); }
        LDS_WAIT(); asm volatile("" ::: "memory"); }
    mx = __builtin_fmaxf(mx, __shfl_xor(mx, 16)); mx = __builtin_fmaxf(mx, __shfl_xor(mx, 32));
    if (lane < 16) __hip_atomic_fetch_max(cml + lane, __builtin_bit_cast(unsigned, mx), __ATOMIC_RELAXED, __HIP_MEMORY_SCOPE_WORKGROUP);
    __syncthreads();
    const float cmx = __builtin_bit_cast(float, cml[n]), inv = cmx > 0.f ? 127.0f / cmx : 0.f;
    const int nn = n0 + n;
    unsigned char* const drow = dst + (size_t)(nn >> 8) * ((size_t)256 * K) + (size_t)(nn & 255) * 128;
#pragma unroll
    for (int b = 0; b < KPW; ++b) { const int kk = ((F.wave + NWAVES * b) << 6) + 16 * kq; v4u o;
#pragma unroll
        for (int c = 0; c < 4; ++c) o[c] = q8x4(v[b][4 * c], v[b][4 * c + 1], v[b][4 * c + 2], v[b][4 * c + 3], inv);
        *(GAS v4u*)(drow + (size_t)(kk >> 7) * (256 * 128) + (kk & 127)) = o; }
    if (F.tid < 16) cm[s0 + F.tid] = cmx;
}
template <int DROP> DI void norm_rows8(Frame& F, const float* x, unsigned char* xq, float* sA, bf16* xb) {
    const int gw = F.vcu * NWAVES + F.wave, NGW = F.G * NWAVES;
    for (int m = gw; m < M; m += NGW) {
        const GAS f32x4* xr = (const GAS f32x4*)(x + (size_t)m * DM) + 4 * F.lane;
        f32x4 v[16]; float s = 0.f, mx = 0.f;
#pragma unroll
        for (int j = 0; j < 4; ++j)
#pragma unroll
            for (int i = 0; i < 4; ++i) { const f32x4 t = xr[256 * j + i]; v[4 * j + i] = t; s += (t.x * t.x + t.y * t.y) + (t.z * t.z + t.w * t.w);
                mx = __builtin_fmaxf(mx, __builtin_fmaxf(__builtin_fmaxf(__builtin_fabsf(t.x), __builtin_fabsf(t.y)), __builtin_fmaxf(__builtin_fabsf(t.z), __builtin_fabsf(t.w)))); }
        const float r = 1.0f / sqrtf(wave_sum(s) * (1.0f / DM) + RMS_EPS);
#pragma unroll
        for (int o = 1; o < 64; o <<= 1) mx = __builtin_fmaxf(mx, __shfl_xor(mx, o));
        const float inv = mx > 0.f ? 127.0f / mx : 0.f;
#pragma unroll
        for (int j = 0; j < 4; ++j) { v4u w;
#pragma unroll
            for (int i = 0; i < 4; ++i) { const f32x4 t = v[4 * j + i]; w[i] = q8x4(t.x, t.y, t.z, t.w, inv); }
            *(GAS v4u*)(xq + (size_t)m * DM + 1024 * j + 16 * F.lane) = w;
            if (xb) {
#pragma unroll
                for (int h = 0; h < 2; ++h) { const f32x4 a = v[4 * j + 2 * h] * r, b = v[4 * j + 2 * h + 1] * r; v4u y;
                    if (DROP > 0) { y.x = f2bf_drop<DROP>(a.x) | (f2bf_drop<DROP>(a.y) << 16); y.y = f2bf_drop<DROP>(a.z) | (f2bf_drop<DROP>(a.w) << 16); y.z = f2bf_drop<DROP>(b.x) | (f2bf_drop<DROP>(b.y) << 16); y.w = f2bf_drop<DROP>(b.z) | (f2bf_drop<DROP>(b.w) << 16); }
                    else { y.x = pk2(a.x, a.y); y.y = pk2(a.z, a.w); y.z = pk2(b.x, b.y); y.w = pk2(b.z, b.w); }
                    *(GAS v4u*)(xb + (size_t)m * DM + 1024 * j + 16 * F.lane + 8 * h) = y; } } }
        if (F.lane == 0) sA[m] = mx * r * (1.0f / 127.0f);
    }
}
#define XROW_LOOP(m_) const bool xblk_ = (F.G == 256); for (int j_ = 0, m_ = xblk_ ? (gw >> 8) * 2048 + (gw & 255) : gw; m_ < M && (!xblk_ || j_ < 8); ++j_, m_ += xblk_ ? 256 : NGW)
DI void quant_rows_bf16(Frame& F, const bf16* o, unsigned char* oq, float* sO) {
    const int gw = F.vcu * NWAVES + F.wave, NGW = F.G * NWAVES;
    XROW_LOOP(m) {
        const GAS v4u* orow = (const GAS v4u*)(o + (size_t)m * DM) + 2 * F.lane;
        v4u v[8]; float mx = 0.f;
#pragma unroll
        for (int j = 0; j < 4; ++j)
#pragma unroll
            for (int h = 0; h < 2; ++h) { const v4u t = orow[128 * j + h]; v[2 * j + h] = t;
#pragma unroll
                for (int c = 0; c < 4; ++c) mx = __builtin_fmaxf(mx, __builtin_fmaxf(__builtin_fabsf(bf2f(t[c] & 0xffffu)), __builtin_fabsf(bf2f(t[c] >> 16)))); }
#pragma unroll
        for (int s = 1; s < 64; s <<= 1) mx = __builtin_fmaxf(mx, __shfl_xor(mx, s));
        const float inv = mx > 0.f ? 127.0f / mx : 0.f;
#pragma unroll
        for (int j = 0; j < 4; ++j) { v4u w;
#pragma unroll
            for (int h = 0; h < 2; ++h) { const v4u t = v[2 * j + h];
                w[2 * h] = q8x4(bf2f(t[0] & 0xffffu), bf2f(t[0] >> 16), bf2f(t[1] & 0xffffu), bf2f(t[1] >> 16), inv);
                w[2 * h + 1] = q8x4(bf2f(t[2] & 0xffffu), bf2f(t[2] >> 16), bf2f(t[3] & 0xffffu), bf2f(t[3] >> 16), inv); }
            *(GAS v4u*)(oq + (size_t)m * DM + 1024 * j + 16 * F.lane) = w; }
        if (F.lane == 0) sO[m] = mx * (1.0f / 127.0f);
    }
}
DI void norm_rows8_b(Frame& F, const bf16* x, unsigned char* xq, float* sA) {
    const int gw = F.vcu * NWAVES + F.wave, NGW = F.G * NWAVES;
    XROW_LOOP(m) {
        const GAS v4u* xr = (const GAS v4u*)(x + (size_t)m * DM) + 2 * F.lane;
        v4u t[8]; float s = 0.f, mx = 0.f;
#pragma unroll
        for (int j = 0; j < 4; ++j) { t[2 * j] = xr[128 * j]; t[2 * j + 1] = xr[128 * j + 1]; }
#pragma unroll
        for (int j = 0; j < 8; ++j)
#pragma unroll
            for (int i = 0; i < 4; ++i) { const float a = __builtin_bit_cast(float, t[j][i] << 16), b = __builtin_bit_cast(float, t[j][i] & 0xffff0000u); s += a * a + b * b; mx = __builtin_fmaxf(mx, __builtin_fmaxf(__builtin_fabsf(a), __builtin_fabsf(b))); }
        const float r = 1.0f / sqrtf(wave_sum(s) * (1.0f / DM) + RMS_EPS);
#pragma unroll
        for (int o = 1; o < 64; o <<= 1) mx = __builtin_fmaxf(mx, __shfl_xor(mx, o));
        const float inv = mx > 0.f ? 127.0f / mx : 0.f;
#pragma unroll
        for (int j = 0; j < 4; ++j) { v4u w;
#pragma unroll
            for (int i = 0; i < 4; ++i) { const unsigned w0 = t[2 * j + (i >> 1)][2 * (i & 1)], w1 = t[2 * j + (i >> 1)][2 * (i & 1) + 1];
                w[i] = q8x4(__builtin_bit_cast(float, w0 << 16), __builtin_bit_cast(float, w0 & 0xffff0000u), __builtin_bit_cast(float, w1 << 16), __builtin_bit_cast(float, w1 & 0xffff0000u), inv); }
            *(GAS v4u*)(xq + (size_t)m * DM + 1024 * j + 16 * F.lane) = w; }
        if (F.lane == 0) sA[m] = mx * r * (1.0f / 127.0f);
    }
}
DI void final_norm_rows_b(Frame& F, const bf16* x, float* out, const float* gain, bool poison) {
    const int gw = F.vcu * NWAVES + F.wave, NGW = F.G * NWAVES;
    XROW_LOOP(m) {
        const GAS v4u* xr = (const GAS v4u*)(x + (size_t)m * DM) + F.lane; GAS f32x4* orow = (GAS f32x4*)(out + (size_t)m * DM) + 2 * F.lane; const GAS f32x4* gr = (const GAS f32x4*)gain + 2 * F.lane;
        v4u t[8]; float s = 0.f;
#pragma unroll
        for (int j = 0; j < 8; ++j) t[j] = xr[64 * j];
#pragma unroll
        for (int j = 0; j < 8; ++j)
#pragma unroll
            for (int i = 0; i < 4; ++i) { const float a = __builtin_bit_cast(float, t[j][i] << 16), b = __builtin_bit_cast(float, t[j][i] & 0xffff0000u); s += a * a + b * b; }
        float r = 1.0f / sqrtf(wave_sum(s) * (1.0f / DM) + RMS_EPS); if (poison) r = __builtin_nanf("");
#pragma unroll
        for (int j = 0; j < 8; ++j) { f32x4 a, b;
            a.x = __builtin_bit_cast(float, t[j].x << 16); a.y = __builtin_bit_cast(float, t[j].x & 0xffff0000u); a.z = __builtin_bit_cast(float, t[j].y << 16); a.w = __builtin_bit_cast(float, t[j].y & 0xffff0000u);
            b.x = __builtin_bit_cast(float, t[j].z << 16); b.y = __builtin_bit_cast(float, t[j].z & 0xffff0000u); b.z = __builtin_bit_cast(float, t[j].w << 16); b.w = __builtin_bit_cast(float, t[j].w & 0xffff0000u);
            orow[128 * j] = a * r * gr[128 * j]; orow[128 * j + 1] = b * r * gr[128 * j + 1]; }
    }
}
DI void final_norm_rows(Frame& F, float* x, const float* gain, bool poison) {
    const int gw = F.vcu * NWAVES + F.wave, NGW = F.G * NWAVES;
    for (int m = gw; m < M; m += NGW) {
        GAS f32x4* xr = (GAS f32x4*)(x + (size_t)m * DM) + F.lane; const GAS f32x4* gr = (const GAS f32x4*)gain + F.lane;
        f32x4 v[16]; float s = 0.f;
#pragma unroll
        for (int j = 0; j < 16; ++j) { v[j] = xr[64 * j]; s += (v[j].x * v[j].x + v[j].y * v[j].y) + (v[j].z * v[j].z + v[j].w * v[j].w); }
        float r = 1.0f / sqrtf(wave_sum(s) * (1.0f / DM) + RMS_EPS); if (poison) r = __builtin_nanf("");
#pragma unroll
        for (int j = 0; j < 16; ++j) xr[64 * j] = v[j] * r * gr[64 * j];
    }
}
DI void kmean_phase(Frame& F) {
    const bf16* Kb = (const bf16*)(F.ws + WS_K); bf16* kh = (bf16*)(F.ws + WS_KMEAN); bf16* kl = kh + 8 * 64 * 128;
    LAS float* red = (LAS float*)(F.lds + RING_OFF);
    const int c = F.tid & 15, rg = F.tid >> 4;
    for (int it = F.vcu; it < 8 * NBLK; it += F.G) {
        const int kvh = it >> 6, n = it & 63; float a[8];
#pragma unroll
        for (int e = 0; e < 8; ++e) a[e] = 0.f;
#pragma unroll
        for (int r = 0; r < 8; ++r) { const v4u w = *(const GAS v4u*)(Kb + (size_t)(n * 256 + rg + 32 * r) * A_KVW + kvh * 128 + c * 8);
            a[0] += bf2f(w.x & 0xffffu); a[1] += bf2f(w.x >> 16); a[2] += bf2f(w.y & 0xffffu); a[3] += bf2f(w.y >> 16); a[4] += bf2f(w.z & 0xffffu); a[5] += bf2f(w.z >> 16); a[6] += bf2f(w.w & 0xffffu); a[7] += bf2f(w.w >> 16); }
#pragma unroll
        for (int e = 0; e < 8; ++e) red[rg * 128 + c * 8 + e] = a[e];
        __syncthreads();
        if (F.tid < 128) { float s = 0.f;
#pragma unroll 8
            for (int g = 0; g < 32; ++g) s += red[g * 128 + F.tid];
            s *= (1.0f / 256.0f); const unsigned h = f2bf(s); const float l = s - bf2f(h);
            kh[(size_t)it * 128 + F.tid] = (bf16)h; kl[(size_t)it * 128 + F.tid] = (bf16)f2bf(l); }
        __syncthreads();
    }
}
namespace att {
template <int D> struct TL { static constexpr int PITCH = D * 2 + 16, BYTES = 64 * PITCH, NCH = D / 8, NLD = (64 * NCH) / 512; };
DI int crow(int reg, int h) { return (reg & 3) + 8 * (reg >> 2) + 4 * h; }
typedef float f32x2_t __attribute__((ext_vector_type(2))); typedef __bf16 bf16x2_t __attribute__((ext_vector_type(2)));
DI unsigned cvtpk(float lo, float hi) { f32x2_t v = {lo, hi}; bf16x2_t b = __builtin_convertvector(v, bf16x2_t); return __builtin_bit_cast(unsigned, b); }
typedef short v4i16_t __attribute__((ext_vector_type(4)));
DI s16x4 vtr(const LAS unsigned char* p) { return __builtin_bit_cast(s16x4, __builtin_amdgcn_ds_read_tr16_b64_v4i16((LAS v4i16_t*)p)); }
#define MFMA32(a, b, c) __builtin_amdgcn_mfma_f32_32x32x16_bf16((a), (b), (c), 0, 0, 0)

template <int D, int NL = TL<D>::NLD> DI void tile_load(v4u (&r)[NL], const bf16* g, int pitch, int tid) {
#pragma unroll
    for (int i = 0; i < NL; ++i) { const int c = tid + 512 * i, row = c / TL<D>::NCH, ch = c % TL<D>::NCH; r[i] = *(const GAS v4u*)(g + (size_t)row * pitch + ch * 8); }
}
template <int D, int NL = TL<D>::NLD> DI void tile_store(LAS unsigned char* t, const v4u (&r)[NL], int tid) {
#pragma unroll
    for (int i = 0; i < NL; ++i) { const int c = tid + 512 * i, row = c / TL<D>::NCH, ch = c % TL<D>::NCH; *(LAS v4u*)(t + row * TL<D>::PITCH + ch * 16) = r[i]; }
}
template <int D, bool INIT = true> DI void qk(f32x16& p0, f32x16& p1, const LAS unsigned char* kt, const bf16x8 (&qf)[D / 16], int r32, int hi) {
    const LAS unsigned char* a = kt + r32 * TL<D>::PITCH + hi * 16;
    if (INIT) {
#pragma unroll
        for (int i = 0; i < 16; ++i) { p0[i] = 0.f; p1[i] = 0.f; } }
#pragma unroll
    for (int s = 0; s < D / 16; ++s) { const bf16x8 a0 = *(const LAS bf16x8*)(a + s * 32), a1 = *(const LAS bf16x8*)(a + 32 * TL<D>::PITCH + s * 32);
        p0 = MFMA32(a0, qf[s], p0); p1 = MFMA32(a1, qf[s], p1); if ((s & 3) == 3) __builtin_amdgcn_sched_barrier(0); }
}
DI bf16x8 pack8(const f32x16& x, int s) {
    v4u p; p.x = cvtpk(x[8 * s], x[8 * s + 1]); p.y = cvtpk(x[8 * s + 2], x[8 * s + 3]); p.z = cvtpk(x[8 * s + 4], x[8 * s + 5]); p.w = cvtpk(x[8 * s + 6], x[8 * s + 7]);
    return __builtin_bit_cast(bf16x8, p);
}
template <int D> DI void pv(f32x16 (&o)[D / 32], const LAS unsigned char* vt, const f32x16& p0, const f32x16& p1, int lane, int hi) {
    bf16x8 pf[4]; pf[0] = pack8(p0, 0); pf[1] = pack8(p0, 1); pf[2] = pack8(p1, 0); pf[3] = pack8(p1, 1);
    const LAS unsigned char* vb = vt + (4 * hi + ((lane & 15) >> 2)) * TL<D>::PITCH + ((lane >> 4) & 1) * 32 + (lane & 3) * 8;
#pragma unroll
    for (int db = 0; db < D / 32; ++db)
#pragma unroll
        for (int ks = 0; ks < 4; ++ks) { const s16x4 lo = vtr(vb + (16 * ks) * TL<D>::PITCH + db * 64), hh = vtr(vb + (16 * ks + 8) * TL<D>::PITCH + db * 64);
            const bf16x8 va = (bf16x8){lo[0], lo[1], lo[2], lo[3], hh[0], hh[1], hh[2], hh[3]};
            o[db] = MFMA32(va, pf[ks], o[db]); if (ks == 3) __builtin_amdgcn_sched_barrier(0); }
}
#ifndef SM_THR
#define SM_THR 8.0f
#endif
template <int D> DI void softmax_update(f32x16& p0, f32x16& p1, float& m, float& l, f32x16 (&o)[D / 32]) {
    float mx = __builtin_fmaxf(p0[0], p1[0]);
#pragma unroll
    for (int i = 1; i < 16; ++i) mx = __builtin_fmaxf(mx, __builtin_fmaxf(p0[i], p1[i]));
    mx = __builtin_fmaxf(mx, __shfl_xor(mx, 32));
    if (__builtin_amdgcn_ballot_w64(mx - m > SM_THR) != 0ull) {
        const float mn = __builtin_fmaxf(m, mx), al = __builtin_amdgcn_exp2f(m - mn);
        l *= al; m = mn;
#pragma unroll
        for (int db = 0; db < D / 32; ++db)
#pragma unroll
            for (int i = 0; i < 16; ++i) o[db][i] *= al;
    }
    float s = 0.f;
#pragma unroll
    for (int i = 0; i < 16; ++i) { p0[i] = __builtin_amdgcn_exp2f(p0[i] - m); p1[i] = __builtin_amdgcn_exp2f(p1[i] - m); s += p0[i] + p1[i]; }
    l += s;
}
template <int D> DI void store_rows16(bf16* orow, const f32x16 (&o)[D / 32], float inv, int hi, bool valid) {
#pragma unroll
    for (int db = 0; db < D / 32; ++db)
#pragma unroll
        for (int gp = 0; gp < 2; ++gp) { const int ge = 8 * gp, go = 8 * gp + 4;
            const unsigned ex = cvtpk(o[db][ge] * inv, o[db][ge + 1] * inv), ey = cvtpk(o[db][ge + 2] * inv, o[db][ge + 3] * inv);
            const unsigned ox = cvtpk(o[db][go] * inv, o[db][go + 1] * inv), oy = cvtpk(o[db][go + 2] * inv, o[db][go + 3] * inv);
            const auto sx = __builtin_amdgcn_permlane32_swap(ex, ox, false, false), sy = __builtin_amdgcn_permlane32_swap(ey, oy, false, false);
            v4u w; w.x = sx[0]; w.y = sy[0]; w.z = sx[1]; w.w = sy[1];
            if (valid) *(GAS v4u*)(orow + db * 32 + 16 * gp + 8 * hi) = w; }
}
template <int D> DI void store_o(bf16* orow  , const f32x16 (&o)[D / 32], float l, int hi) {
    const float L = l + __shfl_xor(l, 32), inv = 1.0f / L;
    store_rows16<D>(orow, o, inv, hi, true);
}

constexpr int MOBA_HIST_OFF = 36864, MOBA_SCAN_OFF = 40960;
DI size_t moba_list_off(int kvh, int n) { return (size_t)kvh * 2064384 + (size_t)1024 * (63 * n - (n * (n - 1)) / 2); }
template <int D> DI void store_part(bf16* po  , float* pml, const f32x16 (&o)[D / 32], float m, float l, int hi, bool valid) {
    const float L = l + __shfl_xor(l, 32), inv = 1.0f / L;
    store_rows16<D>(po, o, inv, hi, valid);
    if (valid && hi == 0) { pml[0] = m; pml[1] = L; }
}
DI void moba_own_item(Frame& F, int b, int h) {
    constexpr int D = 128; typedef TL<D> T;
    LAS unsigned char* kt = F.lds + RING_OFF; LAS unsigned char* vt = kt + T::BYTES;
    LAS unsigned* hist = (LAS unsigned*)(F.lds + RING_OFF + MOBA_HIST_OFF); LAS unsigned* bases = hist + 64;
    const int lane = F.lane, r32 = lane & 31, hi = lane >> 5, w = F.wave, kvh = h >> 2, tid = F.tid;
    const bf16* Kb = (const bf16*)(F.ws + WS_K) + kvh * 128; const bf16* Vb = (const bf16*)(F.ws + WS_V) + kvh * 128;
    const bf16* kmh = (const bf16*)(F.ws + WS_KMEAN) + (size_t)kvh * 64 * 128; const bf16* kml = kmh + 8 * 64 * 128;
    const int tok = b * 256 + w * 32 + r32, pair = tok * 32 + h;
    const bf16* qrow = (const bf16*)(F.ws + WS_Q) + (size_t)tok * DM + h * 128;
    bf16x8 qf[8];
#pragma unroll
    for (int s = 0; s < 8; ++s) qf[s] = *(const GAS bf16x8*)(qrow + 16 * s + 8 * hi);
    v4u rk[T::NLD], rv[T::NLD];
    const float NEG = -__builtin_inff();
    if (b > 0) {
        tile_load<D>(rk, kmh, 128, tid); tile_load<D>(rv, kml, 128, tid);
        if (tid < 64) hist[tid] = 0u;
        __syncthreads(); tile_store<D>(kt, rk, tid); tile_store<D>(vt, rv, tid); __syncthreads();
        int nsel[3]; unsigned rnk[3];
        { f32x16 g0, g1; qk<D>(g0, g1, vt, qf, r32, hi); __builtin_amdgcn_sched_barrier(0); qk<D, false>(g0, g1, kt, qf, r32, hi);
#pragma unroll
          for (int i = 0; i < 16; ++i) { const int n0 = crow(i, hi); g0[i] = (n0 < b) ? g0[i] : NEG; g1[i] = (n0 + 32 < b) ? g1[i] : NEG; }
#pragma unroll
          for (int j = 0; j < 3; ++j) { float bv = NEG; int bi = 64;
#pragma unroll
              for (int i = 0; i < 16; ++i) { const int n0 = crow(i, hi); if (g0[i] > bv) { bv = g0[i]; bi = n0; } }
#pragma unroll
              for (int i = 0; i < 16; ++i) { const int n1 = 32 + crow(i, hi); if (g1[i] > bv) { bv = g1[i]; bi = n1; } }
              const float ov = __shfl_xor(bv, 32); const int oi = __shfl_xor(bi, 32);
              if (ov > bv || (ov == bv && oi < bi)) { bv = ov; bi = oi; }
              nsel[j] = (bv > NEG) ? bi : -1;
#pragma unroll
              for (int i = 0; i < 16; ++i) { const int n0 = crow(i, hi); g0[i] = (n0 == bi) ? NEG : g0[i]; g1[i] = (n0 + 32 == bi) ? NEG : g1[i]; } } }
#pragma unroll
        for (int j = 0; j < 3; ++j) { rnk[j] = 0u; if (hi == 0 && nsel[j] >= 0) rnk[j] = __hip_atomic_fetch_add(hist + nsel[j], 1u, __ATOMIC_RELAXED, __HIP_MEMORY_SCOPE_WORKGROUP); }
        __syncthreads();
        if (tid < 64) { const unsigned hc = hist[tid]; unsigned bs = 0u; if (hc) bs = __hip_atomic_fetch_add((unsigned*)(F.ctl + CW_CNT) + kvh * 64 + tid, hc, RLX_AGENT); bases[tid] = bs; }
        __syncthreads();
        unsigned* lst = (unsigned*)(F.ws + WS_LIST);
#pragma unroll
        for (int j = 0; j < 3; ++j) if (hi == 0 && nsel[j] >= 0) lst[moba_list_off(kvh, nsel[j]) + bases[nsel[j]] + rnk[j]] = ((unsigned)pair << 2) | (unsigned)j;
    }
    float m = -1e30f, l = 0.f; f32x16 o[4];
#pragma unroll
    for (int db = 0; db < 4; ++db)
#pragma unroll
        for (int i = 0; i < 16; ++i) o[db][i] = 0.f;
    tile_load<D>(rk, Kb + (size_t)(b * 256) * A_KVW, A_KVW, tid); tile_load<D>(rv, Vb + (size_t)(b * 256) * A_KVW, A_KVW, tid);
    for (int tt = 0; tt < 4; ++tt) {
        __syncthreads();
        tile_store<D>(kt, rk, tid); tile_store<D>(vt, rv, tid);
        __syncthreads();
        if (tt + 1 < 4) { const size_t r0 = (size_t)b * 256 + (tt + 1) * 64; tile_load<D>(rk, Kb + r0 * A_KVW, A_KVW, tid); tile_load<D>(rv, Vb + r0 * A_KVW, A_KVW, tid); }
        if (tt * 64 <= w * 32 + 31) {
            f32x16 p0, p1; qk<D>(p0, p1, kt, qf, r32, hi);
            const int qrel = w * 32 + r32, kb = tt * 64 + 4 * hi;
#pragma unroll
            for (int i = 0; i < 16; ++i) { const int kv = kb + (i & 3) + 8 * (i >> 2); p0[i] = (kv > qrel) ? NEG : p0[i]; p1[i] = (kv + 32 > qrel) ? NEG : p1[i]; }
            softmax_update<D>(p0, p1, m, l, o);
            pv<D>(o, vt, p0, p1, lane, hi);
        }
    }
    store_part<D>((bf16*)(F.ws + WS_PARTO) + ((size_t)pair * 4 + 3) * 128, (float*)(F.ws + WS_PARTML) + ((size_t)pair * 4 + 3) * 2, o, m, l, hi, true);
    __syncthreads();
}
DI void moba_own_phase(Frame& F) {
#pragma unroll 1
    for (int p2 = 2 * F.vcu; p2 < 2 * 32 * A_H; p2 += (p2 & 1) ? 2 * F.G - 1 : 1) { const int p = p2 >> 1, h = p >> 5, bp = p & 31; moba_own_item(F, (p2 & 1) ? bp : 63 - bp, h); }
}
DI void moba_past_phase(Frame& F) {
    constexpr int D = 128; typedef TL<D> T; constexpr int IMG = 256 * T::PITCH;
    LAS unsigned char* kt = F.lds + RING_OFF; LAS unsigned char* vt = kt + IMG;
    LAS int* sc = (LAS int*)(F.lds + RING_OFF + 2 * IMG); LAS int* pc = sc + 512;
    static_assert(2 * IMG + 4096 <= LDSCTL_OFF, "MoBA past phase LDS map");
    const int lane = F.lane, r32 = lane & 31, hi = lane >> 5, w = F.wave, tid = F.tid;
    { int cv = 0; if (tid < 504) cv = (int)__hip_atomic_load((unsigned*)(F.ctl + CW_CNT) + (tid / 63) * 64 + (tid % 63), RLX_AGENT);
      pc[tid] = cv; sc[tid] = (cv + 255) >> 8; __syncthreads();
      for (int off = 1; off < 512; off <<= 1) { const int x = sc[tid] + (tid >= off ? sc[tid - off] : 0); __syncthreads(); sc[tid] = x; __syncthreads(); } }
    const int total = sc[511];
    const unsigned* lst = (const unsigned*)(F.ws + WS_LIST); const bf16* Qg = (const bf16*)(F.ws + WS_Q);
    const int i_lo = (int)(((long)total * F.vcu) / F.G), i_hi = (int)(((long)total * (F.vcu + 1)) / F.G);
#define MOBA_QLOAD(QF, E) do { const int pr_ = (int)((E) >> 2); const bf16* qrow_ = Qg + (size_t)(pr_ >> 5) * DM + (pr_ & 31) * 128; \
        _Pragma("unroll") for (int s_ = 0; s_ < 8; ++s_) QF[s_] = *(const GAS bf16x8*)(qrow_ + 16 * s_ + 8 * hi); } while (0)
    int t = 0;
    if (i_lo < i_hi) { int lo_ = 0, hi_ = 511; while (lo_ < hi_) { const int mid_ = (lo_ + hi_) >> 1; if (sc[mid_] > i_lo) hi_ = mid_; else lo_ = mid_ + 1; } t = __builtin_amdgcn_readfirstlane(lo_); }
    int t_img = -1; bf16x8 qf[8]; unsigned e = 0u; bool valid = false;
#pragma unroll 1
    for (int idx = i_lo; idx < i_hi; ++idx) {
        while (sc[t] <= idx) ++t;
        t = __builtin_amdgcn_readfirstlane(t);
        const int cnt = pc[t], c = idx - (sc[t] - ((cnt + 255) >> 8)), kvh = t / 63, n = t % 63;
        const size_t lbase = moba_list_off(kvh, n);
        if (t != t_img) {
            const bf16* Kb = (const bf16*)(F.ws + WS_K) + kvh * 128 + (size_t)(n * 256) * A_KVW; const bf16* Vb = (const bf16*)(F.ws + WS_V) + kvh * 128 + (size_t)(n * 256) * A_KVW;
            __syncthreads();
            { v4u r8[8]; tile_load<D, 8>(r8, Kb, A_KVW, tid); tile_store<D, 8>(kt, r8, tid); }
            { v4u r8[8]; tile_load<D, 8>(r8, Vb, A_KVW, tid); tile_store<D, 8>(vt, r8, tid); }
            __syncthreads();
            t_img = t;
            const int ir0 = c * 256 + w * 32 + r32; valid = ir0 < cnt; e = lst[lbase + (valid ? ir0 : 0)]; MOBA_QLOAD(qf, e);
        }
        const bool nxt_same = (idx + 1 < i_hi) && (sc[t] > idx + 1);
        unsigned e2 = 0u; bool valid2 = false;
        if (nxt_same) { const int ir2 = (c + 1) * 256 + w * 32 + r32; valid2 = ir2 < cnt; e2 = lst[lbase + (valid2 ? ir2 : 0)]; }
        const bool wact = __any(valid ? 1 : 0) != 0;
        float m = -1e30f, l = 0.f; f32x16 o[4];
#pragma unroll
        for (int db = 0; db < 4; ++db)
#pragma unroll
            for (int i = 0; i < 16; ++i) o[db][i] = 0.f;
        const int pair = (int)(e >> 2), j = (int)(e & 3u);
#pragma unroll 1
        for (int ss = 0; ss < 4; ++ss) {
            f32x16 p0, p1;
            if (wact) qk<D>(p0, p1, kt + ss * 64 * T::PITCH, qf, r32, hi);
            if (ss == 3 && nxt_same) { __builtin_amdgcn_sched_barrier(0); MOBA_QLOAD(qf, e2); }
            if (wact) { softmax_update<D>(p0, p1, m, l, o); pv<D>(o, vt + ss * 64 * T::PITCH, p0, p1, lane, hi); }
        }
        store_part<D>((bf16*)(F.ws + WS_PARTO) + ((size_t)pair * 4 + j) * 128, (float*)(F.ws + WS_PARTML) + ((size_t)pair * 4 + j) * 2, o, m, l, hi, valid);
        e = e2; valid = valid2;
    }
    __syncthreads();
#undef MOBA_QLOAD
}
DI void moba_combine_phase(Frame& F) {
    const int gw = F.vcu * NWAVES + F.wave, NGW = F.G * NWAVES, sub = F.lane >> 4, ch = F.lane & 15;
    const bf16* po = (const bf16*)(F.ws + WS_PARTO); const float* pml = (const float*)(F.ws + WS_PARTML); bf16* ob = (bf16*)(F.ws + WS_O);
#pragma unroll 1
    for (int it = gw; it < (M * A_H) / 4; it += NGW) {
        const int pair = it * 4 + sub, tok = pair >> 5, h = pair & 31, b = tok >> 8, nv = b < 3 ? b : 3;
        const f32x4 ml01 = *(const GAS f32x4*)(pml + (size_t)pair * 8), ml23 = *(const GAS f32x4*)(pml + (size_t)pair * 8 + 4);
        float mm[4] = {ml01.x, ml01.z, ml23.x, ml23.z}, ll[4] = {ml01.y, ml01.w, ml23.y, ml23.w};
        float mx = mm[3];
#pragma unroll
        for (int s = 0; s < 3; ++s) if (s < nv) mx = __builtin_fmaxf(mx, mm[s]);
        float wgt[4], wsum = 0.f;
#pragma unroll
        for (int s = 0; s < 4; ++s) { const bool ok = (s == 3) || (s < nv); wgt[s] = ok ? __builtin_amdgcn_exp2f(mm[s] - mx) * ll[s] : 0.f; wsum += wgt[s]; }
        const float inv = 1.0f / wsum; float acc[8];
#pragma unroll
        for (int e = 0; e < 8; ++e) acc[e] = 0.f;
#pragma unroll
        for (int s = 0; s < 4; ++s) { const bool ok = (s == 3) || (s < nv);
            if (ok) { const v4u v = *(const GAS v4u*)(po + ((size_t)pair * 4 + s) * 128 + ch * 8); const float ws_ = wgt[s] * inv;
                acc[0] += ws_ * bf2f(v.x & 0xffffu); acc[1] += ws_ * bf2f(v.x >> 16); acc[2] += ws_ * bf2f(v.y & 0xffffu); acc[3] += ws_ * bf2f(v.y >> 16);
                acc[4] += ws_ * bf2f(v.z & 0xffffu); acc[5] += ws_ * bf2f(v.z >> 16); acc[6] += ws_ * bf2f(v.w & 0xffffu); acc[7] += ws_ * bf2f(v.w >> 16); } }
        v4u o; o.x = cvtpk(acc[0], acc[1]); o.y = cvtpk(acc[2], acc[3]); o.z = cvtpk(acc[4], acc[5]); o.w = cvtpk(acc[6], acc[7]);
        *(GAS v4u*)(ob + (size_t)tok * DM + h * 128 + ch * 8) = o;
    }
}

DI void moba_combine_quant_phase(Frame& F, unsigned char* oq, float* sO) {
    const int gw = F.vcu * NWAVES + F.wave, NGW = F.G * NWAVES, sub = F.lane >> 4, ch = F.lane & 15;
    const bf16* po = (const bf16*)(F.ws + WS_PARTO); const float* pml = (const float*)(F.ws + WS_PARTML);
    const bool xblk = (F.G == 256);
#pragma unroll 1
    for (int j_ = 0, tok = xblk ? (gw >> 8) * 2048 + (gw & 255) : gw; tok < M && (!xblk || j_ < 8); ++j_, tok += xblk ? 256 : NGW) {
        const int b = tok >> 8, nv = b < 3 ? b : 3; float acc[8][8]; float amx = 0.f;
#pragma unroll
        for (int j = 0; j < 8; ++j) {
            const int pair = tok * 32 + 4 * j + sub;
            const f32x4 ml01 = *(const GAS f32x4*)(pml + (size_t)pair * 8), ml23 = *(const GAS f32x4*)(pml + (size_t)pair * 8 + 4);
            float mm[4] = {ml01.x, ml01.z, ml23.x, ml23.z}, ll[4] = {ml01.y, ml01.w, ml23.y, ml23.w};
            float mx = mm[3];
#pragma unroll
            for (int s = 0; s < 3; ++s) if (s < nv) mx = __builtin_fmaxf(mx, mm[s]);
            float wgt[4], wsum = 0.f;
#pragma unroll
            for (int s = 0; s < 4; ++s) { const bool ok = (s == 3) || (s < nv); wgt[s] = ok ? __builtin_amdgcn_exp2f(mm[s] - mx) * ll[s] : 0.f; wsum += wgt[s]; }
            const float inv = 1.0f / wsum;
#pragma unroll
            for (int e = 0; e < 8; ++e) acc[j][e] = 0.f;
#pragma unroll
            for (int s = 0; s < 4; ++s) { const bool ok = (s == 3) || (s < nv);
                if (ok) { const v4u v = *(const GAS v4u*)(po + ((size_t)pair * 4 + s) * 128 + ch * 8); const float ws_ = wgt[s] * inv;
                    acc[j][0] += ws_ * bf2f(v.x & 0xffffu); acc[j][1] += ws_ * bf2f(v.x >> 16); acc[j][2] += ws_ * bf2f(v.y & 0xffffu); acc[j][3] += ws_ * bf2f(v.y >> 16);
                    acc[j][4] += ws_ * bf2f(v.z & 0xffffu); acc[j][5] += ws_ * bf2f(v.z >> 16); acc[j][6] += ws_ * bf2f(v.w & 0xffffu); acc[j][7] += ws_ * bf2f(v.w >> 16); } }
#pragma unroll
            for (int e = 0; e < 8; ++e) amx = __builtin_fmaxf(amx, __builtin_fabsf(acc[j][e]));
        }
#pragma unroll
        for (int s = 1; s < 64; s <<= 1) amx = __builtin_fmaxf(amx, __shfl_xor(amx, s));
        const float qi = amx > 0.f ? 127.0f / amx : 0.f;
#pragma unroll
        for (int j = 0; j < 8; ++j) { v2u w; w.x = q8x4(acc[j][0], acc[j][1], acc[j][2], acc[j][3], qi); w.y = q8x4(acc[j][4], acc[j][5], acc[j][6], acc[j][7], qi);
            *(GAS v2u*)(oq + (size_t)tok * DM + (4 * j + sub) * 128 + ch * 8) = w; }
        if (F.lane == 0) sO[tok] = amx * (1.0f / 127.0f);
    }
}

DI void swa_item(Frame& F, int qb, int kvh) {
    constexpr int D = 64; typedef TL<D> T; constexpr int IMG = 384 * T::PITCH;
    LAS unsigned char* kt = F.lds + RING_OFF; LAS unsigned char* vt = kt + IMG;
    const int lane = F.lane, r32 = lane & 31, hi = lane >> 5, w = F.wave, tid = F.tid;
    const long base = (long)qb * 256 - 128; const int tb = (qb == 0) ? 2 : 0;
    const bf16* Kb = (const bf16*)(F.ws + WS_KSH) + kvh * 64 + base * B_KVW; const bf16* Vb = (const bf16*)(F.ws + WS_VSH) + kvh * 64 + base * B_KVW;
    const int tok = qb * 256 + w * 32 + r32;
    const bf16* qrow = (const bf16*)(F.ws + WS_Q) + (size_t)tok * DM + kvh * 8 * 64;
    bf16x8 qf[4];
#pragma unroll
    for (int s = 0; s < 4; ++s) qf[s] = *(const GAS bf16x8*)(qrow + 16 * s + 8 * hi);
    { v4u rk[6], rv[6];
#pragma unroll
      for (int i = 0; i < 6; ++i) { const int c = tid + 512 * i, row = c >> 3, ch = c & 7; if (row >= 64 * tb) { rk[i] = *(const GAS v4u*)(Kb + (size_t)row * B_KVW + ch * 8); rv[i] = *(const GAS v4u*)(Vb + (size_t)row * B_KVW + ch * 8); } }
      __syncthreads();
#pragma unroll
      for (int i = 0; i < 6; ++i) { const int c = tid + 512 * i, row = c >> 3, ch = c & 7; if (row >= 64 * tb) { *(LAS v4u*)(kt + row * T::PITCH + ch * 16) = rk[i]; *(LAS v4u*)(vt + row * T::PITCH + ch * 16) = rv[i]; } }
      __syncthreads(); }
    const float NEG = -__builtin_inff(); const int qs = 32 * w, qrel = qs + r32;
#pragma unroll 1
    for (int g = 0; g < 8; ++g) {
        const int h = kvh * 8 + g;
        bf16x8 qn[4];
        if (g < 7) {
#pragma unroll
            for (int s = 0; s < 4; ++s) qn[s] = *(const GAS bf16x8*)(qrow + (g + 1) * 64 + 16 * s + 8 * hi); }
        float m = F.b_sinks[h] * LOG2E, l = (hi == 0) ? 1.0f : 0.f; f32x16 o[2];
#pragma unroll
        for (int db = 0; db < 2; ++db)
#pragma unroll
            for (int i = 0; i < 16; ++i) o[db][i] = 0.f;
#pragma unroll 1
        for (int tt = tb; tt < 6; ++tt) {
            const int kbr = -128 + 64 * tt;
            if ((kbr <= qs + 31) && (kbr + 63 >= qs - 127)) {
                f32x16 p0, p1; qk<D>(p0, p1, kt + tt * 64 * T::PITCH, qf, r32, hi);
                const int kb = kbr + 4 * hi;
#pragma unroll
                for (int i = 0; i < 16; ++i) { const int kv = kb + (i & 3) + 8 * (i >> 2);
                    p0[i] = (kv <= qrel && qrel - kv < 128) ? p0[i] : NEG; p1[i] = (kv + 32 <= qrel && qrel - kv - 32 < 128) ? p1[i] : NEG; }
                softmax_update<D>(p0, p1, m, l, o);
                pv<D>(o, vt + tt * 64 * T::PITCH, p0, p1, lane, hi);
            }
        }
        store_o<D>((bf16*)(F.ws + WS_O) + (size_t)tok * DM + h * 64, o, l, hi);
        if (g < 7) {
#pragma unroll
            for (int s = 0; s < 4; ++s) qf[s] = qn[s]; }
    }
}
DI void swa_phase(Frame& F) {
    if (F.G == 256) { const int qb = (F.vcu >> 5) * 8 + (F.vcu & 7), kv0 = (F.vcu & 31) >> 3;
#pragma unroll 1
        for (int t = 0; t < 2; ++t) swa_item(F, qb, kv0 + 4 * t); }
    else
#pragma unroll 1
    for (int p = F.vcu; p < 64 * 8; p += F.G) swa_item(F, p & 63, p >> 6);
    __syncthreads();
}
#undef MFMA32
}
struct Args { const float* in[13]; float* out; unsigned char* ws; int ph_lo, ph_hi; };
__global__ void __launch_bounds__(NWAVES * 64, 2) yoco_fwd(Args args) {
    extern __shared__ __attribute__((aligned(16))) unsigned char lds[];
    Frame F;
    F.lds = (LAS unsigned char*)lds;
    F.MISC = (volatile LAS unsigned*)(F.lds + MISC_OFF);
    F.tid = threadIdx.x; F.lane = F.tid & 63; F.wave = __builtin_amdgcn_readfirstlane(F.tid >> 6);
    F.G = gridDim.x; { const int bx = blockIdx.x; F.vcu = (F.G % 8 == 0) ? (bx % 8) * (F.G / 8) + bx / 8 : bx; }
    F.ws = args.ws; F.ctl = (gu32*)(args.ws + WS_CTL);
    F.x = args.in[0]; F.ffn_norm = args.in[1]; F.ffn_w_in = args.in[2]; F.ffn_w_out = args.in[3]; F.attn_norm = args.in[4]; F.a_w_qkv = args.in[5]; F.a_w_o = args.in[6];
    F.kv_norm = args.in[7]; F.w_kv = args.in[8]; F.b_w_q = args.in[9]; F.b_sinks = args.in[10]; F.b_w_o = args.in[11]; F.final_norm = args.in[12]; F.out = args.out;
    for (int u = F.tid; u < (LDS_BYTES - LDSCTL_OFF) / 4; u += NWAVES * 64) ((LAS unsigned*)(F.lds + LDSCTL_OFF))[u] = 0u;
    __syncthreads();
    XcdBarrier bar; bar.bar = (unsigned*)(F.ctl + CW_BAR); bar.x = 0; bar.st = nullptr;
    if (!MK_SPLIT) bar = xcd_barrier_post((unsigned*)(F.ctl + CW_BAR), F.MISC + 8);
#define GRID_BAR(seam) do { if (MK_SPLIT) { if (F.tid == 0) __hip_atomic_store(F.ctl + CW_TMO, 0xBADBA0u | (unsigned)(seam), RLX_AGENT); } else { xcd_barrier(bar); } } while (0)
    const int lo = args.ph_lo, hi = args.ph_hi;
#ifndef PH_MASK
#define PH_MASK 0xffffffffu
#endif
#define IN(k) ((((PH_MASK) >> (k)) & 1u) && lo <= (k) && (k) < hi)
#define SEAM(k) do { if (IN(k) && IN((k) + 1)) GRID_BAR(k); } while (0)
    unsigned* const lbw_ = (unsigned*)(F.ctl + CW_LBAR); bool localok = false;
    if (!MK_SPLIT && F.tid == 0 && ((int)xb_xcc_id() != (int)(blockIdx.x % 8) || F.G != 256)) __hip_atomic_fetch_or((unsigned*)(F.ctl + CW_LFLAG), 1u, RLX_AGENT);
#define LOCAL_BAR(seam) do { if (MK_SPLIT || !localok) GRID_BAR(seam); else xcd_local_barrier(bar, lbw_); } while (0)
#define LSEAM(k) do { if (IN(k) && IN((k) + 1)) LOCAL_BAR(k); } while (0)
    bf16* const W_IN = (bf16*)(F.ws + WS_WIN); bf16* const W_OUT = (bf16*)(F.ws + WS_WOUT);
    bf16* const W_QKV = (bf16*)(F.ws + WS_WQKV); bf16* const W_AO = (bf16*)(F.ws + WS_WAO); bf16* const W_KV = (bf16*)(F.ws + WS_WKV); bf16* const W_BQ = (bf16*)(F.ws + WS_WBQ); bf16* const W_BO = (bf16*)(F.ws + WS_WBO);
    bf16* const XN = (bf16*)(F.ws + WS_XN); bf16* const ACT = (bf16*)(F.ws + WS_ACT); bf16* const QB = (bf16*)(F.ws + WS_Q); bf16* const KB = (bf16*)(F.ws + WS_K); bf16* const VB = (bf16*)(F.ws + WS_V);
    bf16* const OB = (bf16*)(F.ws + WS_O); bf16* const KSH = (bf16*)(F.ws + WS_KSH); bf16* const VSH = (bf16*)(F.ws + WS_VSH);
    const float* const COSA = (const float*)(F.ws + WS_ROPEA); const float* const SINA = COSA + (size_t)M * 64; const float* const COSB = (const float*)(F.ws + WS_ROPEB); const float* const SINB = COSB + (size_t)M * 32;
    unsigned char* const W8 = (unsigned char*)(F.ws + WS_WIN); unsigned char* const XN8 = (unsigned char*)(F.ws + WS_XN8); float* const SA = (float*)(F.ws + WS_SA);
    float* const COLMAX = (float*)(F.ctl + CW_COLMAX); constexpr int CM_BQ = 4 * 2 * DFF, CM_KV = CM_BQ + DM, CM_AO = CM_KV + 2 * B_KVW, CM_BO = CM_AO + DM, CM_OUT = CM_BO + DM, CM_QKV = CM_OUT + 4 * DM;
    bf16* const XRES = (bf16*)(F.ws + WS_XN);
    unsigned char* const ACT8 = (unsigned char*)(F.ws + WS_ACT8); float* const SACT = (float*)(F.ws + WS_SACT); unsigned char* const W8O = (unsigned char*)(F.ws + WS_WOUT);
    constexpr size_t E_WIN = (size_t)2 * DFF * DM, E_WOUT = (size_t)DFF * DM;

#define GEMM_PHASE_T(EPI_T, EPI_OBJ, A_, B_, N_, K_, TA_, TB_, WGM_) do { pg8::Gemm g_{(A_), (B_), M, (N_), (K_)}; pg8::StaticOrder S_; S_.init(M, (N_), F.G, (int)blockIdx.x, (WGM_)); \
        pg8::gemm_phase<EPI_T, pg8::StaticOrder, PG8_ALIGN, PG8_SP2, TA_, TB_>(F.lds + RING_OFF, g_, S_, (EPI_OBJ)); } while (0)
#ifndef XN_TILED
#define XN_TILED false
#endif
#define GEMM_PHASE_8(EPI_T, EPI_OBJ, A_, B_, N_, K_) do { pg8::Gemm g_{(const bf16*)(A_), (const bf16*)(B_), M, (N_), (K_)}; pg8::StaticOrder S_; S_.init(M, (N_), F.G, (int)blockIdx.x, 8); \
        pg8::gemm_phase<EPI_T, pg8::StaticOrder, PG8_ALIGN, PG8_SP2, false, true, true>(F.lds + RING_OFF, g_, S_, (EPI_OBJ)); } while (0)
#define GEMM_PHASE(EPI_T, EPI_OBJ, A_, B_, N_, K_) GEMM_PHASE_T(EPI_T, EPI_OBJ, A_, B_, N_, K_, false, true, 8)
#define GEMM_PHASE_X(EPI_T, EPI_OBJ, A_, B_, N_, K_) GEMM_PHASE_T(EPI_T, EPI_OBJ, A_, B_, N_, K_, XN_TILED, true, 8)
#ifndef DOWN_WGM
#define DOWN_WGM 2
#endif
#define AQ_EARLY 640
#define FFN_UP(f)   do { pg8::EpiSwiGLU8 E_{ACT, DFF, SA, COLMAX + (size_t)(f) * 2 * DFF}; pg8::Gemm g_{(const bf16*)XN8, (const bf16*)(W8 + (size_t)(f) * E_WIN), M, 2 * DFF, DM}; \
        if (localok) { \
            { pg8::UpOrder S_; S_.init(M, 2 * DFF, F.G, (int)blockIdx.x, 8, 0, 21); S_.tailmajor = true; \
              pg8::gemm_phase<pg8::EpiSwiGLU8, pg8::UpOrder, PG8_ALIGN, PG8_SP2, false, true, true>(F.lds + RING_OFF, g_, S_, E_); } \
            unsigned* const arr_ = (unsigned*)(F.ctl + CW_UPARR) + 64 * (f) + (F.vcu >> 5); \
            asm volatile("s_waitcnt vmcnt(0)" ::: "memory"); __syncthreads(); \
            if (F.tid == 0) __hip_atomic_fetch_add(arr_, 1u, RLX_AGENT); \
            if ((F.vcu & 31) < 16) { pg8::UpOrder S_; S_.init(M, 2 * DFF, F.G, (int)blockIdx.x, 8, 21, 22); S_.tailmajor = true; \
              pg8::gemm_phase<pg8::EpiSwiGLU8, pg8::UpOrder, PG8_ALIGN, PG8_SP2, false, true, true>(F.lds + RING_OFF, g_, S_, E_); } \
            else { if (F.tid == 0) { XB_SPIN(__hip_atomic_load(arr_, RLX_AGENT) < 32u, bar.bar); __builtin_amdgcn_fence(__ATOMIC_ACQUIRE, "agent"); asm volatile("s_waitcnt vmcnt(0)" ::: "memory"); } \
              __syncthreads(); \
              act_quant_rows(F, ACT, ACT8, SACT, (F.vcu >> 5) * 2048, (F.vcu >> 5) * 2048 + AQ_EARLY, (F.vcu & 31) - 16, 16); } \
        } else { pg8::ClaimOrder S_; S_.init(M, 2 * DFF, F.G, (int)blockIdx.x, 8); S_.setup((unsigned*)(F.ctl + CW_CLAIM + 64 * (f)), F.MISC + 16); \
            pg8::gemm_phase<pg8::EpiSwiGLU8, pg8::ClaimOrder, PG8_ALIGN, PG8_SP2, false, true, true>(F.lds + RING_OFF, g_, S_, E_); } } while (0)
#define ACT_QUANT_REST() do { if (localok) act_quant_rows(F, ACT, ACT8, SACT, (F.vcu >> 5) * 2048 + AQ_EARLY, (F.vcu >> 5) * 2048 + 2048, F.vcu & 31, 32); else act_quant_phase(F, ACT, ACT8, SACT); } while (0)
#define FFN_DOWN(f, BASE_) do { pg8::EpiResid8 E_{(BASE_), (pg8::bf16_t*)XRES, DM, 0.5f, SACT, COLMAX + CM_OUT + (size_t)(f) * DM}; pg8::Gemm g_{(const bf16*)ACT8, (const bf16*)(W8O + (size_t)(f) * E_WOUT), M, DM, DFF}; \
        pg8::StaticOrder S_; S_.init(M, DM, F.G, (int)blockIdx.x, DOWN_WGM); pg8::gemm_phase<pg8::EpiResid8, pg8::StaticOrder, PG8_ALIGN, PG8_SP2, (ACT8_TILED != 0), true, true>(F.lds + RING_OFF, g_, S_, E_); } while (0)

    LAS float* const scr_ = (LAS float*)(F.lds + RING_OFF + F.wave * 16384);
#ifndef XN_FFN_DROP
#define XN_FFN_DROP 2
#endif
#ifndef FFN_W_DROP
#define FFN_W_DROP 2
#endif
#define TR_WXD(SRC, GAIN, DST, K_, N_, MODE_, LIM_, TL_, GW_, NGW_, DROP_) for (int it_ = (GW_); it_ < ((K_) / 64) * ((N_) / 32); it_ += (NGW_)) tr_item<TL_, DROP_>((SRC), (GAIN), (DST), (K_), (N_), (N_), (MODE_), (LIM_), scr_, it_, F.lane)
#define TR_WX(SRC, GAIN, DST, K_, N_, MODE_, LIM_, TL_, GW_, NGW_) for (int it_ = (GW_); it_ < ((K_) / 64) * ((N_) / 32); it_ += (NGW_)) tr_item<TL_>((SRC), (GAIN), (DST), (K_), (N_), (N_), (MODE_), (LIM_), scr_, it_, F.lane)
    const bool tailconv = false, tailwg = false;
    const int tw_ = ((int)blockIdx.x - 128) * NWAVES + F.wave, NTW_ = 128 * NWAVES;
    if (IN(0)) {
        {
        const int gw = F.vcu * NWAVES + F.wave, NGW = F.G * NWAVES;
#define TR_W(SRC, GAIN, DST, K_, N_, MODE_, LIM_, TL_) TR_WX(SRC, GAIN, DST, K_, N_, MODE_, LIM_, TL_, gw, NGW)
#define TR_WF(SRC, GAIN, DST, K_, N_, MODE_, LIM_, TL_) TR_WXD(SRC, GAIN, DST, K_, N_, MODE_, LIM_, TL_, gw, NGW, FFN_W_DROP)
        if (!tailconv) {
        }
#undef TR_W
#undef TR_WF
        { LAS unsigned* const cmlb_ = (LAS unsigned*)(F.lds + RING_BYTES); constexpr int S_IN = (2 * DFF) / 16, S_D = DM / 16, S_KV = (2 * B_KVW) / 16, S_QKV = NQKV / 16, S_TOT = 4 * S_IN + 3 * S_D + S_KV + S_QKV;
          if (F.tid < 64) cmlb_[F.tid] = 0u;
          __syncthreads();
          int par_ = 0;
#pragma unroll 1
          for (int st_ = F.vcu; st_ < S_TOT; st_ += F.G, par_ = (par_ == 32 ? 0 : par_ + 16)) {
              if (F.tid < 16) cmlb_[(par_ == 32 ? 0 : par_ + 16) + F.tid] = 0u;
              const float* src_; const float* gn_; float* cm_; unsigned char* dst_; int n_, mode_, lim_, sl_;
              if (st_ < 4 * S_IN) { const int fw_ = st_ / S_IN; sl_ = st_ - fw_ * S_IN; src_ = F.ffn_w_in + (size_t)fw_ * E_WIN; gn_ = F.ffn_norm + (size_t)fw_ * DM; cm_ = COLMAX + (size_t)fw_ * 2 * DFF; dst_ = W8 + (size_t)fw_ * E_WIN; n_ = 2 * DFF; mode_ = 1; lim_ = 0; }
              else if (st_ < 4 * S_IN + S_D) { sl_ = st_ - 4 * S_IN; src_ = F.b_w_q; gn_ = F.attn_norm + DM; cm_ = COLMAX + CM_BQ; dst_ = (unsigned char*)W_BQ; n_ = DM; mode_ = 3; lim_ = 4096; }
              else if (st_ < 4 * S_IN + 2 * S_D) { sl_ = st_ - 4 * S_IN - S_D; src_ = F.a_w_o; gn_ = nullptr; cm_ = COLMAX + CM_AO; dst_ = (unsigned char*)W_AO; n_ = DM; mode_ = 0; lim_ = 0; }
              else if (st_ < 4 * S_IN + 3 * S_D) { sl_ = st_ - 4 * S_IN - 2 * S_D; src_ = F.b_w_o; gn_ = nullptr; cm_ = COLMAX + CM_BO; dst_ = (unsigned char*)W_BO; n_ = DM; mode_ = 0; lim_ = 0; }
              else if (st_ >= 4 * S_IN + 3 * S_D + S_KV) { sl_ = st_ - 4 * S_IN - 3 * S_D - S_KV; src_ = F.a_w_qkv; gn_ = F.attn_norm; cm_ = COLMAX + CM_QKV; dst_ = (unsigned char*)W_QKV; n_ = NQKV; mode_ = 2; lim_ = 5120; }
              else { sl_ = st_ - 4 * S_IN - 3 * S_D; src_ = F.w_kv; gn_ = F.kv_norm; cm_ = COLMAX + CM_KV; dst_ = (unsigned char*)W_KV; n_ = 2 * B_KVW; mode_ = 3; lim_ = 512; }
              strip16_quant8(F, src_, gn_, cm_, dst_, n_, mode_, lim_, sl_, scr_, cmlb_ + par_);
          }
          __syncthreads(); }
        { LAS unsigned* const cml_ = (LAS unsigned*)(F.lds + RING_BYTES);
#pragma unroll 1
          for (int st_ = F.vcu; st_ < 4 * (DM / 32); st_ += F.G) { const int fw_ = st_ / (DM / 32), sl_ = st_ - fw_ * (DM / 32);
              strip_quant8_rot(F, F.ffn_w_out + (size_t)fw_ * E_WOUT, COLMAX + CM_OUT + (size_t)fw_ * DM, W8O + (size_t)fw_ * E_WOUT, DFF, DM, sl_, scr_, cml_); } }
        rope_tables(F);
        norm_rows8<0>(F, F.x, XN8, SA, (bf16*)nullptr);
        }
    }
    if (IN(0) && IN(1)) GRID_BAR(0);
    if (!MK_SPLIT) localok = __builtin_amdgcn_readfirstlane((int)__hip_atomic_load((unsigned*)(F.ctl + CW_LFLAG), RLX_AGENT)) == 0;
    if (IN(1)) { FFN_UP(0);
        if (tailwg) { TR_WX(F.a_w_qkv, F.attn_norm, W_QKV, DM, NQKV, 2, 5120, true, tw_, NTW_); } }
    if (IN(1) && IN(27)) LOCAL_BAR(1);
    if (IN(27)) ACT_QUANT_REST();
    if (IN(27) && IN(2)) LOCAL_BAR(27);
    if (IN(2)) FFN_DOWN(0, F.x);
    LSEAM(2);
    if (IN(3)) norm_rows8_b(F, XRES, XN8, SA);
    LSEAM(3);
    if (IN(4)) { pg8::EpiRope8<128> E_{QB, KB, VB, DM, A_KVW, A_KVW, 16, 4, 0.08838834764831845f * LOG2E, COSA, SINA, SA, COLMAX + CM_QKV}; GEMM_PHASE_8(pg8::EpiRope8<128>, E_, XN8, W_QKV, NQKV, DM);
    }
    SEAM(4);
    if (IN(5)) kmean_phase(F);
    SEAM(5);
    if (IN(6)) att::moba_own_phase(F);
    SEAM(6);
    if (IN(22)) att::moba_past_phase(F);
    if (IN(22) && IN(23)) GRID_BAR(22);
    if (IN(23)) att::moba_combine_quant_phase(F, XN8, SA);
    if (IN(23) && IN(7)) LOCAL_BAR(23);
    if (IN(7)) { pg8::EpiResid8 E_{nullptr, (pg8::bf16_t*)XRES, DM, 1.0f, SA, COLMAX + CM_AO}; GEMM_PHASE_8(pg8::EpiResid8, E_, XN8, W_AO, DM, DM); }
    LSEAM(7);
    if (IN(8)) norm_rows8_b(F, XRES, XN8, SA);
    LSEAM(8);
    if (IN(9)) { FFN_UP(1);
        if (tailwg) { } }
    if (IN(9) && IN(28)) LOCAL_BAR(9);
    if (IN(28)) ACT_QUANT_REST();
    if (IN(28) && IN(10)) LOCAL_BAR(28);
    if (IN(10)) FFN_DOWN(1, (const float*)nullptr);
    LSEAM(10);
    if (IN(11)) norm_rows8_b(F, XRES, XN8, SA);
    LSEAM(11);
    if (IN(12)) { { pg8::EpiRope8<64> E_{KSH, KSH, VSH, B_KVW, B_KVW, B_KVW, 0, 2, 1.0f, COSB, SINB, SA, COLMAX + CM_KV}; GEMM_PHASE_8(pg8::EpiRope8<64>, E_, XN8, W_KV, 2 * B_KVW, DM); }
                  FFN_UP(2);
                  }
    if (IN(12) && IN(29)) LOCAL_BAR(12);
    if (IN(29)) ACT_QUANT_REST();
    if (IN(29) && IN(13)) LOCAL_BAR(29);
    if (IN(13)) FFN_DOWN(2, (const float*)nullptr);
    LSEAM(13);
    if (IN(14)) norm_rows8_b(F, XRES, XN8, SA);
    LSEAM(14);
    if (IN(15)) { pg8::EpiRope8<64> E_{QB, QB, QB, DM, DM, DM, 16, 0, 0.125f * LOG2E, COSB, SINB, SA, COLMAX + CM_BQ}; GEMM_PHASE_8(pg8::EpiRope8<64>, E_, XN8, W_BQ, DM, DM); }
    SEAM(15);
    if (IN(16)) att::swa_phase(F);
    if (IN(16) && IN(26)) LOCAL_BAR(16);
    if (IN(26)) quant_rows_bf16(F, OB, XN8, SA);
    if (IN(26) && IN(17)) LOCAL_BAR(26);
    if (IN(17)) { pg8::EpiResid8 E_{nullptr, (pg8::bf16_t*)XRES, DM, 1.0f, SA, COLMAX + CM_BO}; GEMM_PHASE_8(pg8::EpiResid8, E_, XN8, W_BO, DM, DM); }
    LSEAM(17);
    if (IN(18)) norm_rows8_b(F, XRES, XN8, SA);
    LSEAM(18);
    if (IN(19)) FFN_UP(3);
    if (IN(19) && IN(30)) LOCAL_BAR(19);
    if (IN(30)) ACT_QUANT_REST();
    if (IN(30) && IN(20)) LOCAL_BAR(30);
    if (IN(20)) FFN_DOWN(3, (const float*)nullptr);
    LSEAM(20);
    if (IN(21)) { bool poison = false; if (!MK_SPLIT) poison = __hip_atomic_load((gu32*)((unsigned*)(F.ctl + CW_BAR) + XB_TMO), RLX_AGENT) != 0u;
                  final_norm_rows_b(F, XRES, F.out, F.final_norm, poison); }
#undef IN
#undef SEAM
#undef GRID_BAR
#undef LOCAL_BAR
#undef LSEAM
}

extern "C" void kernel_launch(void* const* d_in, const int* in_sizes, int n_in, void* d_out, int out_size, void* d_ws, size_t ws_size, hipStream_t stream) {
    static int grid = 0;
    if (grid == 0) {
        if (n_in != 13 || in_sizes[0] != M * DM || out_size != M * DM || ws_size < WS_END) { fprintf(stderr, "kernel_launch: unexpected shapes: n_in %d, in0 %d, out %d, ws %zu (need %zu); nothing launched\n", n_in, n_in > 0 ? in_sizes[0] : -1, out_size, ws_size, (size_t)WS_END); grid = -1; return; }
        int dev = 0, cus = 0, per_cu = 0;
        if (hipGetDevice(&dev) != hipSuccess || hipDeviceGetAttribute(&cus, hipDeviceAttributeMultiprocessorCount, dev) != hipSuccess) { fprintf(stderr, "kernel_launch: device query failed\n"); grid = -1; return; }
        if (hipFuncSetAttribute((const void*)yoco_fwd, hipFuncAttributeMaxDynamicSharedMemorySize, LDS_BYTES) != hipSuccess) { fprintf(stderr, "kernel_launch: hipFuncSetAttribute failed\n"); grid = -1; return; }
        if (hipOccupancyMaxActiveBlocksPerMultiprocessor(&per_cu, (const void*)yoco_fwd, NWAVES * 64, LDS_BYTES) != hipSuccess || per_cu < 1)
            fprintf(stderr, "kernel_launch: note: occupancy query reports %d workgroups per CU\n", per_cu);
        (void)hipGetLastError();
        grid = cus;
    }
    if (grid < 0) return;
    if (hipMemsetAsync((char*)d_ws + WS_CTL, 0, CTL_ZERO_BYTES, stream) != hipSuccess) { fprintf(stderr, "kernel_launch: hipMemsetAsync failed\n"); return; }
    Args a{};
    for (int i = 0; i < 13; ++i) a.in[i] = (const float*)d_in[i];
    a.out = (float*)d_out; a.ws = (unsigned char*)d_ws;
#if MK_SPLIT
    static const int order[N_PHASES] = {0, 24, 25, 1, 27, 2, 3, 4, 5, 6, 22, 23, 7, 8, 9, 28, 10, 11, 12, 29, 13, 14, 15, 16, 26, 17, 18, 19, 30, 20, 21};
    for (int k = 0; k < N_PHASES; ++k) { a.ph_lo = order[k]; a.ph_hi = order[k] + 1; hipLaunchKernelGGL(yoco_fwd, dim3(grid), dim3(NWAVES * 64), LDS_BYTES, stream, a); }
#else
    a.ph_lo = 0; a.ph_hi = N_PHASES;
    hipLaunchKernelGGL(yoco_fwd, dim3(grid), dim3(NWAVES * 64), LDS_BYTES, stream, a);
#endif
    const hipError_t le = hipPeekAtLastError();
    if (le != hipSuccess) fprintf(stderr, "kernel_launch: launch failed: %s\n", hipGetErrorName(le));
}
```
